# Optimizing an MI355X kernel written in HIP

```python
import functools
import jax, jax.numpy as jnp
from jax import lax
import numpy as np

D_MODEL = 1024
BATCH = 4
SEQ = 4096
DEPTH = 1
DEC_BATCH = 128
DEC_SEQ = 4
PAST_LEN = 2048
PAGE_SIZE = 128

HEAD_DIM = 64
WINDOWS = (128, 512, 2048)
DILATIONS = (1, 4, 16)
N_GROUPS = 3
HEADS_PER_GROUP = 4
N_HEADS = N_GROUPS * HEADS_PER_GROUP
ATTN_WIDTH = N_HEADS * HEAD_DIM
ATTN_OUT_WIDTH = HEADS_PER_GROUP * HEAD_DIM
ATTN_SCALE = HEAD_DIM ** -0.5
ROT_DIM = HEAD_DIM // 4
ROPE_THETA = 500000.0
CONV_CH = D_MODEL // 2
CONV_WIDTH = 31
D_FF = 256 * ((8 * D_MODEL // 3 + 255) // 256)
NORM_EPS = 1e-6
IN_SPLITS = (CONV_CH, 2 * CONV_CH, 2 * CONV_CH + ATTN_WIDTH, 2 * CONV_CH + 2 * ATTN_WIDTH, 2 * CONV_CH + 3 * ATTN_WIDTH)
IN_WIDTH = 2 * CONV_CH + 3 * ATTN_WIDTH + 2 * D_MODEL

kernel_name = "macaron_conv_dilated_window_hybrid_step"


def rmsnorm(x, g):
    xf = x.astype(jnp.float32)
    y = xf * lax.rsqrt(jnp.mean(xf * xf, axis=-1, keepdims=True) + NORM_EPS)
    return (y * g.astype(jnp.float32)).astype(x.dtype)


def swiglu_ffn(x, w_in, w_out):
    gate, up = jnp.split(x @ w_in, 2, axis=-1)
    return (jax.nn.silu(gate) * up) @ w_out


def rotary(x, pos):
    half = ROT_DIM // 2
    inv = jnp.float32(ROPE_THETA) ** (-jnp.arange(half, dtype=jnp.float32) * (2.0 / ROT_DIM))
    ang = pos.astype(jnp.float32)[:, None] * inv[None, :]
    cos = jnp.cos(ang)[:, None, :]
    sin = jnp.sin(ang)[:, None, :]
    xf = x.astype(jnp.float32)
    x1 = xf[..., :half]
    x2 = xf[..., half:ROT_DIM]
    out = jnp.concatenate([x1 * cos - x2 * sin, x2 * cos + x1 * sin, xf[..., ROT_DIM:]], axis=-1)
    return out.astype(x.dtype)


def mix_project(h, pos, w_in, b_gate, q_norm, k_norm):
    u_a, u_b, q, k, v, gates = jnp.split(h @ w_in, list(IN_SPLITS), axis=-1)
    u = u_a * jax.nn.sigmoid(u_b)
    shp = h.shape[:-1] + (N_HEADS, HEAD_DIM)
    q = rotary(rmsnorm(q.reshape(shp), q_norm), pos)
    k = rotary(rmsnorm(k.reshape(shp), k_norm), pos)
    v = v.reshape(shp)
    gates = jax.nn.sigmoid((gates + b_gate).astype(jnp.float32)).astype(h.dtype)
    return u, q, k, v, gates


def conv_branch(conv_in, conv_w, conv_b, ln_g, ln_b, w_conv_out):
    y = lax.conv_general_dilated(conv_in, conv_w[:, None, :], window_strides=(1,), padding="VALID",
                                 dimension_numbers=("NWC", "WIO", "NWC"), feature_group_count=CONV_CH) + conv_b
    yf = y.astype(jnp.float32)
    mu = jnp.mean(yf, axis=-1, keepdims=True)
    var = jnp.mean(jnp.square(yf - mu), axis=-1, keepdims=True)
    yn = ((yf - mu) * lax.rsqrt(var + NORM_EPS) * ln_g.astype(jnp.float32) + ln_b.astype(jnp.float32)).astype(y.dtype)
    return jax.nn.silu(yn) @ w_conv_out


def _with_prev_block(xb):
    prev = jnp.concatenate([jnp.zeros_like(xb[:, :1]), xb[:, :-1]], axis=1)
    return jnp.concatenate([prev, xb], axis=2)


def _band_scores(q, k, window, dil):
    b, tp, h, e = q.shape
    blk = window // dil
    nb = tp // window
    qb = q.reshape(b, nb, blk, dil, h, e)
    kb = _with_prev_block(k.reshape(b, nb, blk, dil, h, e))
    s = jnp.einsum("bnidhe,bnjdhe->bnidhj", qb, kb).astype(jnp.float32) * ATTN_SCALE
    i = jnp.arange(blk)[:, None]
    j = jnp.arange(2 * blk)[None, :]
    n = jnp.arange(nb)[:, None, None]
    rel = i + blk - j
    valid = (rel >= 0) & (rel <= blk) & (n * blk + j - blk >= 0)
    s = jnp.where(valid[None, :, :, None, None, :], s, -jnp.inf)
    return s.reshape(b, tp, h, 2 * blk)


def _band_values(p, v, window, dil):
    b, tp, h, e = v.shape
    blk = window // dil
    nb = tp // window
    vb = _with_prev_block(v.reshape(b, nb, blk, dil, h, e))
    pb = p.reshape(b, nb, blk, dil, h, 2 * blk).astype(v.dtype)
    return jnp.einsum("bnidhj,bnjdhe->bnidhe", pb, vb).reshape(b, tp, h, e)


def dilated_attention_prompt(q, k, v):
    b, t = q.shape[:2]
    w_max = max(WINDOWS)
    tp = -(-t // w_max) * w_max
    pad = ((0, 0), (0, tp - t), (0, 0), (0, 0))
    q, k, v = jnp.pad(q, pad), jnp.pad(k, pad), jnp.pad(v, pad)
    groups = list(zip(WINDOWS, DILATIONS))
    scores = [_band_scores(q[:, :, g * HEADS_PER_GROUP:(g + 1) * HEADS_PER_GROUP],
                           k[:, :, g * HEADS_PER_GROUP:(g + 1) * HEADS_PER_GROUP], w, d)
              for g, (w, d) in enumerate(groups)]
    p = jax.nn.softmax(jnp.concatenate(scores, axis=-1), axis=-1)
    outs = []
    off = 0
    for g, (w, d) in enumerate(groups):
        nk = scores[g].shape[-1]
        outs.append(_band_values(p[..., off:off + nk], v[:, :, g * HEADS_PER_GROUP:(g + 1) * HEADS_PER_GROUP], w, d))
        off += nk
    out = functools.reduce(jnp.add, outs)
    return out[:, :t].reshape(b, t, ATTN_OUT_WIDTH)


def dilated_attention_sample(q, k_full, v_full):
    b, s_len = q.shape[:2]
    scores, vals = [], []
    for g, (w, d) in enumerate(zip(WINDOWS, DILATIONS)):
        kf, vf = k_full[g], v_full[g]
        past = kf.shape[1] - s_len
        nk = w // d + 1
        idx = past + jnp.arange(s_len)[:, None] - d * jnp.arange(nk)[None, :]
        valid = idx >= 0
        idxc = jnp.maximum(idx, 0)
        kg = jnp.take(kf, idxc, axis=1)
        vals.append(jnp.take(vf, idxc, axis=1))
        sc = jnp.einsum("bshe,bsjhe->bshj", q[:, :, g * HEADS_PER_GROUP:(g + 1) * HEADS_PER_GROUP], kg)
        sc = sc.astype(jnp.float32) * ATTN_SCALE
        scores.append(jnp.where(valid[None, :, None, :], sc, -jnp.inf))
    p = jax.nn.softmax(jnp.concatenate(scores, axis=-1), axis=-1)
    outs = []
    off = 0
    for g in range(N_GROUPS):
        nk = scores[g].shape[-1]
        outs.append(jnp.einsum("bshj,bsjhe->bshe", p[..., off:off + nk].astype(vals[g].dtype), vals[g]))
        off += nk
    out = functools.reduce(jnp.add, outs)
    return out.reshape(b, s_len, ATTN_OUT_WIDTH)


def merge_branches(a, b_attn, gates, w_attn_out, w_out):
    g_a, g_b = jnp.split(gates, 2, axis=-1)
    return (g_a * a + g_b * (b_attn @ w_attn_out)) @ w_out


def setup_inputs(seed: int = 0) -> dict:
    key = jax.random.key(seed)
    ks = iter(jax.random.split(key, 40))
    nrm = lambda shape, scale: scale * jax.random.normal(next(ks), shape, jnp.float32)
    gain = lambda shape: 1.0 + nrm(shape, 0.02)
    L = DEPTH
    lens = [min(w, PAST_LEN) for w in WINDOWS]
    cshape = lambda n: (L, DEC_BATCH, n, HEADS_PER_GROUP, HEAD_DIM)
    return {
        "x_prompt": nrm((BATCH, SEQ, D_MODEL), 1.0),
        "x_sample": nrm((DEC_BATCH, DEC_SEQ, D_MODEL), 1.0),
        "cache_k_w128": nrm(cshape(lens[0]), 1.0),
        "cache_v_w128": nrm(cshape(lens[0]), 1.0),
        "cache_k_w512": nrm(cshape(lens[1]), 1.0),
        "cache_v_w512": nrm(cshape(lens[1]), 1.0),
        "cache_k_w2048": nrm(cshape(lens[2]), 1.0),
        "cache_v_w2048": nrm(cshape(lens[2]), 1.0),
        "state_conv": nrm((L, DEC_BATCH, CONV_WIDTH - 1, CONV_CH), 0.5),
        "ffn1_norm": gain((L, D_MODEL)),
        "ffn1_w_in": nrm((L, D_MODEL, 2 * D_FF), D_MODEL ** -0.5),
        "ffn1_w_out": nrm((L, D_FF, D_MODEL), D_FF ** -0.5),
        "mix_norm": gain((L, D_MODEL)),
        "w_in": nrm((L, D_MODEL, IN_WIDTH), D_MODEL ** -0.5),
        "b_gate": nrm((L, 2 * D_MODEL), 0.02),
        "q_norm": gain((L, N_HEADS, HEAD_DIM)),
        "k_norm": gain((L, N_HEADS, HEAD_DIM)),
        "conv_w": nrm((L, CONV_WIDTH, CONV_CH), CONV_WIDTH ** -0.5),
        "conv_b": nrm((L, CONV_CH), 0.02),
        "conv_ln_g": gain((L, CONV_CH)),
        "conv_ln_b": nrm((L, CONV_CH), 0.02),
        "w_conv_out": nrm((L, CONV_CH, D_MODEL), CONV_CH ** -0.5),
        "w_attn_out": nrm((L, ATTN_OUT_WIDTH, D_MODEL), ATTN_OUT_WIDTH ** -0.5),
        "w_out": nrm((L, D_MODEL, D_MODEL), D_MODEL ** -0.5),
        "ffn2_norm": gain((L, D_MODEL)),
        "ffn2_w_in": nrm((L, D_MODEL, 2 * D_FF), D_MODEL ** -0.5),
        "ffn2_w_out": nrm((L, D_FF, D_MODEL), D_FF ** -0.5),
    }


def reference(x_prompt, x_sample, cache_k_w128, cache_v_w128, cache_k_w512, cache_v_w512, cache_k_w2048, cache_v_w2048,
              state_conv, ffn1_norm, ffn1_w_in, ffn1_w_out, mix_norm, w_in, b_gate, q_norm, k_norm, conv_w, conv_b,
              conv_ln_g, conv_ln_b, w_conv_out, w_attn_out, w_out, ffn2_norm, ffn2_w_in, ffn2_w_out):
    t = x_prompt.shape[1]
    s_len = x_sample.shape[1]
    pos_p = jnp.arange(t)
    pos_s = PAST_LEN + jnp.arange(s_len)
    cache_k = (cache_k_w128, cache_k_w512, cache_k_w2048)
    cache_v = (cache_v_w128, cache_v_w512, cache_v_w2048)
    new_k_p = [[] for _ in range(N_GROUPS)]
    new_v_p = [[] for _ in range(N_GROUPS)]
    new_k_s = [[] for _ in range(N_GROUPS)]
    new_v_s = [[] for _ in range(N_GROUPS)]
    new_conv_p, new_conv_s = [], []
    xp, xs = x_prompt, x_sample
    for l in range(DEPTH):
        xp = xp + 0.5 * swiglu_ffn(rmsnorm(xp, ffn1_norm[l]), ffn1_w_in[l], ffn1_w_out[l])
        xs = xs + 0.5 * swiglu_ffn(rmsnorm(xs, ffn1_norm[l]), ffn1_w_in[l], ffn1_w_out[l])
        hp = rmsnorm(xp, mix_norm[l])
        hs = rmsnorm(xs, mix_norm[l])
        up, qp, kp, vp, gp = mix_project(hp, pos_p, w_in[l], b_gate[l], q_norm[l], k_norm[l])
        us, qs, ks, vs, gs = mix_project(hs, pos_s, w_in[l], b_gate[l], q_norm[l], k_norm[l])
        conv_in_p = jnp.concatenate([jnp.zeros((up.shape[0], CONV_WIDTH - 1, CONV_CH), up.dtype), up], axis=1)
        conv_in_s = jnp.concatenate([state_conv[l].astype(us.dtype), us], axis=1)
        a_p = conv_branch(conv_in_p, conv_w[l], conv_b[l], conv_ln_g[l], conv_ln_b[l], w_conv_out[l])
        a_s = conv_branch(conv_in_s, conv_w[l], conv_b[l], conv_ln_g[l], conv_ln_b[l], w_conv_out[l])
        new_conv_p.append(conv_in_p[:, -(CONV_WIDTH - 1):])
        new_conv_s.append(conv_in_s[:, -(CONV_WIDTH - 1):])
        b_p = dilated_attention_prompt(qp, kp, vp)
        k_full, v_full = [], []
        for g, w in enumerate(WINDOWS):
            hsl = slice(g * HEADS_PER_GROUP, (g + 1) * HEADS_PER_GROUP)
            kf = jnp.concatenate([cache_k[g][l].astype(ks.dtype), ks[:, :, hsl]], axis=1)
            vf = jnp.concatenate([cache_v[g][l].astype(vs.dtype), vs[:, :, hsl]], axis=1)
            k_full.append(kf)
            v_full.append(vf)
            keep_p = min(w, t)
            keep_s = min(w, PAST_LEN + s_len)
            new_k_p[g].append(kp[:, t - keep_p:, hsl])
            new_v_p[g].append(vp[:, t - keep_p:, hsl])
            new_k_s[g].append(kf[:, kf.shape[1] - keep_s:])
            new_v_s[g].append(vf[:, vf.shape[1] - keep_s:])
        b_s = dilated_attention_sample(qs, k_full, v_full)
        xp = xp + merge_branches(a_p, b_p, gp, w_attn_out[l], w_out[l])
        xs = xs + merge_branches(a_s, b_s, gs, w_attn_out[l], w_out[l])
        xp = xp + 0.5 * swiglu_ffn(rmsnorm(xp, ffn2_norm[l]), ffn2_w_in[l], ffn2_w_out[l])
        xs = xs + 0.5 * swiglu_ffn(rmsnorm(xs, ffn2_norm[l]), ffn2_w_in[l], ffn2_w_out[l])
    return (xp, xs,
            jnp.stack(new_k_p[0]), jnp.stack(new_v_p[0]), jnp.stack(new_k_p[1]), jnp.stack(new_v_p[1]),
            jnp.stack(new_k_p[2]), jnp.stack(new_v_p[2]), jnp.stack(new_conv_p),
            jnp.stack(new_k_s[0]), jnp.stack(new_v_s[0]), jnp.stack(new_k_s[1]), jnp.stack(new_v_s[1]),
            jnp.stack(new_k_s[2]), jnp.stack(new_v_s[2]), jnp.stack(new_conv_s))
```

```cpp
#include <hip/hip_runtime.h>
#include <cstdio>
#include <cstdint>
namespace pg8 {
#define PG8_LAS __attribute__((address_space(3)))
typedef unsigned short bf16_t;
typedef short bf16x8 __attribute__((ext_vector_type(8)));
typedef float f32x4 __attribute__((ext_vector_type(4)));
typedef unsigned u32x4 __attribute__((ext_vector_type(4)));
constexpr int BM = 256, BK = 64, HALF = 128, HTB = HALF * BK * 2  , STAGE_BYTES = 8 * HTB, NXCD = 8, WGM = 8;

__host__ __device__ __forceinline__ int lds_byte(int r, int c) { const int st = (r >> 4) * 2 + (c >> 5), rr = r & 15, cc = c & 31, ob = rr * 64 + cc * 2; return st * 1024 + (ob ^ (((ob >> 9) & 1) << 5)); }
__host__ __device__ __forceinline__ void stage_rc(int b, int& R, int& C) { const int st = b / 1024, sb = b % 1024, swz = sb ^ (((sb >> 9) & 1) << 5); R = (st >> 1) * 16 + swz / 64; C = (st & 1) * 32 + (swz % 64) / 2; }
__host__ __device__ __forceinline__ int perm32(int rho) { const int n = rho >> 4, i = rho & 15; return 8 * (i >> 2) + 4 * n + (i & 3); }

struct Unit { int pm, pn; };
struct Gemm { const bf16_t* A; const bf16_t* Bt; int M, N, K; };

struct StaticOrder {
    int nM, nN, nwg, G, c;
    __host__ __device__ void init(int M, int N, int G_, int c_) { nM = M / BM; nN = N / BM; nwg = nM * nN; G = G_; c = c_; }
    __host__ __device__ bool next(int i, Unit& u) const {
        const long L = (long)i * G + c; if (L >= nwg) return false;
        int wgid = (int)L; { const int q = nwg / NXCD, r = nwg % NXCD, xcd = wgid % NXCD, off = wgid / NXCD; wgid = (xcd < r ? xcd * (q + 1) : r * (q + 1) + (xcd - r) * q) + off; }
        const int nig = WGM * nN, gid = wgid / nig, fm = gid * WGM, gsz = (nM - fm) < WGM ? (nM - fm) : WGM;
        u.pm = fm + ((wgid % nig) % gsz); u.pn = (wgid % nig) / gsz; return true;
    }
    __device__ __forceinline__ void a_ready(const Unit&) const {}
    __device__ __forceinline__ void done(const Unit&) const {}
};

__device__ __forceinline__ unsigned cvt_pk_bf16(float lo, float hi) { unsigned r; asm volatile("v_cvt_pk_bf16_f32 %0, %1, %2" : "=v"(r) : "v"(lo), "v"(hi)); return r; }
typedef float f32x2 __attribute__((ext_vector_type(2)));
typedef unsigned u32x2 __attribute__((ext_vector_type(2)));
constexpr float NEPS = 1e-6f;
__device__ __forceinline__ float sigmoid_f(float x) { return __builtin_amdgcn_rcpf(1.f + __builtin_amdgcn_exp2f(-1.4426950408889634f * x)); }
__device__ __forceinline__ float silu_f(float x) { return x * sigmoid_f(x); }
__device__ __forceinline__ float bf2f(unsigned short h) { return __builtin_bit_cast(float, (unsigned)h << 16); }
__device__ __forceinline__ float bflo(unsigned w) { return __builtin_bit_cast(float, w << 16); }
__device__ __forceinline__ float bfhi(unsigned w) { return __builtin_bit_cast(float, w & 0xffff0000u); }

struct EpiSwiGLU {
    static constexpr bool PERM = false, AFTER_DRAIN = false;
    const float* rss; bf16_t* O;
    __device__ __forceinline__ void operator()(const f32x4 (&acc)[2][2][4][2], const Unit& u, int wr, int wc, int fr, int fq) const {
        const int row0 = u.pm * BM + wr * 64 + fr, col0 = u.pn * 128 + wc * 32 + 8 * fq;
#pragma unroll
        for (int ai = 0; ai < 2; ++ai)
#pragma unroll
            for (int m = 0; m < 4; ++m) {
                const int row = row0 + ai * HALF + m * 16;
                const float r = __builtin_amdgcn_rsqf(rss[row] * (1.f / 1024.f) + NEPS);
                float o[8];
#pragma unroll
                for (int n = 0; n < 2; ++n)
#pragma unroll
                    for (int e = 0; e < 4; ++e) o[4 * n + e] = silu_f(acc[ai][0][m][n][e] * r) * (acc[ai][1][m][n][e] * r);
                u32x4 w; w.x = cvt_pk_bf16(o[0], o[1]); w.y = cvt_pk_bf16(o[2], o[3]); w.z = cvt_pk_bf16(o[4], o[5]); w.w = cvt_pk_bf16(o[6], o[7]);
                *(u32x4*)(O + (size_t)row * 2816 + col0) = w;
            }
    }
};

template <bool NEXT> struct EpiResid {
    static constexpr bool PERM = false, AFTER_DRAIN = false;
    const float* base_p; const float* base_s; float* out; bf16_t* outb; float* rss; float alpha;
    __device__ __forceinline__ void operator()(const f32x4 (&acc)[2][2][4][2], const Unit& u, int wr, int wc, int fr, int fq) const {
        const int row0 = u.pm * BM + wr * 64 + fr, col0 = u.pn * BM + wc * 32 + 8 * fq;
        const float* base = (u.pm < 64) ? base_p : base_s;
#pragma unroll
        for (int ai = 0; ai < 2; ++ai)
#pragma unroll
            for (int m = 0; m < 4; ++m) {
                const int row = row0 + ai * HALF + m * 16; float ss = 0.f;
#pragma unroll
                for (int bj = 0; bj < 2; ++bj) {
                    const size_t off = (size_t)row * 1024 + col0 + bj * HALF;
                    const f32x4 b0 = *(const f32x4*)(base + off), b1 = *(const f32x4*)(base + off + 4);
                    const f32x4 v0 = b0 + acc[ai][bj][m][0] * alpha, v1 = b1 + acc[ai][bj][m][1] * alpha;
                    *(f32x4*)(out + off) = v0; *(f32x4*)(out + off + 4) = v1;
                    if (NEXT) {
                        u32x4 w; w.x = cvt_pk_bf16(v0[0], v0[1]); w.y = cvt_pk_bf16(v0[2], v0[3]); w.z = cvt_pk_bf16(v1[0], v1[1]); w.w = cvt_pk_bf16(v1[2], v1[3]);
                        *(u32x4*)(outb + off) = w;
                        ss += (v0[0] * v0[0] + v0[1] * v0[1]) + (v0[2] * v0[2] + v0[3] * v0[3]) + (v1[0] * v1[0] + v1[1] * v1[1]) + (v1[2] * v1[2] + v1[3] * v1[3]);
                    }
                }
                if (NEXT) { ss += __shfl_xor(ss, 16); ss += __shfl_xor(ss, 32); if (fq == 0) unsafeAtomicAdd(rss + row, ss); }
            }
    }
};

struct EpiGateA {
    static constexpr bool PERM = false, AFTER_DRAIN = false;
    const bf16_t* gates; float* tmp;
    __device__ __forceinline__ void operator()(const f32x4 (&acc)[2][2][4][2], const Unit& u, int wr, int wc, int fr, int fq) const {
        const int row0 = u.pm * BM + wr * 64 + fr, col0 = u.pn * BM + wc * 32 + 8 * fq;
#pragma unroll
        for (int ai = 0; ai < 2; ++ai)
#pragma unroll
            for (int m = 0; m < 4; ++m) {
                const int row = row0 + ai * HALF + m * 16;
#pragma unroll
                for (int bj = 0; bj < 2; ++bj) {
                    const int c = col0 + bj * HALF;
                    const u32x4 g = *(const u32x4*)(gates + (size_t)row * 2048 + c);
                    f32x4 v0 = acc[ai][bj][m][0], v1 = acc[ai][bj][m][1];
                    v0[0] *= bflo(g.x); v0[1] *= bfhi(g.x); v0[2] *= bflo(g.y); v0[3] *= bfhi(g.y);
                    v1[0] *= bflo(g.z); v1[1] *= bfhi(g.z); v1[2] *= bflo(g.w); v1[3] *= bfhi(g.w);
                    *(f32x4*)(tmp + (size_t)row * 1024 + c) = v0; *(f32x4*)(tmp + (size_t)row * 1024 + c + 4) = v1;
                }
            }
    }
};
struct EpiGateB {
    static constexpr bool PERM = false, AFTER_DRAIN = false;
    const bf16_t* gates; const float* tmp; bf16_t* mix;
    __device__ __forceinline__ void operator()(const f32x4 (&acc)[2][2][4][2], const Unit& u, int wr, int wc, int fr, int fq) const {
        const int row0 = u.pm * BM + wr * 64 + fr, col0 = u.pn * BM + wc * 32 + 8 * fq;
#pragma unroll
        for (int ai = 0; ai < 2; ++ai)
#pragma unroll
            for (int m = 0; m < 4; ++m) {
                const int row = row0 + ai * HALF + m * 16;
#pragma unroll
                for (int bj = 0; bj < 2; ++bj) {
                    const int c = col0 + bj * HALF;
                    const u32x4 g = *(const u32x4*)(gates + (size_t)row * 2048 + 1024 + c);
                    const f32x4 t0 = *(const f32x4*)(tmp + (size_t)row * 1024 + c), t1 = *(const f32x4*)(tmp + (size_t)row * 1024 + c + 4);
                    f32x4 v0 = acc[ai][bj][m][0], v1 = acc[ai][bj][m][1];
                    v0[0] = t0[0] + v0[0] * bflo(g.x); v0[1] = t0[1] + v0[1] * bfhi(g.x); v0[2] = t0[2] + v0[2] * bflo(g.y); v0[3] = t0[3] + v0[3] * bfhi(g.y);
                    v1[0] = t1[0] + v1[0] * bflo(g.z); v1[1] = t1[1] + v1[1] * bfhi(g.z); v1[2] = t1[2] + v1[2] * bflo(g.w); v1[3] = t1[3] + v1[3] * bfhi(g.w);
                    u32x4 w; w.x = cvt_pk_bf16(v0[0], v0[1]); w.y = cvt_pk_bf16(v0[2], v0[3]); w.z = cvt_pk_bf16(v1[0], v1[1]); w.w = cvt_pk_bf16(v1[2], v1[3]);
                    *(u32x4*)(mix + (size_t)row * 1024 + c) = w;
                }
            }
    }
};

struct EpiIn {
    static constexpr bool PERM = false, AFTER_DRAIN = false;
    const float* rss; bf16_t *U, *Q, *G; const float *b_gate, *qk_norm, *rot; float* out;
    static constexpr size_t O_KP0 = 17301504;
    __device__ __forceinline__ void operator()(const f32x4 (&acc)[2][2][4][2], const Unit& u, int wr, int wc, int fr, int fq) const {
        const int row0 = u.pm * BM + wr * 64 + fr; const int pn = u.pn; const bool samp = u.pm >= 64;
        if (pn < 4) {
            const int col0 = pn * 128 + wc * 32 + 8 * fq;
#pragma unroll
            for (int ai = 0; ai < 2; ++ai)
#pragma unroll
                for (int m = 0; m < 4; ++m) {
                    const int row = row0 + ai * HALF + m * 16; const float r = __builtin_amdgcn_rsqf(rss[row] * (1.f / 1024.f) + NEPS);
                    float o[8];
#pragma unroll
                    for (int n = 0; n < 2; ++n)
#pragma unroll
                        for (int e = 0; e < 4; ++e) o[4 * n + e] = (acc[ai][0][m][n][e] * r) * sigmoid_f(acc[ai][1][m][n][e] * r);
                    u32x4 w; w.x = cvt_pk_bf16(o[0], o[1]); w.y = cvt_pk_bf16(o[2], o[3]); w.z = cvt_pk_bf16(o[4], o[5]); w.w = cvt_pk_bf16(o[6], o[7]);
                    *(u32x4*)(U + (size_t)row * 512 + col0) = w;
                    float* cp = nullptr;
                    if (!samp) { const int t = row & 4095, b = row >> 12; if (t >= 4066) cp = out + 22806528 + ((size_t)(b * 30 + (t - 4066))) * 512 + col0; }
                    else { const int sr = row - 16384; cp = out + 199028736 + ((size_t)((sr >> 2) * 30 + 26 + (sr & 3))) * 512 + col0; }
                    if (cp) { *(f32x4*)cp = (f32x4){o[0], o[1], o[2], o[3]}; *(f32x4*)(cp + 4) = (f32x4){o[4], o[5], o[6], o[7]}; }
                }
        } else if (pn < 13) {
            const int kind = (pn - 4) / 3, g = (pn - 4) % 3;
            const int W = 128 << (2 * g);
            const int hcol = (4 * g + wc) * 64;
            int dim0[2][2];
#pragma unroll
            for (int n = 0; n < 2; ++n) { dim0[0][n] = (kind < 2 && fq < 2) ? 4 * fq + 8 * n : 8 * fq + 4 * n; dim0[1][n] = 32 + 8 * fq + 4 * n; }
            f32x4 gn[2][2];
            if (kind < 2) { const float* nw = qk_norm + kind * 768 + hcol;
#pragma unroll
                for (int bj = 0; bj < 2; ++bj)
#pragma unroll
                    for (int n = 0; n < 2; ++n) gn[bj][n] = *(const f32x4*)(nw + dim0[bj][n]); }
            bf16_t* dstb = Q + (size_t)kind * ((size_t)16896 * 768);
            size_t okp = 17301504, oks = 22867968;
            for (int gg = 0; gg < g; ++gg) { okp += (size_t)2 * 4 * (128 << (2 * gg)) * 256; oks += (size_t)2 * 128 * (128 << (2 * gg)) * 256; }
            if (kind == 2) { okp += (size_t)4 * W * 256; oks += (size_t)128 * W * 256; }
#pragma unroll
            for (int ai = 0; ai < 2; ++ai)
#pragma unroll
                for (int m = 0; m < 4; ++m) {
                    const int row = row0 + ai * HALF + m * 16; const float r = __builtin_amdgcn_rsqf(rss[row] * (1.f / 1024.f) + NEPS);
                    f32x4 v[2][2];
#pragma unroll
                    for (int bj = 0; bj < 2; ++bj)
#pragma unroll
                        for (int n = 0; n < 2; ++n) v[bj][n] = acc[ai][bj][m][n] * r;
                    int posidx, b, tt; float* cdst = nullptr;
                    if (!samp) { tt = row & 4095; b = row >> 12; posidx = tt; if (kind >= 1 && tt >= 4096 - W) cdst = out + okp + ((size_t)(b * W + (tt - (4096 - W))) * 4 + wc) * 64; }
                    else { const int sr = row - 16384; b = sr >> 2; tt = sr & 3; posidx = 4096 + tt; if (kind >= 1) cdst = out + oks + ((size_t)(b * W + (W - 4 + tt)) * 4 + wc) * 64; }
                    if (kind < 2) {
                        float ss = 0.f;
#pragma unroll
                        for (int bj = 0; bj < 2; ++bj)
#pragma unroll
                            for (int n = 0; n < 2; ++n) ss += (v[bj][n][0] * v[bj][n][0] + v[bj][n][1] * v[bj][n][1]) + (v[bj][n][2] * v[bj][n][2] + v[bj][n][3] * v[bj][n][3]);
                        ss += __shfl_xor(ss, 16); ss += __shfl_xor(ss, 32);
                        const float rn = __builtin_amdgcn_rsqf(ss * (1.f / 64.f) + NEPS);
#pragma unroll
                        for (int bj = 0; bj < 2; ++bj)
#pragma unroll
                            for (int n = 0; n < 2; ++n) v[bj][n] = v[bj][n] * rn * gn[bj][n];
                        if (fq < 2) {
                            const f32x4 cs = *(const f32x4*)(rot + (size_t)posidx * 16 + 4 * fq), sn = *(const f32x4*)(rot + (size_t)posidx * 16 + 8 + 4 * fq);
                            const f32x4 x1 = v[0][0], x2 = v[0][1];
                            v[0][0] = x1 * cs - x2 * sn; v[0][1] = x2 * cs + x1 * sn;
                        }
                        if (kind == 0) {
#pragma unroll
                            for (int bj = 0; bj < 2; ++bj)
#pragma unroll
                                for (int n = 0; n < 2; ++n) v[bj][n] = v[bj][n] * (0.125f * 1.4426950408889634f);
                        }
                    }
#pragma unroll
                    for (int bj = 0; bj < 2; ++bj)
#pragma unroll
                        for (int n = 0; n < 2; ++n) {
                            u32x2 w; w.x = cvt_pk_bf16(v[bj][n][0], v[bj][n][1]); w.y = cvt_pk_bf16(v[bj][n][2], v[bj][n][3]);
                            *(u32x2*)(dstb + (size_t)row * 768 + hcol + dim0[bj][n]) = w;
                            if (cdst) *(f32x4*)(cdst + dim0[bj][n]) = v[bj][n];
                        }
                }
        } else {
            const int col0 = (pn - 13) * 256 + wc * 32 + 8 * fq;
            f32x4 bv[2][2];
#pragma unroll
            for (int bj = 0; bj < 2; ++bj)
#pragma unroll
                for (int n = 0; n < 2; ++n) bv[bj][n] = *(const f32x4*)(b_gate + col0 + bj * HALF + 4 * n);
#pragma unroll
            for (int ai = 0; ai < 2; ++ai)
#pragma unroll
                for (int m = 0; m < 4; ++m) {
                    const int row = row0 + ai * HALF + m * 16; const float r = __builtin_amdgcn_rsqf(rss[row] * (1.f / 1024.f) + NEPS);
#pragma unroll
                    for (int bj = 0; bj < 2; ++bj) {
                        float o[8];
#pragma unroll
                        for (int n = 0; n < 2; ++n)
#pragma unroll
                            for (int e = 0; e < 4; ++e) o[4 * n + e] = sigmoid_f(acc[ai][bj][m][n][e] * r + bv[bj][n][e]);
                        u32x4 w; w.x = cvt_pk_bf16(o[0], o[1]); w.y = cvt_pk_bf16(o[2], o[3]); w.z = cvt_pk_bf16(o[4], o[5]); w.w = cvt_pk_bf16(o[6], o[7]);
                        *(u32x4*)(G + (size_t)row * 2048 + col0 + bj * HALF) = w;
                    }
                }
        }
    }
};
template <class Epi, class Sched, bool ALIGN_EPI = false, bool SP2 = false>
__device__ __forceinline__ void gemm_phase(PG8_LAS unsigned char* lds, const Gemm g, const Sched& S, const Epi& E) {
    const int tid = threadIdx.x, wid = __builtin_amdgcn_readfirstlane(tid >> 6), lane = tid & 63, wr = wid >> 2, wc = wid & 3, fr = lane & 15, fq = lane >> 4;
    const int K = g.K, nt = K / BK;
    unsigned voffA[2], voffB[2];
#pragma unroll
    for (int i = 0; i < 2; ++i) { int R, C; stage_rc(tid * 16 + i * 8192, R, C); const int Rb = Epi::PERM ? ((R & ~31) + perm32(R & 31)) : R;
        voffA[i] = (unsigned)(R * K + C) * 2u; voffB[i] = (unsigned)(Rb * K + C) * 2u; }
    const size_t kstep = (size_t)(BK * 2);
    const size_t hstep = (size_t)HALF * K * 2;
    const size_t tstep = 2 * hstep;
    const unsigned ldsw = (unsigned)wid * 1024u;
    const int aoff = lds_byte(wr * 64 + fr, fq * 8), boff = lds_byte(wc * 32 + fr, fq * 8);
#define PG8_SA(b, h) (((b) * 2 + (h)) * HTB)
#define PG8_SB(b, h) ((4 + (b) * 2 + (h)) * HTB)
#define PG8_STAGE(bufoff, gbase, voff) do { _Pragma("unroll") for (int _i = 0; _i < 2; ++_i) \
        __builtin_amdgcn_global_load_lds((const unsigned*)((const char*)(gbase) + (voff)[_i]), (PG8_LAS unsigned*)(lds + (bufoff) + ldsw + _i * 8192), 16, 0, 0); } while (0)
#define PG8_LDA(dst, b, h) do { _Pragma("unroll") for (int m = 0; m < 4; ++m) _Pragma("unroll") for (int k = 0; k < 2; ++k) dst[m][k] = *(const PG8_LAS bf16x8*)(lds + PG8_SA(b, h) + aoff + m * 2048 + k * 1024); } while (0)
#define PG8_LDB(dst, b, h) do { _Pragma("unroll") for (int n = 0; n < 2; ++n) _Pragma("unroll") for (int k = 0; k < 2; ++k) dst[n][k] = *(const PG8_LAS bf16x8*)(lds + PG8_SB(b, h) + boff + n * 2048 + k * 1024); } while (0)
#define PG8_MMA(ai, bj, At, Bt) do { __builtin_amdgcn_s_setprio(1); _Pragma("unroll") for (int m = 0; m < 4; ++m) _Pragma("unroll") for (int n = 0; n < 2; ++n) _Pragma("unroll") for (int k = 0; k < 2; ++k) \
        acc[ai][bj][m][n] = __builtin_amdgcn_mfma_f32_16x16x32_bf16(Bt[n][k], At[m][k], acc[ai][bj][m][n], 0, 0, 0); __builtin_amdgcn_s_setprio(0); } while (0)
#define PG8_WAIT_V(n) asm volatile("s_waitcnt vmcnt(" #n ")" ::: "memory")
#define PG8_WAIT_L(n) asm volatile("s_waitcnt lgkmcnt(" #n ")" ::: "memory")
#define PG8_BAR __builtin_amdgcn_s_barrier()
#define PG8_SCHED __builtin_amdgcn_sched_barrier(0)
    Unit cur, nxt; int ui = 0;
    if (!S.next(0, cur)) return;
    f32x4 acc[2][2][4][2];
#pragma unroll
    for (int a = 0; a < 2; ++a)
#pragma unroll
        for (int b = 0; b < 2; ++b)
#pragma unroll
            for (int m = 0; m < 4; ++m)
#pragma unroll
                for (int n = 0; n < 2; ++n) acc[a][b][m][n] = (f32x4){0.f, 0.f, 0.f, 0.f};
    bf16x8 At[4][2], B0[2][2], B1[2][2];
    const char* cA = (const char*)g.A + (size_t)cur.pm * tstep; const char* cB = (const char*)g.Bt + (size_t)cur.pn * tstep;
    S.a_ready(cur);
    if constexpr (SP2) {
        PG8_STAGE(PG8_SB(0, 0), cB, voffB); PG8_STAGE(PG8_SB(0, 1), cB + hstep, voffB); PG8_STAGE(PG8_SA(0, 0), cA, voffA); PG8_STAGE(PG8_SA(0, 1), cA + hstep, voffA);
        if (wr == 1) PG8_BAR;
        PG8_WAIT_V(2); PG8_BAR;
        PG8_STAGE(PG8_SB(1, 0), cB + kstep, voffB); PG8_STAGE(PG8_SA(1, 0), cA + kstep, voffA); PG8_STAGE(PG8_SB(1, 1), cB + hstep + kstep, voffB);
        PG8_WAIT_V(6); PG8_BAR;
    } else {
        PG8_STAGE(PG8_SB(0, 0), cB, voffB); PG8_STAGE(PG8_SA(0, 0), cA, voffA); PG8_STAGE(PG8_SB(0, 1), cB + hstep, voffB); PG8_STAGE(PG8_SA(0, 1), cA + hstep, voffA);
        if (wr == 1) PG8_BAR;
        PG8_WAIT_V(4); PG8_BAR;
        PG8_STAGE(PG8_SB(1, 0), cB + kstep, voffB); PG8_STAGE(PG8_SA(1, 0), cA + kstep, voffA); PG8_STAGE(PG8_SB(1, 1), cB + hstep + kstep, voffB);
        PG8_WAIT_V(6); PG8_BAR;
    }
    for (;;) {
        const bool has_next = S.next(ui + 1, nxt);
        const char* nA = has_next ? (const char*)g.A + (size_t)nxt.pm * tstep : cA; const char* nB = has_next ? (const char*)g.Bt + (size_t)nxt.pn * tstep : cB;
        for (int t = 0; t < nt; t += 2) {
            const bool last = (t == nt - 2);
            const char* a1 = cA + (size_t)(t + 1) * kstep;
            const char* a2 = last ? nA : cA + (size_t)(t + 2) * kstep; const char* b2 = last ? nB : cB + (size_t)(t + 2) * kstep;
            const char* a3 = a2 + kstep; const char* b3 = b2 + kstep;
            if (last && has_next) S.a_ready(nxt);
            if constexpr (SP2) {
            PG8_LDB(B0, 0, 0); PG8_LDB(B1, 0, 1); PG8_SCHED; PG8_LDA(At, 0, 0); PG8_STAGE(PG8_SA(1, 1), a1 + hstep, voffA);
            PG8_WAIT_V(8); PG8_WAIT_L(0); PG8_BAR; PG8_MMA(0, 0, At, B0); PG8_MMA(0, 1, At, B1); PG8_BAR; PG8_SCHED;
            PG8_LDA(At, 0, 1); PG8_STAGE(PG8_SB(0, 0), b2, voffB); PG8_STAGE(PG8_SB(0, 1), b2 + hstep, voffB); PG8_STAGE(PG8_SA(0, 0), a2, voffA);
            PG8_WAIT_V(8); PG8_WAIT_L(0); PG8_BAR; PG8_MMA(1, 0, At, B0); PG8_MMA(1, 1, At, B1); PG8_BAR; PG8_SCHED;
            PG8_LDB(B0, 1, 0); PG8_LDB(B1, 1, 1); PG8_SCHED; PG8_LDA(At, 1, 0); PG8_STAGE(PG8_SA(0, 1), a2 + hstep, voffA);
            PG8_WAIT_V(8); PG8_WAIT_L(0); PG8_BAR; PG8_MMA(0, 0, At, B0); PG8_MMA(0, 1, At, B1); PG8_BAR; PG8_SCHED;
            PG8_LDA(At, 1, 1); PG8_STAGE(PG8_SB(1, 0), b3, voffB); PG8_STAGE(PG8_SB(1, 1), b3 + hstep, voffB); PG8_STAGE(PG8_SA(1, 0), a3, voffA);
            PG8_WAIT_V(8); PG8_WAIT_L(0); PG8_BAR; PG8_MMA(1, 0, At, B0); PG8_MMA(1, 1, At, B1); PG8_BAR; PG8_SCHED;
            } else {
            PG8_LDB(B0, 0, 0); PG8_SCHED; PG8_LDA(At, 0, 0); PG8_STAGE(PG8_SA(1, 1), a1 + hstep, voffA);
            PG8_WAIT_L(8); PG8_BAR; PG8_WAIT_L(0); PG8_MMA(0, 0, At, B0); PG8_BAR; PG8_SCHED;
            PG8_LDB(B1, 0, 1); PG8_STAGE(PG8_SB(0, 0), b2, voffB);
            PG8_BAR; PG8_WAIT_L(0); PG8_MMA(0, 1, At, B1); PG8_BAR;
            PG8_LDA(At, 0, 1); PG8_STAGE(PG8_SA(0, 0), a2, voffA);
            PG8_BAR; PG8_WAIT_L(0); PG8_MMA(1, 0, At, B0); PG8_BAR; PG8_SCHED;
            PG8_STAGE(PG8_SB(0, 1), b2 + hstep, voffB);
            PG8_WAIT_V(6); PG8_BAR; PG8_MMA(1, 1, At, B1); PG8_BAR;
            PG8_LDB(B0, 1, 0); PG8_SCHED; PG8_LDA(At, 1, 0); PG8_STAGE(PG8_SA(0, 1), a2 + hstep, voffA);
            PG8_WAIT_L(8); PG8_BAR; PG8_WAIT_L(0); PG8_MMA(0, 0, At, B0); PG8_BAR; PG8_SCHED;
            PG8_LDB(B1, 1, 1); PG8_STAGE(PG8_SB(1, 0), b3, voffB);
            PG8_BAR; PG8_WAIT_L(0); PG8_MMA(0, 1, At, B1); PG8_BAR;
            PG8_LDA(At, 1, 1); PG8_STAGE(PG8_SA(1, 0), a3, voffA);
            PG8_BAR; PG8_WAIT_L(0); PG8_MMA(1, 0, At, B0); PG8_BAR; PG8_SCHED;
            PG8_STAGE(PG8_SB(1, 1), b3 + hstep, voffB);
            PG8_WAIT_V(6); PG8_BAR; PG8_MMA(1, 1, At, B1); PG8_BAR;
            }
        }
        if constexpr (ALIGN_EPI) { if (wr == 0) PG8_BAR; }
        if constexpr (!Epi::AFTER_DRAIN) { E(acc, cur, wr, wc, fr, fq); S.done(cur); }
        if (!has_next) break;
#pragma unroll
        for (int a = 0; a < 2; ++a)
#pragma unroll
            for (int b = 0; b < 2; ++b)
#pragma unroll
                for (int m = 0; m < 4; ++m)
#pragma unroll
                    for (int n = 0; n < 2; ++n) acc[a][b][m][n] = (f32x4){0.f, 0.f, 0.f, 0.f};
        cur = nxt; cA = nA; cB = nB; ++ui;
        if constexpr (ALIGN_EPI) { if (wr == 1) PG8_BAR; }
    }
    PG8_WAIT_V(0);
    if constexpr (!ALIGN_EPI) { if (wr == 0) PG8_BAR; }
    PG8_BAR;
    if constexpr (Epi::AFTER_DRAIN) { E.fused(acc, cur, wr, wc, fr, fq, lds, wid, lane); S.done(cur); }
#undef PG8_SA
#undef PG8_SB
#undef PG8_STAGE
#undef PG8_LDA
#undef PG8_LDB
#undef PG8_MMA
#undef PG8_WAIT_V
#undef PG8_WAIT_L
#undef PG8_BAR
#undef PG8_SCHED
}
}

#ifndef MK_N_LAUNCHES
#define MK_N_LAUNCHES 1
#endif
constexpr int N_PHASES = 10;
constexpr int TP = 16384, TS = 512, T = TP + TS, D = 1024, FF = 2816, NIN = 5376;
#define GAS __attribute__((address_space(1)))
#define LAS __attribute__((address_space(3)))
typedef unsigned short bf16;
typedef float f32x4 __attribute__((ext_vector_type(4)));
typedef float f32x16 __attribute__((ext_vector_type(16)));
typedef short bf16x8 __attribute__((ext_vector_type(8)));
typedef unsigned v4u __attribute__((ext_vector_type(4)));
typedef unsigned v2u __attribute__((ext_vector_type(2)));

constexpr size_t al256(size_t x) { return (x + 255) & ~(size_t)255; }
constexpr size_t WS_BAR = 0, WS_BAR_BYTES = 16384;
constexpr size_t WS_RSS0 = WS_BAR_BYTES, WS_RSS1 = WS_RSS0 + al256((size_t)T * 4), WS_RSS2 = WS_RSS1 + al256((size_t)T * 4);
constexpr size_t WS_ROT = WS_RSS2 + al256((size_t)T * 4);
constexpr size_t WS_QKN = WS_ROT + al256((size_t)4100 * 16 * 4);
constexpr size_t WS_W1 = WS_QKN + al256((size_t)1536 * 4);
constexpr size_t WS_W2 = WS_W1 + (size_t)2 * FF * D * 2;
constexpr size_t WS_W3 = WS_W2 + (size_t)D * FF * 2;
constexpr size_t WS_W4A = WS_W3 + (size_t)NIN * D * 2;
constexpr size_t WS_W4B = WS_W4A + (size_t)D * 512 * 2;
constexpr size_t WS_W5 = WS_W4B + (size_t)D * 256 * 2;
constexpr size_t WS_W6 = WS_W5 + (size_t)D * D * 2;
constexpr size_t WS_W7 = WS_W6 + (size_t)2 * FF * D * 2;
constexpr size_t WS_XB = WS_W7 + (size_t)D * FF * 2;
constexpr size_t WS_ACT = WS_XB + (size_t)T * D * 2;
constexpr size_t WS_X1 = WS_ACT + (size_t)T * FF * 2;
constexpr size_t WS_X1B = WS_X1 + (size_t)T * D * 4;
constexpr size_t WS_U = WS_X1B + (size_t)T * D * 2;
constexpr size_t WS_Q = WS_U + (size_t)T * 512 * 2;
constexpr size_t WS_K = WS_Q + (size_t)T * 768 * 2;
constexpr size_t WS_V = WS_K + (size_t)T * 768 * 2;
constexpr size_t WS_G = WS_V + (size_t)T * 768 * 2;
constexpr size_t WS_CONVF = WS_G + (size_t)T * 2048 * 2;
constexpr size_t WS_OG = WS_CONVF + (size_t)T * 512 * 2;
constexpr size_t WS_ML = WS_OG + (size_t)3 * T * 256 * 2;
constexpr size_t WS_BATT = WS_ML + (size_t)3 * T * 8 * 4;
constexpr size_t WS_TMP = WS_BATT + (size_t)T * 256 * 2;
constexpr size_t WS_MIX = WS_TMP + (size_t)T * D * 4;
constexpr size_t WS_X2 = WS_MIX + (size_t)T * D * 2;
constexpr size_t WS_X2B = WS_X2 + (size_t)T * D * 4;
constexpr size_t WS_END = WS_X2B + (size_t)T * D * 2;

constexpr size_t O_CP = 22806528, O_KS0 = 22867968, O_CS = 199028736;

constexpr int LDS_BYTES = 131072 + 1024;

__device__ __forceinline__ unsigned f2bf(float f) { unsigned u = __builtin_bit_cast(unsigned, f); return (u + 0x7fffu + ((u >> 16) & 1u)) >> 16; }
__device__ __forceinline__ unsigned pk2(float lo, float hi) { return f2bf(lo) | (f2bf(hi) << 16); }
__device__ __forceinline__ float bf2f_g(unsigned short h) { return __builtin_bit_cast(float, (unsigned)h << 16); }
__device__ __forceinline__ float bfl(unsigned w) { return __builtin_bit_cast(float, w << 16); }
__device__ __forceinline__ float bfh(unsigned w) { return __builtin_bit_cast(float, w & 0xffff0000u); }
__device__ __forceinline__ float wave_sum(float v) {
#pragma unroll
    for (int o = 1; o < 64; o <<= 1) v += __shfl_xor(v, o);
    return v;
}

struct Args { const float* in[27]; float* out; unsigned char* ws; int ph_lo, ph_hi; };

__device__ __forceinline__ int perm32(int rho) { const int n = rho >> 4, i = rho & 15; return 8 * (i >> 2) + 4 * n + (i & 3); }
template <int MAP> __device__ __forceinline__ int src_col(int nd) {
    if (MAP == 0) return (nd & ~31) + perm32(nd & 31);
    const int pn = nd >> 8, w = nd & 255, bj = w >> 7, rem = w & 127, wc = rem >> 5, slot = rem & 31;
    if (MAP == 1) return bj * FF + pn * 128 + wc * 32 + perm32(slot);
    if (pn < 4) return bj * 512 + pn * 128 + wc * 32 + perm32(slot);
    if (pn < 13) {
        int dim;
        if (pn < 10 && bj == 0) { const int fq = (slot & 15) >> 2, n = slot >> 4, e = slot & 3; dim = fq < 2 ? 4 * fq + 8 * n + e : 8 * fq + 4 * n + e; }
        else dim = 32 * bj + perm32(slot);
        return 1024 + (pn - 4) * 256 + wc * 64 + dim;
    }
    return 3328 + (pn - 13) * 256 + bj * 128 + wc * 32 + perm32(slot);
}
template <int MAP> __device__ __forceinline__ void p0_transpose_item(const float* W, int K, int Ns, int Nd, bf16* WT, const float* gain, LAS float* scr, int item, int lane) {
    const int nblk = Nd / 32, kb = item / nblk, nb = item % nblk, k0 = 64 * kb, n0 = 32 * nb;
    const int sc = src_col<MAP>(n0 + (lane & 31));
#pragma unroll 8
    for (int i = 0; i < 32; ++i) { const int kk = 2 * i + (lane >> 5); float v = W[(size_t)(k0 + kk) * Ns + sc]; if (gain) v *= gain[k0 + kk]; scr[kk * 33 + (lane & 31)] = v; }
    asm volatile("s_waitcnt lgkmcnt(0)" ::: "memory");
    const int c = lane & 7;
#pragma unroll
    for (int j = 0; j < 4; ++j) { const int n = (lane >> 3) + 8 * j; const LAS float* s = scr + (8 * c) * 33 + n;
        v4u o; o.x = pk2(s[0 * 33], s[1 * 33]); o.y = pk2(s[2 * 33], s[3 * 33]); o.z = pk2(s[4 * 33], s[5 * 33]); o.w = pk2(s[6 * 33], s[7 * 33]);
        *(v4u*)(WT + (size_t)(n0 + n) * K + k0 + 8 * c) = o; }
    asm volatile("s_waitcnt lgkmcnt(0)" ::: "memory");
}
__device__ __forceinline__ void copy_shift(const float* src, float* dst, int nb, int rows, int rowf4, size_t gtid, size_t nthr) {
    const size_t per = (size_t)(rows - 4) * rowf4, n4 = (size_t)nb * per;
    const f32x4* s4 = (const f32x4*)src; f32x4* d4 = (f32x4*)dst;
    for (size_t i = gtid; i < n4; i += 4 * nthr) {
        f32x4 v[4]; size_t di[4];
#pragma unroll
        for (int k = 0; k < 4; ++k) { const size_t ii = i + k * nthr; if (ii < n4) { const size_t b = ii / per, off = ii - b * per; di[k] = b * (size_t)rows * rowf4 + off; v[k] = __builtin_nontemporal_load(s4 + di[k] + 4 * (size_t)rowf4); } }
#pragma unroll
        for (int k = 0; k < 4; ++k) { const size_t ii = i + k * nthr; if (ii < n4) __builtin_nontemporal_store(v[k], d4 + di[k]); }
    }
}

__device__ __forceinline__ void p0_prologue(const Args& a, LAS unsigned char* lds, int G, int bid, int tid) {
    const int wave = tid >> 6, lane = tid & 63;
    LAS float* scr = (LAS float*)(lds + wave * 16384);
    const int gw = bid * 8 + wave, NGW = G * 8;
    unsigned char* ws = a.ws;
    constexpr int I_IN = (D / 64) * (2 * FF / 32), I_OUT = (FF / 64) * (D / 32), I_3 = (D / 64) * (NIN / 32), I_4A = (512 / 64) * (D / 32), I_4B = (256 / 64) * (D / 32), I_5 = (D / 64) * (D / 32);
    constexpr int NITEMS = 2 * I_IN + 2 * I_OUT + I_3 + I_4A + I_4B + I_5;
    for (int it = gw; it < NITEMS; it += NGW) {
        int r = it;
        if (r < I_IN) { p0_transpose_item<1>(a.in[10], D, 2 * FF, 2 * FF, (bf16*)(ws + WS_W1), a.in[9], scr, r, lane); continue; } r -= I_IN;
        if (r < I_IN) { p0_transpose_item<1>(a.in[25], D, 2 * FF, 2 * FF, (bf16*)(ws + WS_W6), a.in[24], scr, r, lane); continue; } r -= I_IN;
        if (r < I_OUT) { p0_transpose_item<0>(a.in[11], FF, D, D, (bf16*)(ws + WS_W2), nullptr, scr, r, lane); continue; } r -= I_OUT;
        if (r < I_OUT) { p0_transpose_item<0>(a.in[26], FF, D, D, (bf16*)(ws + WS_W7), nullptr, scr, r, lane); continue; } r -= I_OUT;
        if (r < I_3) { p0_transpose_item<2>(a.in[13], D, NIN, NIN, (bf16*)(ws + WS_W3), a.in[12], scr, r, lane); continue; } r -= I_3;
        if (r < I_4A) { p0_transpose_item<0>(a.in[21], 512, D, D, (bf16*)(ws + WS_W4A), nullptr, scr, r, lane); continue; } r -= I_4A;
        if (r < I_4B) { p0_transpose_item<0>(a.in[22], 256, D, D, (bf16*)(ws + WS_W4B), nullptr, scr, r, lane); continue; } r -= I_4B;
        p0_transpose_item<0>(a.in[23], D, D, D, (bf16*)(ws + WS_W5), nullptr, scr, r, lane);
    }
    float* rss0 = (float*)(ws + WS_RSS0); float* rss1 = (float*)(ws + WS_RSS1); float* rss2 = (float*)(ws + WS_RSS2);
    bf16* XB = (bf16*)(ws + WS_XB);
    for (int m = gw; m < T; m += NGW) {
        const float* xr = (m < TP) ? a.in[0] + (size_t)m * D : a.in[1] + (size_t)(m - TP) * D;
        const f32x4* x4 = (const f32x4*)xr + lane; f32x4 v[4]; float s = 0.f;
#pragma unroll
        for (int j = 0; j < 4; ++j) { v[j] = x4[64 * j]; s += (v[j][0] * v[j][0] + v[j][1] * v[j][1]) + (v[j][2] * v[j][2] + v[j][3] * v[j][3]); }
        s = wave_sum(s);
        if (lane == 0) { rss0[m] = s; rss1[m] = 0.f; rss2[m] = 0.f; }
        v2u* o8 = (v2u*)(XB + (size_t)m * D) + lane;
#pragma unroll
        for (int j = 0; j < 4; ++j) { v2u w; w.x = pk2(v[j][0], v[j][1]); w.y = pk2(v[j][2], v[j][3]); o8[64 * j] = w; }
    }
    const size_t gtid = (size_t)bid * 512 + tid, nthr = (size_t)G * 512;
    float* rot = (float*)(ws + WS_ROT);
    for (size_t i = gtid; i < (size_t)4100 * 8; i += nthr) {
        const int p = (int)(i >> 3), f = (int)(i & 7); const int pos = p < 4096 ? p : 2048 + (p - 4096);
        const double inv = exp2(-(double)f * (18.931568569324174 / 8.0));
        const double rev = (double)pos * inv * 0.15915494309189535;
        const double fr = rev - rint(rev);
        const float ang = (float)(fr * 6.283185307179586);
        rot[(size_t)p * 16 + f] = __builtin_amdgcn_cosf((float)fr); rot[(size_t)p * 16 + 8 + f] = __builtin_amdgcn_sinf((float)fr); (void)ang;
    }
    { float* qkn = (float*)(ws + WS_QKN); for (size_t i = gtid; i < 1536; i += nthr) qkn[i] = i < 768 ? a.in[15][i] : a.in[16][i - 768]; }
    float* out = a.out; size_t oks = O_KS0;
#pragma unroll 1
    for (int g = 0; g < 3; ++g) { const int W = 128 << (2 * g);
        copy_shift(a.in[2 + 2 * g], out + oks, 128, W, 64, gtid, nthr); oks += (size_t)128 * W * 256;
        copy_shift(a.in[3 + 2 * g], out + oks, 128, W, 64, gtid, nthr); oks += (size_t)128 * W * 256; }
    copy_shift(a.in[8], out + O_CS, 128, 30, 128, gtid, nthr);
}

__device__ __forceinline__ int crow(int r, int hi) { return (r & 3) + 8 * (r >> 2) + 4 * hi; }
constexpr int KS_STRIDE = 144, VT_OFF = 384 * KS_STRIDE, VT_STRIDE = 776;
__device__ __forceinline__ void attn_prompt_unit(LAS unsigned char* lds, const bf16* Q, const bf16* Kb, const bf16* Vb, bf16* OG, float* ML, int unit, int tid) {
    const int b = unit / 192; int rem = unit % 192; const int g = rem / 64; rem %= 64; const int h = rem / 16, x = rem % 16;
    const int dsh = 2 * g, d = 1 << dsh, nblk = 16 >> dsh, r = x / nblk, qb = x % nblk, i0 = qb * 256;
    const int hc = (4 * g + h) * 64;
    __syncthreads();
    if (tid < 384) {
        const int s = tid, i = i0 - 128 + s;
        v4u kv[8], vv[8];
        if (i >= 0) { const size_t row = (size_t)b * 4096 + (size_t)i * d + r; const v4u* kp = (const v4u*)(Kb + row * 768 + hc); const v4u* vp = (const v4u*)(Vb + row * 768 + hc);
#pragma unroll
            for (int j = 0; j < 8; ++j) { kv[j] = kp[j]; vv[j] = vp[j]; } }
        else {
#pragma unroll
            for (int j = 0; j < 8; ++j) { kv[j] = (v4u){0u, 0u, 0u, 0u}; vv[j] = (v4u){0u, 0u, 0u, 0u}; } }
#pragma unroll
        for (int j = 0; j < 8; ++j) *(LAS v4u*)(lds + s * KS_STRIDE + 16 * j) = kv[j];
#pragma unroll
        for (int j = 0; j < 8; ++j)
#pragma unroll
            for (int e = 0; e < 4; ++e) { const unsigned w = vv[j][e];
                *(LAS unsigned short*)(lds + VT_OFF + (8 * j + 2 * e) * VT_STRIDE + s * 2) = (unsigned short)(w & 0xffffu);
                *(LAS unsigned short*)(lds + VT_OFF + (8 * j + 2 * e + 1) * VT_STRIDE + s * 2) = (unsigned short)(w >> 16); }
    }
    __syncthreads();
    const int w = tid >> 6, lane = tid & 63, ql = lane & 31, hi = lane >> 5;
    const int iq = i0 + 32 * w + ql; const size_t qrow = (size_t)b * 4096 + (size_t)iq * d + r;
    bf16x8 qf[4];
#pragma unroll
    for (int kk = 0; kk < 4; ++kk) qf[kk] = *(const bf16x8*)(Q + qrow * 768 + hc + 16 * kk + 8 * hi);
    f32x16 S[5];
#pragma unroll
    for (int j = 0; j < 5; ++j) {
#pragma unroll
        for (int e = 0; e < 16; ++e) S[j][e] = 0.f;
#pragma unroll
        for (int kk = 0; kk < 4; ++kk) { const bf16x8 af = *(const LAS bf16x8*)(lds + (32 * (w + j) + ql) * KS_STRIDE + (16 * kk + 8 * hi) * 2);
            S[j] = __builtin_amdgcn_mfma_f32_32x32x16_bf16(af, qf[kk], S[j], 0, 0, 0); }
    }
    float mx = -INFINITY;
#pragma unroll
    for (int j = 0; j < 5; ++j)
#pragma unroll
        for (int e = 0; e < 16; ++e) { const int kl = crow(e, hi); const int rel = 128 + ql - 32 * j - kl; const int ik = i0 - 128 + 32 * (w + j) + kl;
            const bool valid = (rel >= 0) && (rel <= 128) && (ik >= 0);
            S[j][e] = valid ? S[j][e] : -INFINITY; mx = fmaxf(mx, S[j][e]); }
    mx = fmaxf(mx, __shfl_xor(mx, 32));
    float l = 0.f;
#pragma unroll
    for (int j = 0; j < 5; ++j)
#pragma unroll
        for (int e = 0; e < 16; ++e) { const float p = __builtin_amdgcn_exp2f(S[j][e] - mx); S[j][e] = p; l += p; }
    l += __shfl_xor(l, 32);
    f32x16 O[2];
#pragma unroll
    for (int e = 0; e < 16; ++e) { O[0][e] = 0.f; O[1][e] = 0.f; }
#pragma unroll
    for (int j = 0; j < 5; ++j)
#pragma unroll
        for (int c = 0; c < 2; ++c) {
            v4u pw; pw.x = pk2(S[j][8 * c + 0], S[j][8 * c + 1]); pw.y = pk2(S[j][8 * c + 2], S[j][8 * c + 3]); pw.z = pk2(S[j][8 * c + 4], S[j][8 * c + 5]); pw.w = pk2(S[j][8 * c + 6], S[j][8 * c + 7]);
            const bf16x8 pf = __builtin_bit_cast(bf16x8, pw);
            const int s0 = 32 * (w + j) + 16 * c + 4 * hi;
#pragma unroll
            for (int dt = 0; dt < 2; ++dt) { const int dim = 32 * dt + ql;
                const v2u lo = *(const LAS v2u*)(lds + VT_OFF + dim * VT_STRIDE + s0 * 2), hh = *(const LAS v2u*)(lds + VT_OFF + dim * VT_STRIDE + (s0 + 8) * 2);
                v4u vw; vw.x = lo.x; vw.y = lo.y; vw.z = hh.x; vw.w = hh.y;
                O[dt] = __builtin_amdgcn_mfma_f32_32x32x16_bf16(__builtin_bit_cast(bf16x8, vw), pf, O[dt], 0, 0, 0); }
        }
    const float inv = 1.f / l;
    bf16* og = OG + ((size_t)g * T + qrow) * 256 + h * 64;
#pragma unroll
    for (int dt = 0; dt < 2; ++dt)
#pragma unroll
        for (int q4 = 0; q4 < 4; ++q4) { v2u w2; w2.x = pk2(O[dt][4 * q4] * inv, O[dt][4 * q4 + 1] * inv); w2.y = pk2(O[dt][4 * q4 + 2] * inv, O[dt][4 * q4 + 3] * inv);
            *(v2u*)(og + 32 * dt + 8 * q4 + 4 * hi) = w2; }
    if (hi == 0) { float* ml = ML + (((size_t)g * T + qrow) * 4 + h) * 2; ml[0] = mx; ml[1] = l; }
}

__device__ __forceinline__ void attn_sample_task(const Args& a, const bf16* Q, const bf16* Kb, const bf16* Vb, bf16* OG, float* ML, int task, int lane) {
    const int b = task / 12, g = (task % 12) >> 2, s = task & 3;
    const int W = 128 << (2 * g), d = 1 << (2 * g);
    const float* ck = a.in[2 + 2 * g] + (size_t)b * W * 256 + lane * 4; const float* cv = a.in[3 + 2 * g] + (size_t)b * W * 256 + lane * 4;
    const size_t row = (size_t)TP + b * 4 + s; const int head = lane >> 4, dl = (lane & 15) * 4;
    const int hcol = (4 * g + head) * 64 + dl;
    float q[4]; { const v2u qw = *(const v2u*)(Q + row * 768 + hcol); q[0] = bfl(qw.x); q[1] = bfh(qw.x); q[2] = bfl(qw.y); q[3] = bfh(qw.y); }
    float m = -INFINITY, l = 0.f, o[4] = {0.f, 0.f, 0.f, 0.f};
#pragma unroll 1
    for (int j0 = 0; j0 < 136; j0 += 8) {
        f32x4 kk[8], vv[8];
#pragma unroll
        for (int jj = 0; jj < 8; ++jj) { const int j = j0 + jj; int idx = W + s - d * j; if (j > 128) idx = 0;
            if (idx >= W) { const size_t r2 = (size_t)TP + b * 4 + (idx - W); const v2u kw = *(const v2u*)(Kb + r2 * 768 + hcol), vw = *(const v2u*)(Vb + r2 * 768 + hcol);
                kk[jj] = (f32x4){bfl(kw.x), bfh(kw.x), bfl(kw.y), bfh(kw.y)}; vv[jj] = (f32x4){bfl(vw.x), bfh(vw.x), bfl(vw.y), bfh(vw.y)}; }
            else { kk[jj] = *(const f32x4*)(ck + (size_t)idx * 256); vv[jj] = *(const f32x4*)(cv + (size_t)idx * 256); } }
        float sc[8]; float cm = -INFINITY;
#pragma unroll
        for (int jj = 0; jj < 8; ++jj) { float t = (kk[jj][0] * q[0] + kk[jj][1] * q[1]) + (kk[jj][2] * q[2] + kk[jj][3] * q[3]);
            t += __shfl_xor(t, 1); t += __shfl_xor(t, 2); t += __shfl_xor(t, 4); t += __shfl_xor(t, 8);
            sc[jj] = (j0 + jj <= 128) ? t : -INFINITY; cm = fmaxf(cm, sc[jj]); }
        const float mn = fmaxf(m, cm), scale = __builtin_amdgcn_exp2f(m - mn);
        l *= scale; o[0] *= scale; o[1] *= scale; o[2] *= scale; o[3] *= scale;
#pragma unroll
        for (int jj = 0; jj < 8; ++jj) { const float p = __builtin_amdgcn_exp2f(sc[jj] - mn); l += p; o[0] += p * vv[jj][0]; o[1] += p * vv[jj][1]; o[2] += p * vv[jj][2]; o[3] += p * vv[jj][3]; }
        m = mn;
    }
    const float inv = 1.f / l;
    v2u w2; w2.x = pk2(o[0] * inv, o[1] * inv); w2.y = pk2(o[2] * inv, o[3] * inv);
    *(v2u*)(OG + ((size_t)g * T + row) * 256 + head * 64 + dl) = w2;
    if ((lane & 15) == 0) { float* ml = ML + (((size_t)g * T + row) * 4 + head) * 2; ml[0] = m; ml[1] = l; }
}

template <int NTOK, bool SAMPLE> __device__ __forceinline__ void conv_unit(const Args& a, LAS unsigned char* lds, const bf16* U, bf16* CONVF, const float (&cw)[31], int unit, int tid) {
    const int c = tid; float win[NTOK + 30];
    size_t row0;
    if (!SAMPLE) { row0 = (size_t)unit * NTOK; const int t0 = (int)(row0 & 4095);
#pragma unroll
        for (int jr = 0; jr < NTOK + 30; ++jr) { const int t = t0 - 30 + jr; win[jr] = (t >= 0) ? bf2f_g(U[(row0 - 30 + jr) * 512 + c]) : 0.f; } }
    else { row0 = (size_t)TP + (size_t)unit * 4; const float* st = a.in[8] + (size_t)unit * 30 * 512 + c;
#pragma unroll
        for (int jr = 0; jr < 30; ++jr) win[jr] = st[jr * 512];
#pragma unroll
        for (int jr = 0; jr < NTOK; ++jr) win[30 + jr] = bf2f_g(U[(row0 + jr) * 512 + c]); }
    const float cb = a.in[18][c];
    LAS float* yb = (LAS float*)lds;
    __syncthreads();
#pragma unroll
    for (int t = 0; t < NTOK; ++t) { float y = cb;
#pragma unroll
        for (int j = 0; j < 31; ++j) y += cw[j] * win[t + j];
        yb[t * 512 + c] = y; }
    __syncthreads();
    const int w = tid >> 6, lane = tid & 63;
    constexpr int TPW = (NTOK + 7) / 8;
#pragma unroll
    for (int tt = 0; tt < TPW; ++tt) { const int t = w * TPW + tt;
        if (t < NTOK) {
            float y[8]; float s = 0.f;
#pragma unroll
            for (int i = 0; i < 8; ++i) { y[i] = yb[t * 512 + lane + 64 * i]; s += y[i]; }
            const float mu = wave_sum(s) * (1.f / 512.f); float q = 0.f;
#pragma unroll
            for (int i = 0; i < 8; ++i) { y[i] -= mu; q += y[i] * y[i]; }
            const float rstd = __builtin_amdgcn_rsqf(wave_sum(q) * (1.f / 512.f) + 1e-6f);
#pragma unroll
            for (int i = 0; i < 8; ++i) { const int cc = lane + 64 * i; const float z = y[i] * rstd * a.in[19][cc] + a.in[20][cc];
                const float sw = z * __builtin_amdgcn_rcpf(1.f + __builtin_amdgcn_exp2f(-1.4426950408889634f * z));
                CONVF[(row0 + t) * 512 + cc] = (bf16)f2bf(sw); }
        }
    }
}

__device__ __forceinline__ void combine_groups(const bf16* OG, const float* ML, bf16* BATT, size_t gtid, size_t nthr) {
    for (size_t i = gtid; i < (size_t)T * 32; i += nthr) {
        const size_t row = i >> 5; const int c8 = (int)(i & 31), h = c8 >> 3;
        float mg[3], lg[3]; v4u og[3];
#pragma unroll
        for (int g = 0; g < 3; ++g) { const float* ml = ML + (((size_t)g * T + row) * 4 + h) * 2; mg[g] = ml[0]; lg[g] = ml[1]; og[g] = *(const v4u*)(OG + ((size_t)g * T + row) * 256 + c8 * 8); }
        const float M = fmaxf(mg[0], fmaxf(mg[1], mg[2]));
        float wg[3], ws = 0.f;
#pragma unroll
        for (int g = 0; g < 3; ++g) { wg[g] = __builtin_amdgcn_exp2f(mg[g] - M) * lg[g]; ws += wg[g]; }
        const float inv = 1.f / ws; float o[8];
#pragma unroll
        for (int e = 0; e < 8; ++e) o[e] = 0.f;
#pragma unroll
        for (int g = 0; g < 3; ++g) { const float wn = wg[g] * inv;
#pragma unroll
            for (int e = 0; e < 4; ++e) { o[2 * e] += wn * bfl(og[g][e]); o[2 * e + 1] += wn * bfh(og[g][e]); } }
        v4u w; w.x = pk2(o[0], o[1]); w.y = pk2(o[2], o[3]); w.z = pk2(o[4], o[5]); w.w = pk2(o[6], o[7]);
        *(v4u*)(BATT + row * 256 + c8 * 8) = w;
    }
}

#define XB_TMO      128
#define XB_XCNT(j)  (256  + 64 * (j))
#define XB_XSUB(j)  (1280 + 64 * (j))
#define XB_XGEN(j)  (2304 + 64 * (j))
#define XB_TOP      3328
#define XB_TOPGEN   3392
#define XCD_BAR_WORDS 3456
#define XB_SPIN_CAP (1u << 18)

__device__ __forceinline__ unsigned xb_ld(unsigned* p)              { return __hip_atomic_load(p, __ATOMIC_RELAXED, __HIP_MEMORY_SCOPE_AGENT); }
__device__ __forceinline__ unsigned xb_add(unsigned* p, unsigned v) { return __hip_atomic_fetch_add(p, v, __ATOMIC_RELAXED, __HIP_MEMORY_SCOPE_AGENT); }
__device__ __forceinline__ unsigned xb_xcc_id() { return (unsigned)__builtin_amdgcn_s_getreg((3 << 11) | 20) & 0xFu; }
#define XB_SPIN(cond, bar) do { unsigned _sp = 0; while (cond) { __builtin_amdgcn_s_sleep(1); \
    if ((++_sp & 255u) == 0u) { if (xb_ld(&(bar)[XB_TMO])) break; if (_sp > XB_SPIN_CAP) { atomicAdd(&(bar)[XB_TMO], 1u); break; } } } } while (0)

struct XcdBarrier {
    unsigned* bar; unsigned x;
    volatile LAS unsigned* st;
};

__device__ __forceinline__ XcdBarrier xcd_barrier_post(unsigned* bar, volatile LAS unsigned* st) {
    XcdBarrier b; b.bar = bar; b.x = xb_xcc_id(); b.st = st;
    if (threadIdx.x == 0) (void)xb_add(&bar[XB_XCNT(b.x)], 1u);
    return b;
}
__device__ __forceinline__ void xcd_barrier_complete(unsigned* bar, unsigned x, unsigned& nloc, unsigned& nx) {
    const unsigned G = gridDim.x * gridDim.y * gridDim.z;
    unsigned sum, cnt, mine, sp = 0u;
    for (;;) {
        sum = 0u; cnt = 0u; mine = 0u;
#pragma unroll
        for (unsigned j = 0; j < 16; ++j) { const unsigned c = xb_ld(&bar[XB_XCNT(j)]); sum += c; cnt += (c > 0u) ? 1u : 0u; mine = (j == x) ? c : mine; }
        if (sum == G) break;
        __builtin_amdgcn_s_sleep(1);
        if ((++sp & 255u) == 0u) { if (xb_ld(&bar[XB_TMO])) break; if (sp > XB_SPIN_CAP) { atomicAdd(&bar[XB_TMO], 1u); break; } }
    }
    nloc = mine > 0u ? mine : 1u; nx = cnt > 0u ? cnt : 1u;
}

__device__ __forceinline__ void xcd_barrier(const XcdBarrier& b) {
    asm volatile("s_waitcnt vmcnt(0)" ::: "memory");
    __syncthreads();
    if (threadIdx.x == 0) {
        unsigned* bar = b.bar;
        __builtin_amdgcn_s_waitcnt(0);
        unsigned nloc = b.st[0], nx = b.st[1];
        if (nloc == 0u) { xcd_barrier_complete(bar, b.x, nloc, nx); b.st[0] = nloc; b.st[1] = nx; }
        const unsigned old = xb_add(&bar[XB_XSUB(b.x)], 1u);
        const unsigned gen = old / nloc;
        if (old + 1u == (gen + 1u) * nloc) {
            __builtin_amdgcn_fence(__ATOMIC_RELEASE, "agent");
            asm volatile("s_waitcnt vmcnt(0)" ::: "memory");
            const unsigned og = xb_add(&bar[XB_TOP], 1u);
            const unsigned tg = og / nx;
            if (og + 1u == (tg + 1u) * nx) xb_add(&bar[XB_TOPGEN], 1u);
            else XB_SPIN(xb_ld(&bar[XB_TOPGEN]) == tg, bar);
            __builtin_amdgcn_fence(__ATOMIC_ACQUIRE, "agent");
            xb_add(&bar[XB_XGEN(b.x)], 1u);
            asm volatile("s_waitcnt vmcnt(0)" ::: "memory");
        } else {
            XB_SPIN(xb_ld(&bar[XB_XGEN(b.x)]) == gen, bar);
            __builtin_amdgcn_fence(__ATOMIC_ACQUIRE, "agent");
            asm volatile("s_waitcnt vmcnt(0)" ::: "memory");
        }
    }
    __syncthreads();
}
__global__ void __launch_bounds__(512, 2) mk_fwd(Args args) {
    extern __shared__ __attribute__((aligned(16))) unsigned char lds_raw[];
    LAS unsigned char* lds = (LAS unsigned char*)lds_raw;
    const int tid = threadIdx.x, G = gridDim.x, bid = blockIdx.x;
    unsigned char* ws = args.ws;
    const int lo = args.ph_lo, hi = args.ph_hi;
#define IN(k) (lo <= (k) && (k) < hi)
#define SEAM(k) do { if (IN(k) && IN((k) + 1)) { xcd_barrier(bar); } } while (0)
    volatile LAS unsigned* MISC = (volatile LAS unsigned*)(lds + 131072);
    if (tid < 64) MISC[tid] = 0u;
    __syncthreads();
    XcdBarrier bar; bar.bar = (unsigned*)(ws + WS_BAR); bar.x = 0; bar.st = nullptr;
    if (hi - lo > 1) bar = xcd_barrier_post((unsigned*)(ws + WS_BAR), MISC + 8);
    float* rss0 = (float*)(ws + WS_RSS0); float* rss1 = (float*)(ws + WS_RSS1); float* rss2 = (float*)(ws + WS_RSS2);
    bf16* XB = (bf16*)(ws + WS_XB); bf16* ACT = (bf16*)(ws + WS_ACT); float* X1 = (float*)(ws + WS_X1); bf16* X1B = (bf16*)(ws + WS_X1B);
    bf16* Ub = (bf16*)(ws + WS_U); bf16* Qb = (bf16*)(ws + WS_Q); bf16* Kb = (bf16*)(ws + WS_K); bf16* Vb = (bf16*)(ws + WS_V); bf16* Gb = (bf16*)(ws + WS_G);
    bf16* CONVF = (bf16*)(ws + WS_CONVF); bf16* OG = (bf16*)(ws + WS_OG); float* ML = (float*)(ws + WS_ML); bf16* BATT = (bf16*)(ws + WS_BATT);
    float* TMP = (float*)(ws + WS_TMP); bf16* MIX = (bf16*)(ws + WS_MIX); float* X2 = (float*)(ws + WS_X2); bf16* X2B = (bf16*)(ws + WS_X2B);

    if (IN(0)) { p0_prologue(args, lds, G, bid, tid); }
    SEAM(0);
    if (IN(1)) {
        pg8::Gemm g{XB, (const bf16*)(ws + WS_W1), T, 2 * FF, D}; pg8::StaticOrder S; S.init(T, 2 * FF, G, bid);
        pg8::EpiSwiGLU E{rss0, ACT};
        pg8::gemm_phase<pg8::EpiSwiGLU, pg8::StaticOrder, true, true>(lds, g, S, E);
    }
    SEAM(1);
    if (IN(2)) {
        pg8::Gemm g{ACT, (const bf16*)(ws + WS_W2), T, D, FF}; pg8::StaticOrder S; S.init(T, D, G, bid);
        pg8::EpiResid<true> E{args.in[0], args.in[1] - (size_t)TP * D, X1, X1B, rss1, 0.5f};
        pg8::gemm_phase<pg8::EpiResid<true>, pg8::StaticOrder, true, true>(lds, g, S, E);
    }
    SEAM(2);
    if (IN(3)) {
        pg8::Gemm g{X1B, (const bf16*)(ws + WS_W3), T, NIN, D}; pg8::StaticOrder S; S.init(T, NIN, G, bid);
        pg8::EpiIn E{rss1, Ub, Qb, Gb, args.in[14], (const float*)(ws + WS_QKN), (const float*)(ws + WS_ROT), args.out};
        pg8::gemm_phase<pg8::EpiIn, pg8::StaticOrder, true, true>(lds, g, S, E);
    }
    SEAM(3);
    if (IN(4)) {
        for (int u = bid; u < 768; u += G) attn_prompt_unit(lds, Qb, Kb, Vb, OG, ML, u, tid);
        for (int u = bid; u < 192; u += G) attn_sample_task(args, Qb, Kb, Vb, OG, ML, u * 8 + (tid >> 6), tid & 63);
        float cw[31];
#pragma unroll
        for (int j = 0; j < 31; ++j) cw[j] = args.in[17][j * 512 + tid];
        for (int u = bid; u < 1024; u += G) conv_unit<16, false>(args, lds, Ub, CONVF, cw, u, tid);
        for (int u = bid; u < 128; u += G) conv_unit<4, true>(args, lds, Ub, CONVF, cw, u, tid);
    }
    SEAM(4);
    if (IN(5)) {
        combine_groups(OG, ML, BATT, (size_t)bid * 512 + tid, (size_t)G * 512);
        __syncthreads();
        pg8::Gemm g{CONVF, (const bf16*)(ws + WS_W4A), T, D, 512}; pg8::StaticOrder S; S.init(T, D, G, bid);
        pg8::EpiGateA E{Gb, TMP};
        pg8::gemm_phase<pg8::EpiGateA, pg8::StaticOrder, true, true>(lds, g, S, E);
    }
    SEAM(5);
    if (IN(6)) {
        pg8::Gemm g{BATT, (const bf16*)(ws + WS_W4B), T, D, 256}; pg8::StaticOrder S; S.init(T, D, G, bid);
        pg8::EpiGateB E{Gb, TMP, MIX};
        pg8::gemm_phase<pg8::EpiGateB, pg8::StaticOrder, true, true>(lds, g, S, E);
    }
    SEAM(6);
    if (IN(7)) {
        pg8::Gemm g{MIX, (const bf16*)(ws + WS_W5), T, D, D}; pg8::StaticOrder S; S.init(T, D, G, bid);
        pg8::EpiResid<true> E{X1, X1, X2, X2B, rss2, 1.0f};
        pg8::gemm_phase<pg8::EpiResid<true>, pg8::StaticOrder, true, true>(lds, g, S, E);
    }
    SEAM(7);
    if (IN(8)) {
        pg8::Gemm g{X2B, (const bf16*)(ws + WS_W6), T, 2 * FF, D}; pg8::StaticOrder S; S.init(T, 2 * FF, G, bid);
        pg8::EpiSwiGLU E{rss2, ACT};
        pg8::gemm_phase<pg8::EpiSwiGLU, pg8::StaticOrder, true, true>(lds, g, S, E);
    }
    SEAM(8);
    if (IN(9)) {
        pg8::Gemm g{ACT, (const bf16*)(ws + WS_W7), T, D, FF}; pg8::StaticOrder S; S.init(T, D, G, bid);
        pg8::EpiResid<false> E{X2, X2, args.out, nullptr, nullptr, 0.5f};
        pg8::gemm_phase<pg8::EpiResid<false>, pg8::StaticOrder, true, true>(lds, g, S, E);
    }
#undef IN
#undef SEAM
}

extern "C" void kernel_launch(void* const* d_in, const int* in_sizes, int n_in, void* d_out, int out_size, void* d_ws, size_t ws_size, hipStream_t stream) {
    static int grid = 0;
    if (grid == 0) {
        int dev = 0, cus = 0, per_cu = 0;
        if (n_in != 27 || ws_size < WS_END) { fprintf(stderr, "kernel_launch: unexpected n_in %d / ws %zu (need %zu)\n", n_in, ws_size, (size_t)WS_END); grid = -1; return; }
        (void)hipGetDevice(&dev);
        (void)hipDeviceGetAttribute(&cus, hipDeviceAttributeMultiprocessorCount, dev);
        if (hipFuncSetAttribute((const void*)mk_fwd, hipFuncAttributeMaxDynamicSharedMemorySize, LDS_BYTES) != hipSuccess) { fprintf(stderr, "kernel_launch: hipFuncSetAttribute failed\n"); grid = -1; return; }
        if (hipOccupancyMaxActiveBlocksPerMultiprocessor(&per_cu, (const void*)mk_fwd, 512, LDS_BYTES) != hipSuccess || per_cu < 1) { fprintf(stderr, "kernel_launch: occupancy query failed (%d)\n", per_cu); per_cu = 1; }
        (void)hipGetLastError();
        grid = cus;
        fprintf(stderr, "kernel_launch: cus %d per_cu %d grid %d\n", cus, per_cu, grid);
    }
    if (grid < 0) return;
    Args a{};
    for (int i = 0; i < 27; ++i) a.in[i] = (const float*)d_in[i];
    a.out = (float*)d_out; a.ws = (unsigned char*)d_ws;
#if MK_N_LAUNCHES == 1
    a.ph_lo = 0; a.ph_hi = N_PHASES;
    if (hipMemsetAsync((char*)d_ws + WS_BAR, 0, WS_BAR_BYTES, stream) != hipSuccess) { fprintf(stderr, "kernel_launch: memset failed\n"); return; }
    hipLaunchKernelGGL(mk_fwd, dim3(grid), dim3(512), LDS_BYTES, stream, a);
#else
    for (int p = 0; p < N_PHASES; ++p) { a.ph_lo = p; a.ph_hi = p + 1; hipLaunchKernelGGL(mk_fwd, dim3(grid), dim3(512), LDS_BYTES, stream, a); }
#endif
}
```

```cpp
#include <hip/hip_runtime.h>
#include <cstdio>
#include <cstdint>
namespace pg8 {
#define PG8_LAS __attribute__((address_space(3)))
typedef unsigned short bf16_t;
typedef short bf16x8 __attribute__((ext_vector_type(8)));
typedef float f32x4 __attribute__((ext_vector_type(4)));
typedef unsigned u32x4 __attribute__((ext_vector_type(4)));
constexpr int BM = 256, BK = 64, HALF = 128, HTB = HALF * BK * 2  , STAGE_BYTES = 8 * HTB, NXCD = 8, WGM = 8;

__host__ __device__ __forceinline__ int lds_byte(int r, int c) { const int st = (r >> 4) * 2 + (c >> 5), rr = r & 15, cc = c & 31, ob = rr * 64 + cc * 2; return st * 1024 + (ob ^ (((ob >> 9) & 1) << 5)); }
__host__ __device__ __forceinline__ void stage_rc(int b, int& R, int& C) { const int st = b / 1024, sb = b % 1024, swz = sb ^ (((sb >> 9) & 1) << 5); R = (st >> 1) * 16 + swz / 64; C = (st & 1) * 32 + (swz % 64) / 2; }
__host__ __device__ __forceinline__ int perm32(int rho) { const int n = rho >> 4, i = rho & 15; return 8 * (i >> 2) + 4 * n + (i & 3); }

struct Unit { int pm, pn; };
struct Gemm { const bf16_t* A; const bf16_t* Bt; int M, N, K; };

struct StaticOrder {
    int nM, nN, nwg, G, c;
    __host__ __device__ void init(int M, int N, int G_, int c_) { nM = M / BM; nN = N / BM; nwg = nM * nN; G = G_; c = c_; }
    __host__ __device__ bool next(int i, Unit& u) const {
        const long L = (long)i * G + c; if (L >= nwg) return false;
        int wgid = (int)L; { const int q = nwg / NXCD, r = nwg % NXCD, xcd = wgid % NXCD, off = wgid / NXCD; wgid = (xcd < r ? xcd * (q + 1) : r * (q + 1) + (xcd - r) * q) + off; }
        const int nig = WGM * nN, gid = wgid / nig, fm = gid * WGM, gsz = (nM - fm) < WGM ? (nM - fm) : WGM;
        u.pm = fm + ((wgid % nig) % gsz); u.pn = (wgid % nig) / gsz; return true;
    }
    __device__ __forceinline__ void a_ready(const Unit&) const {}
    __device__ __forceinline__ void done(const Unit&) const {}
};

__device__ __forceinline__ unsigned cvt_pk_bf16(float lo, float hi) { unsigned r; asm volatile("v_cvt_pk_bf16_f32 %0, %1, %2" : "=v"(r) : "v"(lo), "v"(hi)); return r; }
typedef float f32x2 __attribute__((ext_vector_type(2)));
typedef unsigned u32x2 __attribute__((ext_vector_type(2)));
constexpr float NEPS = 1e-6f;
__device__ __forceinline__ float sigmoid_f(float x) { return __builtin_amdgcn_rcpf(1.f + __builtin_amdgcn_exp2f(-1.4426950408889634f * x)); }
__device__ __forceinline__ float silu_f(float x) { return x * sigmoid_f(x); }
__device__ __forceinline__ float bf2f(unsigned short h) { return __builtin_bit_cast(float, (unsigned)h << 16); }
__device__ __forceinline__ float bflo(unsigned w) { return __builtin_bit_cast(float, w << 16); }
__device__ __forceinline__ float bfhi(unsigned w) { return __builtin_bit_cast(float, w & 0xffff0000u); }

struct EpiSwiGLU {
    static constexpr bool PERM = false, AFTER_DRAIN = false;
    const float* rss; bf16_t* O;
    __device__ __forceinline__ void operator()(const f32x4 (&acc)[2][2][4][2], const Unit& u, int wr, int wc, int fr, int fq) const {
        const int row0 = u.pm * BM + wr * 64 + fr, col0 = u.pn * 128 + wc * 32 + 8 * fq;
#pragma unroll
        for (int ai = 0; ai < 2; ++ai)
#pragma unroll
            for (int m = 0; m < 4; ++m) {
                const int row = row0 + ai * HALF + m * 16;
                const float r = __builtin_amdgcn_rsqf(rss[row] * (1.f / 1024.f) + NEPS);
                float o[8];
#pragma unroll
                for (int n = 0; n < 2; ++n)
#pragma unroll
                    for (int e = 0; e < 4; ++e) o[4 * n + e] = silu_f(acc[ai][0][m][n][e] * r) * (acc[ai][1][m][n][e] * r);
                u32x4 w; w.x = cvt_pk_bf16(o[0], o[1]); w.y = cvt_pk_bf16(o[2], o[3]); w.z = cvt_pk_bf16(o[4], o[5]); w.w = cvt_pk_bf16(o[6], o[7]);
                *(u32x4*)(O + (size_t)row * 2816 + col0) = w;
            }
    }
};

template <bool NEXT> struct EpiResid {
    static constexpr bool PERM = false, AFTER_DRAIN = false;
    const float* base_p; const float* base_s; float* out; bf16_t* outb; float* rss; float alpha;
    __device__ __forceinline__ void operator()(const f32x4 (&acc)[2][2][4][2], const Unit& u, int wr, int wc, int fr, int fq) const {
        const int row0 = u.pm * BM + wr * 64 + fr, col0 = u.pn * BM + wc * 32 + 8 * fq;
        const float* base = (u.pm < 64) ? base_p : base_s;
#pragma unroll
        for (int ai = 0; ai < 2; ++ai)
#pragma unroll
            for (int m = 0; m < 4; ++m) {
                const int row = row0 + ai * HALF + m * 16; float ss = 0.f;
#pragma unroll
                for (int bj = 0; bj < 2; ++bj) {
                    const size_t off = (size_t)row * 1024 + col0 + bj * HALF;
                    const f32x4 b0 = *(const f32x4*)(base + off), b1 = *(const f32x4*)(base + off + 4);
                    const f32x4 v0 = b0 + acc[ai][bj][m][0] * alpha, v1 = b1 + acc[ai][bj][m][1] * alpha;
                    *(f32x4*)(out + off) = v0; *(f32x4*)(out + off + 4) = v1;
                    if (NEXT) {
                        u32x4 w; w.x = cvt_pk_bf16(v0[0], v0[1]); w.y = cvt_pk_bf16(v0[2], v0[3]); w.z = cvt_pk_bf16(v1[0], v1[1]); w.w = cvt_pk_bf16(v1[2], v1[3]);
                        *(u32x4*)(outb + off) = w;
                        ss += (v0[0] * v0[0] + v0[1] * v0[1]) + (v0[2] * v0[2] + v0[3] * v0[3]) + (v1[0] * v1[0] + v1[1] * v1[1]) + (v1[2] * v1[2] + v1[3] * v1[3]);
                    }
                }
                if (NEXT) { ss += __shfl_xor(ss, 16); ss += __shfl_xor(ss, 32); if (fq == 0) unsafeAtomicAdd(rss + row, ss); }
            }
    }
};

struct EpiGateA {
    static constexpr bool PERM = false, AFTER_DRAIN = false;
    const bf16_t* gates; float* tmp;
    __device__ __forceinline__ void operator()(const f32x4 (&acc)[2][2][4][2], const Unit& u, int wr, int wc, int fr, int fq) const {
        const int row0 = u.pm * BM + wr * 64 + fr, col0 = u.pn * BM + wc * 32 + 8 * fq;
#pragma unroll
        for (int ai = 0; ai < 2; ++ai)
#pragma unroll
            for (int m = 0; m < 4; ++m) {
                const int row = row0 + ai * HALF + m * 16;
#pragma unroll
                for (int bj = 0; bj < 2; ++bj) {
                    const int c = col0 + bj * HALF;
                    const u32x4 g = *(const u32x4*)(gates + (size_t)row * 2048 + c);
                    f32x4 v0 = acc[ai][bj][m][0], v1 = acc[ai][bj][m][1];
                    v0[0] *= bflo(g.x); v0[1] *= bfhi(g.x); v0[2] *= bflo(g.y); v0[3] *= bfhi(g.y);
                    v1[0] *= bflo(g.z); v1[1] *= bfhi(g.z); v1[2] *= bflo(g.w); v1[3] *= bfhi(g.w);
                    *(f32x4*)(tmp + (size_t)row * 1024 + c) = v0; *(f32x4*)(tmp + (size_t)row * 1024 + c + 4) = v1;
                }
            }
    }
};
struct EpiGateB {
    static constexpr bool PERM = false, AFTER_DRAIN = false;
    const bf16_t* gates; const float* tmp; bf16_t* mix;
    __device__ __forceinline__ void operator()(const f32x4 (&acc)[2][2][4][2], const Unit& u, int wr, int wc, int fr, int fq) const {
        const int row0 = u.pm * BM + wr * 64 + fr, col0 = u.pn * BM + wc * 32 + 8 * fq;
#pragma unroll
        for (int ai = 0; ai < 2; ++ai)
#pragma unroll
            for (int m = 0; m < 4; ++m) {
                const int row = row0 + ai * HALF + m * 16;
#pragma unroll
                for (int bj = 0; bj < 2; ++bj) {
                    const int c = col0 + bj * HALF;
                    const u32x4 g = *(const u32x4*)(gates + (size_t)row * 2048 + 1024 + c);
                    const f32x4 t0 = *(const f32x4*)(tmp + (size_t)row * 1024 + c), t1 = *(const f32x4*)(tmp + (size_t)row * 1024 + c + 4);
                    f32x4 v0 = acc[ai][bj][m][0], v1 = acc[ai][bj][m][1];
                    v0[0] = t0[0] + v0[0] * bflo(g.x); v0[1] = t0[1] + v0[1] * bfhi(g.x); v0[2] = t0[2] + v0[2] * bflo(g.y); v0[3] = t0[3] + v0[3] * bfhi(g.y);
                    v1[0] = t1[0] + v1[0] * bflo(g.z); v1[1] = t1[1] + v1[1] * bfhi(g.z); v1[2] = t1[2] + v1[2] * bflo(g.w); v1[3] = t1[3] + v1[3] * bfhi(g.w);
                    u32x4 w; w.x = cvt_pk_bf16(v0[0], v0[1]); w.y = cvt_pk_bf16(v0[2], v0[3]); w.z = cvt_pk_bf16(v1[0], v1[1]); w.w = cvt_pk_bf16(v1[2], v1[3]);
                    *(u32x4*)(mix + (size_t)row * 1024 + c) = w;
                }
            }
    }
};

struct EpiIn {
    static constexpr bool PERM = false, AFTER_DRAIN = false;
    const float* rss; bf16_t *U, *Q, *G; const float *b_gate, *qk_norm, *rot; float* out;
    static constexpr size_t O_KP0 = 17301504;
    __device__ __forceinline__ void operator()(const f32x4 (&acc)[2][2][4][2], const Unit& u, int wr, int wc, int fr, int fq) const {
        const int row0 = u.pm * BM + wr * 64 + fr; const int pn = u.pn; const bool samp = u.pm >= 64;
        if (pn < 4) {
            const int col0 = pn * 128 + wc * 32 + 8 * fq;
#pragma unroll
            for (int ai = 0; ai < 2; ++ai)
#pragma unroll
                for (int m = 0; m < 4; ++m) {
                    const int row = row0 + ai * HALF + m * 16; const float r = __builtin_amdgcn_rsqf(rss[row] * (1.f / 1024.f) + NEPS);
                    float o[8];
#pragma unroll
                    for (int n = 0; n < 2; ++n)
#pragma unroll
                        for (int e = 0; e < 4; ++e) o[4 * n + e] = (acc[ai][0][m][n][e] * r) * sigmoid_f(acc[ai][1][m][n][e] * r);
                    u32x4 w; w.x = cvt_pk_bf16(o[0], o[1]); w.y = cvt_pk_bf16(o[2], o[3]); w.z = cvt_pk_bf16(o[4], o[5]); w.w = cvt_pk_bf16(o[6], o[7]);
                    *(u32x4*)(U + (size_t)row * 512 + col0) = w;
                    float* cp = nullptr;
                    if (!samp) { const int t = row & 4095, b = row >> 12; if (t >= 4066) cp = out + 22806528 + ((size_t)(b * 30 + (t - 4066))) * 512 + col0; }
                    else { const int sr = row - 16384; cp = out + 199028736 + ((size_t)((sr >> 2) * 30 + 26 + (sr & 3))) * 512 + col0; }
                    if (cp) { *(f32x4*)cp = (f32x4){o[0], o[1], o[2], o[3]}; *(f32x4*)(cp + 4) = (f32x4){o[4], o[5], o[6], o[7]}; }
                }
        } else if (pn < 13) {
            const int kind = (pn - 4) / 3, g = (pn - 4) % 3;
            const int W = 128 << (2 * g);
            const int hcol = (4 * g + wc) * 64;
            int dim0[2][2];
#pragma unroll
            for (int n = 0; n < 2; ++n) { dim0[0][n] = (kind < 2 && fq < 2) ? 4 * fq + 8 * n : 8 * fq + 4 * n; dim0[1][n] = 32 + 8 * fq + 4 * n; }
            f32x4 gn[2][2];
            if (kind < 2) { const float* nw = qk_norm + kind * 768 + hcol;
#pragma unroll
                for (int bj = 0; bj < 2; ++bj)
#pragma unroll
                    for (int n = 0; n < 2; ++n) gn[bj][n] = *(const f32x4*)(nw + dim0[bj][n]); }
            bf16_t* dstb = Q + (size_t)kind * ((size_t)16896 * 768);
            size_t okp = 17301504, oks = 22867968;
            for (int gg = 0; gg < g; ++gg) { okp += (size_t)2 * 4 * (128 << (2 * gg)) * 256; oks += (size_t)2 * 128 * (128 << (2 * gg)) * 256; }
            if (kind == 2) { okp += (size_t)4 * W * 256; oks += (size_t)128 * W * 256; }
#pragma unroll
            for (int ai = 0; ai < 2; ++ai)
#pragma unroll
                for (int m = 0; m < 4; ++m) {
                    const int row = row0 + ai * HALF + m * 16; const float r = __builtin_amdgcn_rsqf(rss[row] * (1.f / 1024.f) + NEPS);
                    f32x4 v[2][2];
#pragma unroll
                    for (int bj = 0; bj < 2; ++bj)
#pragma unroll
                        for (int n = 0; n < 2; ++n) v[bj][n] = acc[ai][bj][m][n] * r;
                    int posidx, b, tt; float* cdst = nullptr;
                    if (!samp) { tt = row & 4095; b = row >> 12; posidx = tt; if (kind >= 1 && tt >= 4096 - W) cdst = out + okp + ((size_t)(b * W + (tt - (4096 - W))) * 4 + wc) * 64; }
                    else { const int sr = row - 16384; b = sr >> 2; tt = sr & 3; posidx = 4096 + tt; if (kind >= 1) cdst = out + oks + ((size_t)(b * W + (W - 4 + tt)) * 4 + wc) * 64; }
                    if (kind < 2) {
                        float ss = 0.f;
#pragma unroll
                        for (int bj = 0; bj < 2; ++bj)
#pragma unroll
                            for (int n = 0; n < 2; ++n) ss += (v[bj][n][0] * v[bj][n][0] + v[bj][n][1] * v[bj][n][1]) + (v[bj][n][2] * v[bj][n][2] + v[bj][n][3] * v[bj][n][3]);
                        ss += __shfl_xor(ss, 16); ss += __shfl_xor(ss, 32);
                        const float rn = __builtin_amdgcn_rsqf(ss * (1.f / 64.f) + NEPS);
#pragma unroll
                        for (int bj = 0; bj < 2; ++bj)
#pragma unroll
                            for (int n = 0; n < 2; ++n) v[bj][n] = v[bj][n] * rn * gn[bj][n];
                        if (fq < 2) {
                            const f32x4 cs = *(const f32x4*)(rot + (size_t)posidx * 16 + 4 * fq), sn = *(const f32x4*)(rot + (size_t)posidx * 16 + 8 + 4 * fq);
                            const f32x4 x1 = v[0][0], x2 = v[0][1];
                            v[0][0] = x1 * cs - x2 * sn; v[0][1] = x2 * cs + x1 * sn;
                        }
                        if (kind == 0) {
#pragma unroll
                            for (int bj = 0; bj < 2; ++bj)
#pragma unroll
                                for (int n = 0; n < 2; ++n) v[bj][n] = v[bj][n] * (0.125f * 1.4426950408889634f);
                        }
                    }
#pragma unroll
                    for (int bj = 0; bj < 2; ++bj)
#pragma unroll
                        for (int n = 0; n < 2; ++n) {
                            u32x2 w; w.x = cvt_pk_bf16(v[bj][n][0], v[bj][n][1]); w.y = cvt_pk_bf16(v[bj][n][2], v[bj][n][3]);
                            *(u32x2*)(dstb + (size_t)row * 768 + hcol + dim0[bj][n]) = w;
                            if (cdst) *(f32x4*)(cdst + dim0[bj][n]) = v[bj][n];
                        }
                }
        } else {
            const int col0 = (pn - 13) * 256 + wc * 32 + 8 * fq;
            f32x4 bv[2][2];
#pragma unroll
            for (int bj = 0; bj < 2; ++bj)
#pragma unroll
                for (int n = 0; n < 2; ++n) bv[bj][n] = *(const f32x4*)(b_gate + col0 + bj * HALF + 4 * n);
#pragma unroll
            for (int ai = 0; ai < 2; ++ai)
#pragma unroll
                for (int m = 0; m < 4; ++m) {
                    const int row = row0 + ai * HALF + m * 16; const float r = __builtin_amdgcn_rsqf(rss[row] * (1.f / 1024.f) + NEPS);
#pragma unroll
                    for (int bj = 0; bj < 2; ++bj) {
                        float o[8];
#pragma unroll
                        for (int n = 0; n < 2; ++n)
#pragma unroll
                            for (int e = 0; e < 4; ++e) o[4 * n + e] = sigmoid_f(acc[ai][bj][m][n][e] * r + bv[bj][n][e]);
                        u32x4 w; w.x = cvt_pk_bf16(o[0], o[1]); w.y = cvt_pk_bf16(o[2], o[3]); w.z = cvt_pk_bf16(o[4], o[5]); w.w = cvt_pk_bf16(o[6], o[7]);
                        *(u32x4*)(G + (size_t)row * 2048 + col0 + bj * HALF) = w;
                    }
                }
        }
    }
};
template <class Epi, class Sched, bool ALIGN_EPI = false, bool SP2 = false>
__device__ __forceinline__ void gemm_phase(PG8_LAS unsigned char* lds, const Gemm g, const Sched& S, const Epi& E) {
    const int tid = threadIdx.x, wid = __builtin_amdgcn_readfirstlane(tid >> 6), lane = tid & 63, wr = wid >> 2, wc = wid & 3, fr = lane & 15, fq = lane >> 4;
    const int K = g.K, nt = K / BK;
    unsigned voffA[2], voffB[2];
#pragma unroll
    for (int i = 0; i < 2; ++i) { int R, C; stage_rc(tid * 16 + i * 8192, R, C); const int Rb = Epi::PERM ? ((R & ~31) + perm32(R & 31)) : R;
        voffA[i] = (unsigned)(R * K + C) * 2u; voffB[i] = (unsigned)(Rb * K + C) * 2u; }
    const size_t kstep = (size_t)(BK * 2);
    const size_t hstep = (size_t)HALF * K * 2;
    const size_t tstep = 2 * hstep;
    const unsigned ldsw = (unsigned)wid * 1024u;
    const int aoff = lds_byte(wr * 64 + fr, fq * 8), boff = lds_byte(wc * 32 + fr, fq * 8);
#define PG8_SA(b, h) (((b) * 2 + (h)) * HTB)
#define PG8_SB(b, h) ((4 + (b) * 2 + (h)) * HTB)
#define PG8_STAGE(bufoff, gbase, voff) do { _Pragma("unroll") for (int _i = 0; _i < 2; ++_i) \
        __builtin_amdgcn_global_load_lds((const unsigned*)((const char*)(gbase) + (voff)[_i]), (PG8_LAS unsigned*)(lds + (bufoff) + ldsw + _i * 8192), 16, 0, 0); } while (0)
#define PG8_LDA(dst, b, h) do { _Pragma("unroll") for (int m = 0; m < 4; ++m) _Pragma("unroll") for (int k = 0; k < 2; ++k) dst[m][k] = *(const PG8_LAS bf16x8*)(lds + PG8_SA(b, h) + aoff + m * 2048 + k * 1024); } while (0)
#define PG8_LDB(dst, b, h) do { _Pragma("unroll") for (int n = 0; n < 2; ++n) _Pragma("unroll") for (int k = 0; k < 2; ++k) dst[n][k] = *(const PG8_LAS bf16x8*)(lds + PG8_SB(b, h) + boff + n * 2048 + k * 1024); } while (0)
#define PG8_MMA(ai, bj, At, Bt) do { __builtin_amdgcn_s_setprio(1); _Pragma("unroll") for (int m = 0; m < 4; ++m) _Pragma("unroll") for (int n = 0; n < 2; ++n) _Pragma("unroll") for (int k = 0; k < 2; ++k) \
        acc[ai][bj][m][n] = __builtin_amdgcn_mfma_f32_16x16x32_bf16(Bt[n][k], At[m][k], acc[ai][bj][m][n], 0, 0, 0); __builtin_amdgcn_s_setprio(0); } while (0)
#define PG8_WAIT_V(n) asm volatile("s_waitcnt vmcnt(" #n ")" ::: "memory")
#define PG8_WAIT_L(n) asm volatile("s_waitcnt lgkmcnt(" #n ")" ::: "memory")
#define PG8_BAR __builtin_amdgcn_s_barrier()
#define PG8_SCHED __builtin_amdgcn_sched_barrier(0)
    Unit cur, nxt; int ui = 0;
    if (!S.next(0, cur)) return;
    f32x4 acc[2][2][4][2];
#pragma unroll
    for (int a = 0; a < 2; ++a)
#pragma unroll
        for (int b = 0; b < 2; ++b)
#pragma unroll
            for (int m = 0; m < 4; ++m)
#pragma unroll
                for (int n = 0; n < 2; ++n) acc[a][b][m][n] = (f32x4){0.f, 0.f, 0.f, 0.f};
    bf16x8 At[4][2], B0[2][2], B1[2][2];
    const char* cA = (const char*)g.A + (size_t)cur.pm * tstep; const char* cB = (const char*)g.Bt + (size_t)cur.pn * tstep;
    S.a_ready(cur);
    if constexpr (SP2) {
        PG8_STAGE(PG8_SB(0, 0), cB, voffB); PG8_STAGE(PG8_SB(0, 1), cB + hstep, voffB); PG8_STAGE(PG8_SA(0, 0), cA, voffA); PG8_STAGE(PG8_SA(0, 1), cA + hstep, voffA);
        if (wr == 1) PG8_BAR;
        PG8_WAIT_V(2); PG8_BAR;
        PG8_STAGE(PG8_SB(1, 0), cB + kstep, voffB); PG8_STAGE(PG8_SA(1, 0), cA + kstep, voffA); PG8_STAGE(PG8_SB(1, 1), cB + hstep + kstep, voffB);
        PG8_WAIT_V(6); PG8_BAR;
    } else {
        PG8_STAGE(PG8_SB(0, 0), cB, voffB); PG8_STAGE(PG8_SA(0, 0), cA, voffA); PG8_STAGE(PG8_SB(0, 1), cB + hstep, voffB); PG8_STAGE(PG8_SA(0, 1), cA + hstep, voffA);
        if (wr == 1) PG8_BAR;
        PG8_WAIT_V(4); PG8_BAR;
        PG8_STAGE(PG8_SB(1, 0), cB + kstep, voffB); PG8_STAGE(PG8_SA(1, 0), cA + kstep, voffA); PG8_STAGE(PG8_SB(1, 1), cB + hstep + kstep, voffB);
        PG8_WAIT_V(6); PG8_BAR;
    }
    for (;;) {
        const bool has_next = S.next(ui + 1, nxt);
        const char* nA = has_next ? (const char*)g.A + (size_t)nxt.pm * tstep : cA; const char* nB = has_next ? (const char*)g.Bt + (size_t)nxt.pn * tstep : cB;
        for (int t = 0; t < nt; t += 2) {
            const bool last = (t == nt - 2);
            const char* a1 = cA + (size_t)(t + 1) * kstep;
            const char* a2 = last ? nA : cA + (size_t)(t + 2) * kstep; const char* b2 = last ? nB : cB + (size_t)(t + 2) * kstep;
            const char* a3 = a2 + kstep; const char* b3 = b2 + kstep;
            if (last && has_next) S.a_ready(nxt);
            if constexpr (SP2) {
            PG8_LDB(B0, 0, 0); PG8_LDB(B1, 0, 1); PG8_SCHED; PG8_LDA(At, 0, 0); PG8_STAGE(PG8_SA(1, 1), a1 + hstep, voffA);
            PG8_WAIT_V(8); PG8_WAIT_L(0); PG8_BAR; PG8_MMA(0, 0, At, B0); PG8_MMA(0, 1, At, B1); PG8_BAR; PG8_SCHED;
            PG8_LDA(At, 0, 1); PG8_STAGE(PG8_SB(0, 0), b2, voffB); PG8_STAGE(PG8_SB(0, 1), b2 + hstep, voffB); PG8_STAGE(PG8_SA(0, 0), a2, voffA);
            PG8_WAIT_V(8); PG8_WAIT_L(0); PG8_BAR; PG8_MMA(1, 0, At, B0); PG8_MMA(1, 1, At, B1); PG8_BAR; PG8_SCHED;
            PG8_LDB(B0, 1, 0); PG8_LDB(B1, 1, 1); PG8_SCHED; PG8_LDA(At, 1, 0); PG8_STAGE(PG8_SA(0, 1), a2 + hstep, voffA);
            PG8_WAIT_V(8); PG8_WAIT_L(0); PG8_BAR; PG8_MMA(0, 0, At, B0); PG8_MMA(0, 1, At, B1); PG8_BAR; PG8_SCHED;
            PG8_LDA(At, 1, 1); PG8_STAGE(PG8_SB(1, 0), b3, voffB); PG8_STAGE(PG8_SB(1, 1), b3 + hstep, voffB); PG8_STAGE(PG8_SA(1, 0), a3, voffA);
            PG8_WAIT_V(8); PG8_WAIT_L(0); PG8_BAR; PG8_MMA(1, 0, At, B0); PG8_MMA(1, 1, At, B1); PG8_BAR; PG8_SCHED;
            } else {
            PG8_LDB(B0, 0, 0); PG8_SCHED; PG8_LDA(At, 0, 0); PG8_STAGE(PG8_SA(1, 1), a1 + hstep, voffA);
            PG8_WAIT_L(8); PG8_BAR; PG8_WAIT_L(0); PG8_MMA(0, 0, At, B0); PG8_BAR; PG8_SCHED;
            PG8_LDB(B1, 0, 1); PG8_STAGE(PG8_SB(0, 0), b2, voffB);
            PG8_BAR; PG8_WAIT_L(0); PG8_MMA(0, 1, At, B1); PG8_BAR;
            PG8_LDA(At, 0, 1); PG8_STAGE(PG8_SA(0, 0), a2, voffA);
            PG8_BAR; PG8_WAIT_L(0); PG8_MMA(1, 0, At, B0); PG8_BAR; PG8_SCHED;
            PG8_STAGE(PG8_SB(0, 1), b2 + hstep, voffB);
            PG8_WAIT_V(6); PG8_BAR; PG8_MMA(1, 1, At, B1); PG8_BAR;
            PG8_LDB(B0, 1, 0); PG8_SCHED; PG8_LDA(At, 1, 0); PG8_STAGE(PG8_SA(0, 1), a2 + hstep, voffA);
            PG8_WAIT_L(8); PG8_BAR; PG8_WAIT_L(0); PG8_MMA(0, 0, At, B0); PG8_BAR; PG8_SCHED;
            PG8_LDB(B1, 1, 1); PG8_STAGE(PG8_SB(1, 0), b3, voffB);
            PG8_BAR; PG8_WAIT_L(0); PG8_MMA(0, 1, At, B1); PG8_BAR;
            PG8_LDA(At, 1, 1); PG8_STAGE(PG8_SA(1, 0), a3, voffA);
            PG8_BAR; PG8_WAIT_L(0); PG8_MMA(1, 0, At, B0); PG8_BAR; PG8_SCHED;
            PG8_STAGE(PG8_SB(1, 1), b3 + hstep, voffB);
            PG8_WAIT_V(6); PG8_BAR; PG8_MMA(1, 1, At, B1); PG8_BAR;
            }
        }
        if constexpr (ALIGN_EPI) { if (wr == 0) PG8_BAR; }
        if constexpr (!Epi::AFTER_DRAIN) { E(acc, cur, wr, wc, fr, fq); S.done(cur); }
        if (!has_next) break;
#pragma unroll
        for (int a = 0; a < 2; ++a)
#pragma unroll
            for (int b = 0; b < 2; ++b)
#pragma unroll
                for (int m = 0; m < 4; ++m)
#pragma unroll
                    for (int n = 0; n < 2; ++n) acc[a][b][m][n] = (f32x4){0.f, 0.f, 0.f, 0.f};
        cur = nxt; cA = nA; cB = nB; ++ui;
        if constexpr (ALIGN_EPI) { if (wr == 1) PG8_BAR; }
    }
    PG8_WAIT_V(0);
    if constexpr (!ALIGN_EPI) { if (wr == 0) PG8_BAR; }
    PG8_BAR;
    if constexpr (Epi::AFTER_DRAIN) { E.fused(acc, cur, wr, wc, fr, fq, lds, wid, lane); S.done(cur); }
#undef PG8_SA
#undef PG8_SB
#undef PG8_STAGE
#undef PG8_LDA
#undef PG8_LDB
#undef PG8_MMA
#undef PG8_WAIT_V
#undef PG8_WAIT_L
#undef PG8_BAR
#undef PG8_SCHED
}
}

#ifndef MK_N_LAUNCHES
#define MK_N_LAUNCHES 1
#endif
constexpr int N_PHASES = 10;
constexpr int TP = 16384, TS = 512, T = TP + TS, D = 1024, FF = 2816, NIN = 5376;
#define GAS __attribute__((address_space(1)))
#define LAS __attribute__((address_space(3)))
typedef unsigned short bf16;
typedef float f32x4 __attribute__((ext_vector_type(4)));
typedef float f32x16 __attribute__((ext_vector_type(16)));
typedef short bf16x8 __attribute__((ext_vector_type(8)));
typedef unsigned v4u __attribute__((ext_vector_type(4)));
typedef unsigned v2u __attribute__((ext_vector_type(2)));

constexpr size_t al256(size_t x) { return (x + 255) & ~(size_t)255; }
constexpr size_t WS_BAR = 0, WS_CTL = 16384, WS_BAR_BYTES = 32768;
constexpr size_t WS_RSS0 = WS_BAR_BYTES, WS_RSS1 = WS_RSS0 + al256((size_t)T * 4), WS_RSS2 = WS_RSS1 + al256((size_t)T * 4);
constexpr size_t WS_ROT = WS_RSS2 + al256((size_t)T * 4);
constexpr size_t WS_QKN = WS_ROT + al256((size_t)4100 * 16 * 4);
constexpr size_t WS_W1 = WS_QKN + al256((size_t)1536 * 4);
constexpr size_t WS_W2 = WS_W1 + (size_t)2 * FF * D * 2;
constexpr size_t WS_W3 = WS_W2 + (size_t)D * FF * 2;
constexpr size_t WS_W4A = WS_W3 + (size_t)NIN * D * 2;
constexpr size_t WS_W4B = WS_W4A + (size_t)D * 512 * 2;
constexpr size_t WS_W5 = WS_W4B + (size_t)D * 256 * 2;
constexpr size_t WS_W6 = WS_W5 + (size_t)D * D * 2;
constexpr size_t WS_W7 = WS_W6 + (size_t)2 * FF * D * 2;
constexpr size_t WS_XB = WS_W7 + (size_t)D * FF * 2;
constexpr size_t WS_ACT = WS_XB + (size_t)T * D * 2;
constexpr size_t WS_X1 = WS_ACT + (size_t)T * FF * 2;
constexpr size_t WS_X1B = WS_X1 + (size_t)T * D * 4;
constexpr size_t WS_U = WS_X1B + (size_t)T * D * 2;
constexpr size_t WS_Q = WS_U + (size_t)T * 512 * 2;
constexpr size_t WS_K = WS_Q + (size_t)T * 768 * 2;
constexpr size_t WS_V = WS_K + (size_t)T * 768 * 2;
constexpr size_t WS_G = WS_V + (size_t)T * 768 * 2;
constexpr size_t WS_CONVF = WS_G + (size_t)T * 2048 * 2;
constexpr size_t WS_OG = WS_CONVF + (size_t)T * 512 * 2;
constexpr size_t WS_ML = WS_OG + (size_t)3 * T * 256 * 2;
constexpr size_t WS_BATT = WS_ML + (size_t)3 * T * 8 * 4;
constexpr size_t WS_TMP = WS_BATT + (size_t)T * 256 * 2;
constexpr size_t WS_MIX = WS_TMP + (size_t)T * D * 4;
constexpr size_t WS_X2 = WS_MIX + (size_t)T * D * 2;
constexpr size_t WS_X2B = WS_X2 + (size_t)T * D * 4;
constexpr size_t WS_END = WS_X2B + (size_t)T * D * 2;

constexpr size_t O_CP = 22806528, O_KS0 = 22867968, O_CS = 199028736;

constexpr int LDS_BYTES = 131072 + 1024;

__device__ __forceinline__ unsigned f2bf(float f) { unsigned u = __builtin_bit_cast(unsigned, f); return (u + 0x7fffu + ((u >> 16) & 1u)) >> 16; }
__device__ __forceinline__ unsigned pk2(float lo, float hi) { return f2bf(lo) | (f2bf(hi) << 16); }
__device__ __forceinline__ float bf2f_g(unsigned short h) { return __builtin_bit_cast(float, (unsigned)h << 16); }
__device__ __forceinline__ float bfl(unsigned w) { return __builtin_bit_cast(float, w << 16); }
__device__ __forceinline__ float bfh(unsigned w) { return __builtin_bit_cast(float, w & 0xffff0000u); }
__device__ __forceinline__ float wave_sum(float v) {
#pragma unroll
    for (int o = 1; o < 64; o <<= 1) v += __shfl_xor(v, o);
    return v;
}

struct Args { const float* in[27]; float* out; unsigned char* ws; int ph_lo, ph_hi; };

__device__ __forceinline__ int perm32(int rho) { const int n = rho >> 4, i = rho & 15; return 8 * (i >> 2) + 4 * n + (i & 3); }
template <int MAP> __device__ __forceinline__ int src_col(int nd) {
    if (MAP == 0) return (nd & ~31) + perm32(nd & 31);
    const int pn = nd >> 8, w = nd & 255, bj = w >> 7, rem = w & 127, wc = rem >> 5, slot = rem & 31;
    if (MAP == 1) return bj * FF + pn * 128 + wc * 32 + perm32(slot);
    if (pn < 4) return bj * 512 + pn * 128 + wc * 32 + perm32(slot);
    if (pn < 13) {
        int dim;
        if (pn < 10 && bj == 0) { const int fq = (slot & 15) >> 2, n = slot >> 4, e = slot & 3; dim = fq < 2 ? 4 * fq + 8 * n + e : 8 * fq + 4 * n + e; }
        else dim = 32 * bj + perm32(slot);
        return 1024 + (pn - 4) * 256 + wc * 64 + dim;
    }
    return 3328 + (pn - 13) * 256 + bj * 128 + wc * 32 + perm32(slot);
}
template <int MAP> __device__ __forceinline__ void p0_transpose_item(const float* W, int K, int Ns, int Nd, bf16* WT, const float* gain, LAS float* scr, int item, int lane) {
    const int nblk = Nd / 32, kb = item / nblk, nb = item % nblk, k0 = 64 * kb, n0 = 32 * nb;
    const int sc = src_col<MAP>(n0 + (lane & 31));
#pragma unroll 8
    for (int i = 0; i < 32; ++i) { const int kk = 2 * i + (lane >> 5); float v = W[(size_t)(k0 + kk) * Ns + sc]; if (gain) v *= gain[k0 + kk]; scr[kk * 33 + (lane & 31)] = v; }
    asm volatile("s_waitcnt lgkmcnt(0)" ::: "memory");
    const int c = lane & 7;
#pragma unroll
    for (int j = 0; j < 4; ++j) { const int n = (lane >> 3) + 8 * j; const LAS float* s = scr + (8 * c) * 33 + n;
        v4u o; o.x = pk2(s[0 * 33], s[1 * 33]); o.y = pk2(s[2 * 33], s[3 * 33]); o.z = pk2(s[4 * 33], s[5 * 33]); o.w = pk2(s[6 * 33], s[7 * 33]);
        *(v4u*)(WT + (size_t)(n0 + n) * K + k0 + 8 * c) = o; }
    asm volatile("s_waitcnt lgkmcnt(0)" ::: "memory");
}
constexpr int N_CHUNKS = 10752 + 128;
__device__ __forceinline__ void copy_chunk(const Args& a, int id, int tid) {
    const float* src; float* dst; int nrows;
    if (id < 10752) {
        int g, r;
        if (id < 512) { g = 0; r = id; } else if (id < 2560) { g = 1; r = id - 512; } else { g = 2; r = id - 2560; }
        const int W = 128 << (2 * g), cpb = 2 << (2 * g);
        const int kv = r / (128 * cpb), r2 = r % (128 * cpb), b = r2 / cpb, ch = r2 % cpb, row0 = ch * 64;
        nrows = (W - 4 - row0) < 64 ? (W - 4 - row0) : 64;
        size_t oks = O_KS0; for (int gg = 0; gg < g; ++gg) oks += (size_t)2 * 128 * (128 << (2 * gg)) * 256;
        oks += (size_t)kv * 128 * W * 256;
        src = a.in[2 + 2 * g + kv] + ((size_t)b * W + 4 + row0) * 256; dst = a.out + oks + ((size_t)b * W + row0) * 256;
    } else { const int b = id - 10752; src = a.in[8] + ((size_t)b * 30 + 4) * 512; dst = a.out + O_CS + (size_t)b * 30 * 512; nrows = 52; }
    const int n4 = nrows * 64; const f32x4* s4 = (const f32x4*)src; f32x4* d4 = (f32x4*)dst;
    f32x4 v[8];
#pragma unroll
    for (int k = 0; k < 8; ++k) { const int i = tid + 512 * k; if (i < n4) v[k] = __builtin_nontemporal_load(s4 + i); }
#pragma unroll
    for (int k = 0; k < 8; ++k) { const int i = tid + 512 * k; if (i < n4) __builtin_nontemporal_store(v[k], d4 + i); }
}
__device__ __forceinline__ void filler(const Args& a, unsigned* ctl, int phase, unsigned my_units, unsigned total_units, volatile LAS unsigned* misc, int tid) {
    unsigned* done = ctl + 64 * (1 + phase);
    if (tid == 0 && total_units) __hip_atomic_fetch_add(done, my_units, __ATOMIC_RELAXED, __HIP_MEMORY_SCOPE_AGENT);
    for (int it = 0;; ++it) {
        if (tid == 0) { unsigned id = N_CHUNKS;
            if (!total_units || __hip_atomic_load(done, __ATOMIC_RELAXED, __HIP_MEMORY_SCOPE_AGENT) < total_units) id = __hip_atomic_fetch_add(ctl, 1u, __ATOMIC_RELAXED, __HIP_MEMORY_SCOPE_AGENT);
            misc[16 + (it & 1)] = id; }
        __syncthreads();
        const unsigned id = misc[16 + (it & 1)];
        if (id >= (unsigned)N_CHUNKS) break;
        copy_chunk(a, (int)id, tid);
    }
}
__device__ __forceinline__ unsigned units_of(int nwg, int G, int c) { return c < nwg ? (unsigned)((nwg - c + G - 1) / G) : 0u; }

__device__ __forceinline__ void p0_prologue(const Args& a, LAS unsigned char* lds, int G, int bid, int tid) {
    const int wave = tid >> 6, lane = tid & 63;
    LAS float* scr = (LAS float*)(lds + wave * 16384);
    const int gw = bid * 8 + wave, NGW = G * 8;
    unsigned char* ws = a.ws;
    constexpr int I_IN = (D / 64) * (2 * FF / 32), I_OUT = (FF / 64) * (D / 32), I_3 = (D / 64) * (NIN / 32), I_4A = (512 / 64) * (D / 32), I_4B = (256 / 64) * (D / 32), I_5 = (D / 64) * (D / 32);
    constexpr int NITEMS = 2 * I_IN + 2 * I_OUT + I_3 + I_4A + I_4B + I_5;
    for (int it = gw; it < NITEMS; it += NGW) {
        int r = it;
        if (r < I_IN) { p0_transpose_item<1>(a.in[10], D, 2 * FF, 2 * FF, (bf16*)(ws + WS_W1), a.in[9], scr, r, lane); continue; } r -= I_IN;
        if (r < I_IN) { p0_transpose_item<1>(a.in[25], D, 2 * FF, 2 * FF, (bf16*)(ws + WS_W6), a.in[24], scr, r, lane); continue; } r -= I_IN;
        if (r < I_OUT) { p0_transpose_item<0>(a.in[11], FF, D, D, (bf16*)(ws + WS_W2), nullptr, scr, r, lane); continue; } r -= I_OUT;
        if (r < I_OUT) { p0_transpose_item<0>(a.in[26], FF, D, D, (bf16*)(ws + WS_W7), nullptr, scr, r, lane); continue; } r -= I_OUT;
        if (r < I_3) { p0_transpose_item<2>(a.in[13], D, NIN, NIN, (bf16*)(ws + WS_W3), a.in[12], scr, r, lane); continue; } r -= I_3;
        if (r < I_4A) { p0_transpose_item<0>(a.in[21], 512, D, D, (bf16*)(ws + WS_W4A), nullptr, scr, r, lane); continue; } r -= I_4A;
        if (r < I_4B) { p0_transpose_item<0>(a.in[22], 256, D, D, (bf16*)(ws + WS_W4B), nullptr, scr, r, lane); continue; } r -= I_4B;
        p0_transpose_item<0>(a.in[23], D, D, D, (bf16*)(ws + WS_W5), nullptr, scr, r, lane);
    }
    float* rss0 = (float*)(ws + WS_RSS0); float* rss1 = (float*)(ws + WS_RSS1); float* rss2 = (float*)(ws + WS_RSS2);
    bf16* XB = (bf16*)(ws + WS_XB);
    for (int m = gw; m < T; m += NGW) {
        const float* xr = (m < TP) ? a.in[0] + (size_t)m * D : a.in[1] + (size_t)(m - TP) * D;
        const f32x4* x4 = (const f32x4*)xr + lane; f32x4 v[4]; float s = 0.f;
#pragma unroll
        for (int j = 0; j < 4; ++j) { v[j] = x4[64 * j]; s += (v[j][0] * v[j][0] + v[j][1] * v[j][1]) + (v[j][2] * v[j][2] + v[j][3] * v[j][3]); }
        s = wave_sum(s);
        if (lane == 0) { rss0[m] = s; rss1[m] = 0.f; rss2[m] = 0.f; }
        v2u* o8 = (v2u*)(XB + (size_t)m * D) + lane;
#pragma unroll
        for (int j = 0; j < 4; ++j) { v2u w; w.x = pk2(v[j][0], v[j][1]); w.y = pk2(v[j][2], v[j][3]); o8[64 * j] = w; }
    }
    const size_t gtid = (size_t)bid * 512 + tid, nthr = (size_t)G * 512;
    float* rot = (float*)(ws + WS_ROT);
    for (size_t i = gtid; i < (size_t)4100 * 8; i += nthr) {
        const int p = (int)(i >> 3), f = (int)(i & 7); const int pos = p < 4096 ? p : 2048 + (p - 4096);
        const double inv = exp2(-(double)f * (18.931568569324174 / 8.0));
        const double rev = (double)pos * inv * 0.15915494309189535;
        const double fr = rev - rint(rev);
        const float ang = (float)(fr * 6.283185307179586);
        rot[(size_t)p * 16 + f] = __builtin_amdgcn_cosf((float)fr); rot[(size_t)p * 16 + 8 + f] = __builtin_amdgcn_sinf((float)fr); (void)ang;
    }
    { float* qkn = (float*)(ws + WS_QKN); for (size_t i = gtid; i < 1536; i += nthr) qkn[i] = i < 768 ? a.in[15][i] : a.in[16][i - 768]; }
}

__device__ __forceinline__ int crow(int r, int hi) { return (r & 3) + 8 * (r >> 2) + 4 * hi; }
constexpr int KS_STRIDE = 144, VT_OFF = 384 * KS_STRIDE, VT_STRIDE = 776;
__device__ __forceinline__ void attn_prompt_unit(LAS unsigned char* lds, const bf16* Q, const bf16* Kb, const bf16* Vb, bf16* OG, float* ML, int unit, int tid) {
    const int b = unit / 192; int rem = unit % 192; const int g = rem / 64; rem %= 64; const int h = rem / 16, x = rem % 16;
    const int dsh = 2 * g, d = 1 << dsh, nblk = 16 >> dsh, r = x / nblk, qb = x % nblk, i0 = qb * 256;
    const int hc = (4 * g + h) * 64;
    __syncthreads();
    if (tid < 384) {
        const int s = tid, i = i0 - 128 + s;
        v4u kv[8], vv[8];
        if (i >= 0) { const size_t row = (size_t)b * 4096 + (size_t)i * d + r; const v4u* kp = (const v4u*)(Kb + row * 768 + hc); const v4u* vp = (const v4u*)(Vb + row * 768 + hc);
#pragma unroll
            for (int j = 0; j < 8; ++j) { kv[j] = kp[j]; vv[j] = vp[j]; } }
        else {
#pragma unroll
            for (int j = 0; j < 8; ++j) { kv[j] = (v4u){0u, 0u, 0u, 0u}; vv[j] = (v4u){0u, 0u, 0u, 0u}; } }
#pragma unroll
        for (int j = 0; j < 8; ++j) *(LAS v4u*)(lds + s * KS_STRIDE + 16 * j) = kv[j];
#pragma unroll
        for (int j = 0; j < 8; ++j)
#pragma unroll
            for (int e = 0; e < 4; ++e) { const unsigned w = vv[j][e];
                *(LAS unsigned short*)(lds + VT_OFF + (8 * j + 2 * e) * VT_STRIDE + s * 2) = (unsigned short)(w & 0xffffu);
                *(LAS unsigned short*)(lds + VT_OFF + (8 * j + 2 * e + 1) * VT_STRIDE + s * 2) = (unsigned short)(w >> 16); }
    }
    __syncthreads();
    const int w = tid >> 6, lane = tid & 63, ql = lane & 31, hi = lane >> 5;
    const int iq = i0 + 32 * w + ql; const size_t qrow = (size_t)b * 4096 + (size_t)iq * d + r;
    bf16x8 qf[4];
#pragma unroll
    for (int kk = 0; kk < 4; ++kk) qf[kk] = *(const bf16x8*)(Q + qrow * 768 + hc + 16 * kk + 8 * hi);
    f32x16 S[5];
#pragma unroll
    for (int j = 0; j < 5; ++j) {
#pragma unroll
        for (int e = 0; e < 16; ++e) S[j][e] = 0.f;
#pragma unroll
        for (int kk = 0; kk < 4; ++kk) { const bf16x8 af = *(const LAS bf16x8*)(lds + (32 * (w + j) + ql) * KS_STRIDE + (16 * kk + 8 * hi) * 2);
            S[j] = __builtin_amdgcn_mfma_f32_32x32x16_bf16(af, qf[kk], S[j], 0, 0, 0); }
    }
    float mx = -INFINITY;
#pragma unroll
    for (int j = 0; j < 5; ++j)
#pragma unroll
        for (int e = 0; e < 16; ++e) { const int kl = crow(e, hi); const int rel = 128 + ql - 32 * j - kl; const int ik = i0 - 128 + 32 * (w + j) + kl;
            const bool valid = (rel >= 0) && (rel <= 128) && (ik >= 0);
            S[j][e] = valid ? S[j][e] : -INFINITY; mx = fmaxf(mx, S[j][e]); }
    mx = fmaxf(mx, __shfl_xor(mx, 32));
    float l = 0.f;
#pragma unroll
    for (int j = 0; j < 5; ++j)
#pragma unroll
        for (int e = 0; e < 16; ++e) { const float p = __builtin_amdgcn_exp2f(S[j][e] - mx); S[j][e] = p; l += p; }
    l += __shfl_xor(l, 32);
    f32x16 O[2];
#pragma unroll
    for (int e = 0; e < 16; ++e) { O[0][e] = 0.f; O[1][e] = 0.f; }
#pragma unroll
    for (int j = 0; j < 5; ++j)
#pragma unroll
        for (int c = 0; c < 2; ++c) {
            v4u pw; pw.x = pk2(S[j][8 * c + 0], S[j][8 * c + 1]); pw.y = pk2(S[j][8 * c + 2], S[j][8 * c + 3]); pw.z = pk2(S[j][8 * c + 4], S[j][8 * c + 5]); pw.w = pk2(S[j][8 * c + 6], S[j][8 * c + 7]);
            const bf16x8 pf = __builtin_bit_cast(bf16x8, pw);
            const int s0 = 32 * (w + j) + 16 * c + 4 * hi;
#pragma unroll
            for (int dt = 0; dt < 2; ++dt) { const int dim = 32 * dt + ql;
                const v2u lo = *(const LAS v2u*)(lds + VT_OFF + dim * VT_STRIDE + s0 * 2), hh = *(const LAS v2u*)(lds + VT_OFF + dim * VT_STRIDE + (s0 + 8) * 2);
                v4u vw; vw.x = lo.x; vw.y = lo.y; vw.z = hh.x; vw.w = hh.y;
                O[dt] = __builtin_amdgcn_mfma_f32_32x32x16_bf16(__builtin_bit_cast(bf16x8, vw), pf, O[dt], 0, 0, 0); }
        }
    const float inv = 1.f / l;
    bf16* og = OG + ((size_t)g * T + qrow) * 256 + h * 64;
#pragma unroll
    for (int dt = 0; dt < 2; ++dt)
#pragma unroll
        for (int q4 = 0; q4 < 4; ++q4) { v2u w2; w2.x = pk2(O[dt][4 * q4] * inv, O[dt][4 * q4 + 1] * inv); w2.y = pk2(O[dt][4 * q4 + 2] * inv, O[dt][4 * q4 + 3] * inv);
            *(v2u*)(og + 32 * dt + 8 * q4 + 4 * hi) = w2; }
    if (hi == 0) { float* ml = ML + (((size_t)g * T + qrow) * 4 + h) * 2; ml[0] = mx; ml[1] = l; }
}

__device__ __forceinline__ void attn_sample_task(const Args& a, const bf16* Q, const bf16* Kb, const bf16* Vb, bf16* OG, float* ML, int task, int lane) {
    const int b = task / 12, g = (task % 12) >> 2, s = task & 3;
    const int W = 128 << (2 * g), d = 1 << (2 * g);
    const float* ck = a.in[2 + 2 * g] + (size_t)b * W * 256 + lane * 4; const float* cv = a.in[3 + 2 * g] + (size_t)b * W * 256 + lane * 4;
    const size_t row = (size_t)TP + b * 4 + s; const int head = lane >> 4, dl = (lane & 15) * 4;
    const int hcol = (4 * g + head) * 64 + dl;
    float q[4]; { const v2u qw = *(const v2u*)(Q + row * 768 + hcol); q[0] = bfl(qw.x); q[1] = bfh(qw.x); q[2] = bfl(qw.y); q[3] = bfh(qw.y); }
    float m = -INFINITY, l = 0.f, o[4] = {0.f, 0.f, 0.f, 0.f};
#pragma unroll 1
    for (int j0 = 0; j0 < 136; j0 += 8) {
        f32x4 kk[8], vv[8];
#pragma unroll
        for (int jj = 0; jj < 8; ++jj) { const int j = j0 + jj; int idx = W + s - d * j; if (j > 128) idx = 0;
            if (idx >= W) { const size_t r2 = (size_t)TP + b * 4 + (idx - W); const v2u kw = *(const v2u*)(Kb + r2 * 768 + hcol), vw = *(const v2u*)(Vb + r2 * 768 + hcol);
                kk[jj] = (f32x4){bfl(kw.x), bfh(kw.x), bfl(kw.y), bfh(kw.y)}; vv[jj] = (f32x4){bfl(vw.x), bfh(vw.x), bfl(vw.y), bfh(vw.y)}; }
            else { kk[jj] = *(const f32x4*)(ck + (size_t)idx * 256); vv[jj] = *(const f32x4*)(cv + (size_t)idx * 256); } }
        float sc[8]; float cm = -INFINITY;
#pragma unroll
        for (int jj = 0; jj < 8; ++jj) { float t = (kk[jj][0] * q[0] + kk[jj][1] * q[1]) + (kk[jj][2] * q[2] + kk[jj][3] * q[3]);
            t += __shfl_xor(t, 1); t += __shfl_xor(t, 2); t += __shfl_xor(t, 4); t += __shfl_xor(t, 8);
            sc[jj] = (j0 + jj <= 128) ? t : -INFINITY; cm = fmaxf(cm, sc[jj]); }
        const float mn = fmaxf(m, cm), scale = __builtin_amdgcn_exp2f(m - mn);
        l *= scale; o[0] *= scale; o[1] *= scale; o[2] *= scale; o[3] *= scale;
#pragma unroll
        for (int jj = 0; jj < 8; ++jj) { const float p = __builtin_amdgcn_exp2f(sc[jj] - mn); l += p; o[0] += p * vv[jj][0]; o[1] += p * vv[jj][1]; o[2] += p * vv[jj][2]; o[3] += p * vv[jj][3]; }
        m = mn;
    }
    const float inv = 1.f / l;
    v2u w2; w2.x = pk2(o[0] * inv, o[1] * inv); w2.y = pk2(o[2] * inv, o[3] * inv);
    *(v2u*)(OG + ((size_t)g * T + row) * 256 + head * 64 + dl) = w2;
    if ((lane & 15) == 0) { float* ml = ML + (((size_t)g * T + row) * 4 + head) * 2; ml[0] = m; ml[1] = l; }
}

template <int NTOK, bool SAMPLE> __device__ __forceinline__ void conv_unit(const Args& a, LAS unsigned char* lds, const bf16* U, bf16* CONVF, const float (&cw)[31], int unit, int tid) {
    const int c = tid; float win[NTOK + 30];
    size_t row0;
    if (!SAMPLE) { row0 = (size_t)unit * NTOK; const int t0 = (int)(row0 & 4095);
#pragma unroll
        for (int jr = 0; jr < NTOK + 30; ++jr) { const int t = t0 - 30 + jr; win[jr] = (t >= 0) ? bf2f_g(U[(row0 - 30 + jr) * 512 + c]) : 0.f; } }
    else { row0 = (size_t)TP + (size_t)unit * 4; const float* st = a.in[8] + (size_t)unit * 30 * 512 + c;
#pragma unroll
        for (int jr = 0; jr < 30; ++jr) win[jr] = st[jr * 512];
#pragma unroll
        for (int jr = 0; jr < NTOK; ++jr) win[30 + jr] = bf2f_g(U[(row0 + jr) * 512 + c]); }
    const float cb = a.in[18][c];
    LAS float* yb = (LAS float*)lds;
    __syncthreads();
#pragma unroll
    for (int t = 0; t < NTOK; ++t) { float y = cb;
#pragma unroll
        for (int j = 0; j < 31; ++j) y += cw[j] * win[t + j];
        yb[t * 512 + c] = y; }
    __syncthreads();
    const int w = tid >> 6, lane = tid & 63;
    constexpr int TPW = (NTOK + 7) / 8;
#pragma unroll
    for (int tt = 0; tt < TPW; ++tt) { const int t = w * TPW + tt;
        if (t < NTOK) {
            float y[8]; float s = 0.f;
#pragma unroll
            for (int i = 0; i < 8; ++i) { y[i] = yb[t * 512 + lane + 64 * i]; s += y[i]; }
            const float mu = wave_sum(s) * (1.f / 512.f); float q = 0.f;
#pragma unroll
            for (int i = 0; i < 8; ++i) { y[i] -= mu; q += y[i] * y[i]; }
            const float rstd = __builtin_amdgcn_rsqf(wave_sum(q) * (1.f / 512.f) + 1e-6f);
#pragma unroll
            for (int i = 0; i < 8; ++i) { const int cc = lane + 64 * i; const float z = y[i] * rstd * a.in[19][cc] + a.in[20][cc];
                const float sw = z * __builtin_amdgcn_rcpf(1.f + __builtin_amdgcn_exp2f(-1.4426950408889634f * z));
                CONVF[(row0 + t) * 512 + cc] = (bf16)f2bf(sw); }
        }
    }
}

__device__ __forceinline__ void combine_groups(const bf16* OG, const float* ML, bf16* BATT, size_t gtid, size_t nthr) {
    for (size_t i = gtid; i < (size_t)T * 32; i += nthr) {
        const size_t row = i >> 5; const int c8 = (int)(i & 31), h = c8 >> 3;
        float mg[3], lg[3]; v4u og[3];
#pragma unroll
        for (int g = 0; g < 3; ++g) { const float* ml = ML + (((size_t)g * T + row) * 4 + h) * 2; mg[g] = ml[0]; lg[g] = ml[1]; og[g] = *(const v4u*)(OG + ((size_t)g * T + row) * 256 + c8 * 8); }
        const float M = fmaxf(mg[0], fmaxf(mg[1], mg[2]));
        float wg[3], ws = 0.f;
#pragma unroll
        for (int g = 0; g < 3; ++g) { wg[g] = __builtin_amdgcn_exp2f(mg[g] - M) * lg[g]; ws += wg[g]; }
        const float inv = 1.f / ws; float o[8];
#pragma unroll
        for (int e = 0; e < 8; ++e) o[e] = 0.f;
#pragma unroll
        for (int g = 0; g < 3; ++g) { const float wn = wg[g] * inv;
#pragma unroll
            for (int e = 0; e < 4; ++e) { o[2 * e] += wn * bfl(og[g][e]); o[2 * e + 1] += wn * bfh(og[g][e]); } }
        v4u w; w.x = pk2(o[0], o[1]); w.y = pk2(o[2], o[3]); w.z = pk2(o[4], o[5]); w.w = pk2(o[6], o[7]);
        *(v4u*)(BATT + row * 256 + c8 * 8) = w;
    }
}

#define XB_TMO      128
#define XB_XCNT(j)  (256  + 64 * (j))
#define XB_XSUB(j)  (1280 + 64 * (j))
#define XB_XGEN(j)  (2304 + 64 * (j))
#define XB_TOP      3328
#define XB_TOPGEN   3392
#define XCD_BAR_WORDS 3456
#define XB_SPIN_CAP (1u << 18)

__device__ __forceinline__ unsigned xb_ld(unsigned* p)              { return __hip_atomic_load(p, __ATOMIC_RELAXED, __HIP_MEMORY_SCOPE_AGENT); }
__device__ __forceinline__ unsigned xb_add(unsigned* p, unsigned v) { return __hip_atomic_fetch_add(p, v, __ATOMIC_RELAXED, __HIP_MEMORY_SCOPE_AGENT); }
__device__ __forceinline__ unsigned xb_xcc_id() { return (unsigned)__builtin_amdgcn_s_getreg((3 << 11) | 20) & 0xFu; }
#define XB_SPIN(cond, bar) do { unsigned _sp = 0; while (cond) { __builtin_amdgcn_s_sleep(1); \
    if ((++_sp & 255u) == 0u) { if (xb_ld(&(bar)[XB_TMO])) break; if (_sp > XB_SPIN_CAP) { atomicAdd(&(bar)[XB_TMO], 1u); break; } } } } while (0)

struct XcdBarrier {
    unsigned* bar; unsigned x;
    volatile LAS unsigned* st;
};

__device__ __forceinline__ XcdBarrier xcd_barrier_post(unsigned* bar, volatile LAS unsigned* st) {
    XcdBarrier b; b.bar = bar; b.x = xb_xcc_id(); b.st = st;
    if (threadIdx.x == 0) (void)xb_add(&bar[XB_XCNT(b.x)], 1u);
    return b;
}
__device__ __forceinline__ void xcd_barrier_complete(unsigned* bar, unsigned x, unsigned& nloc, unsigned& nx) {
    const unsigned G = gridDim.x * gridDim.y * gridDim.z;
    unsigned sum, cnt, mine, sp = 0u;
    for (;;) {
        sum = 0u; cnt = 0u; mine = 0u;
#pragma unroll
        for (unsigned j = 0; j < 16; ++j) { const unsigned c = xb_ld(&bar[XB_XCNT(j)]); sum += c; cnt += (c > 0u) ? 1u : 0u; mine = (j == x) ? c : mine; }
        if (sum == G) break;
        __builtin_amdgcn_s_sleep(1);
        if ((++sp & 255u) == 0u) { if (xb_ld(&bar[XB_TMO])) break; if (sp > XB_SPIN_CAP) { atomicAdd(&bar[XB_TMO], 1u); break; } }
    }
    nloc = mine > 0u ? mine : 1u; nx = cnt > 0u ? cnt : 1u;
}

__device__ __forceinline__ void xcd_barrier(const XcdBarrier& b) {
    asm volatile("s_waitcnt vmcnt(0)" ::: "memory");
    __syncthreads();
    if (threadIdx.x == 0) {
        unsigned* bar = b.bar;
        __builtin_amdgcn_s_waitcnt(0);
        unsigned nloc = b.st[0], nx = b.st[1];
        if (nloc == 0u) { xcd_barrier_complete(bar, b.x, nloc, nx); b.st[0] = nloc; b.st[1] = nx; }
        const unsigned old = xb_add(&bar[XB_XSUB(b.x)], 1u);
        const unsigned gen = old / nloc;
        if (old + 1u == (gen + 1u) * nloc) {
            __builtin_amdgcn_fence(__ATOMIC_RELEASE, "agent");
            asm volatile("s_waitcnt vmcnt(0)" ::: "memory");
            const unsigned og = xb_add(&bar[XB_TOP], 1u);
            const unsigned tg = og / nx;
            if (og + 1u == (tg + 1u) * nx) xb_add(&bar[XB_TOPGEN], 1u);
            else XB_SPIN(xb_ld(&bar[XB_TOPGEN]) == tg, bar);
            __builtin_amdgcn_fence(__ATOMIC_ACQUIRE, "agent");
            xb_add(&bar[XB_XGEN(b.x)], 1u);
            asm volatile("s_waitcnt vmcnt(0)" ::: "memory");
        } else {
            XB_SPIN(xb_ld(&bar[XB_XGEN(b.x)]) == gen, bar);
            __builtin_amdgcn_fence(__ATOMIC_ACQUIRE, "agent");
            asm volatile("s_waitcnt vmcnt(0)" ::: "memory");
        }
    }
    __syncthreads();
}
__global__ void __launch_bounds__(512, 2) mk_fwd(Args args) {
    extern __shared__ __attribute__((aligned(16))) unsigned char lds_raw[];
    LAS unsigned char* lds = (LAS unsigned char*)lds_raw;
    const int tid = threadIdx.x, G = gridDim.x, bid = blockIdx.x;
    unsigned char* ws = args.ws;
    const int lo = args.ph_lo, hi = args.ph_hi;
#define IN(k) (lo <= (k) && (k) < hi)
#define SEAM(k) do { if (IN(k) && IN((k) + 1)) { xcd_barrier(bar); } } while (0)
    volatile LAS unsigned* MISC = (volatile LAS unsigned*)(lds + 131072);
    if (tid < 64) MISC[tid] = 0u;
    __syncthreads();
    unsigned* fctl = (unsigned*)(ws + WS_CTL);
    XcdBarrier bar; bar.bar = (unsigned*)(ws + WS_BAR); bar.x = 0; bar.st = nullptr;
    if (hi - lo > 1) bar = xcd_barrier_post((unsigned*)(ws + WS_BAR), MISC + 8);
    float* rss0 = (float*)(ws + WS_RSS0); float* rss1 = (float*)(ws + WS_RSS1); float* rss2 = (float*)(ws + WS_RSS2);
    bf16* XB = (bf16*)(ws + WS_XB); bf16* ACT = (bf16*)(ws + WS_ACT); float* X1 = (float*)(ws + WS_X1); bf16* X1B = (bf16*)(ws + WS_X1B);
    bf16* Ub = (bf16*)(ws + WS_U); bf16* Qb = (bf16*)(ws + WS_Q); bf16* Kb = (bf16*)(ws + WS_K); bf16* Vb = (bf16*)(ws + WS_V); bf16* Gb = (bf16*)(ws + WS_G);
    bf16* CONVF = (bf16*)(ws + WS_CONVF); bf16* OG = (bf16*)(ws + WS_OG); float* ML = (float*)(ws + WS_ML); bf16* BATT = (bf16*)(ws + WS_BATT);
    float* TMP = (float*)(ws + WS_TMP); bf16* MIX = (bf16*)(ws + WS_MIX); float* X2 = (float*)(ws + WS_X2); bf16* X2B = (bf16*)(ws + WS_X2B);

    if (IN(0)) { p0_prologue(args, lds, G, bid, tid); }
    SEAM(0);
    if (IN(1)) {
        pg8::Gemm g{XB, (const bf16*)(ws + WS_W1), T, 2 * FF, D}; pg8::StaticOrder S; S.init(T, 2 * FF, G, bid);
        pg8::EpiSwiGLU E{rss0, ACT};
        pg8::gemm_phase<pg8::EpiSwiGLU, pg8::StaticOrder, true, true>(lds, g, S, E);
        filler(args, fctl, 1, units_of((T / 256) * (2 * FF / 256), G, bid), (unsigned)((T / 256) * (2 * FF / 256)), MISC, tid);
    }
    SEAM(1);
    if (IN(2)) {
        pg8::Gemm g{ACT, (const bf16*)(ws + WS_W2), T, D, FF}; pg8::StaticOrder S; S.init(T, D, G, bid);
        pg8::EpiResid<true> E{args.in[0], args.in[1] - (size_t)TP * D, X1, X1B, rss1, 0.5f};
        pg8::gemm_phase<pg8::EpiResid<true>, pg8::StaticOrder, true, true>(lds, g, S, E);
        filler(args, fctl, 2, units_of((T / 256) * 4, G, bid), (unsigned)((T / 256) * 4), MISC, tid);
    }
    SEAM(2);
    if (IN(3)) {
        pg8::Gemm g{X1B, (const bf16*)(ws + WS_W3), T, NIN, D}; pg8::StaticOrder S; S.init(T, NIN, G, bid);
        pg8::EpiIn E{rss1, Ub, Qb, Gb, args.in[14], (const float*)(ws + WS_QKN), (const float*)(ws + WS_ROT), args.out};
        pg8::gemm_phase<pg8::EpiIn, pg8::StaticOrder, true, true>(lds, g, S, E);
        filler(args, fctl, 3, units_of((T / 256) * (NIN / 256), G, bid), (unsigned)((T / 256) * (NIN / 256)), MISC, tid);
    }
    SEAM(3);
    if (IN(4)) {
        for (int u = bid; u < 768; u += G) attn_prompt_unit(lds, Qb, Kb, Vb, OG, ML, u, tid);
        for (int u = bid; u < 192; u += G) attn_sample_task(args, Qb, Kb, Vb, OG, ML, u * 8 + (tid >> 6), tid & 63);
        float cw[31];
#pragma unroll
        for (int j = 0; j < 31; ++j) cw[j] = args.in[17][j * 512 + tid];
        for (int u = bid; u < 1024; u += G) conv_unit<16, false>(args, lds, Ub, CONVF, cw, u, tid);
        for (int u = bid; u < 128; u += G) conv_unit<4, true>(args, lds, Ub, CONVF, cw, u, tid);
    }
    SEAM(4);
    if (IN(5)) {
        combine_groups(OG, ML, BATT, (size_t)bid * 512 + tid, (size_t)G * 512);
        __syncthreads();
        pg8::Gemm g{CONVF, (const bf16*)(ws + WS_W4A), T, D, 512}; pg8::StaticOrder S; S.init(T, D, G, bid);
        pg8::EpiGateA E{Gb, TMP};
        pg8::gemm_phase<pg8::EpiGateA, pg8::StaticOrder, true, true>(lds, g, S, E);
        filler(args, fctl, 5, units_of((T / 256) * 4, G, bid), (unsigned)((T / 256) * 4), MISC, tid);
    }
    SEAM(5);
    if (IN(6)) {
        pg8::Gemm g{BATT, (const bf16*)(ws + WS_W4B), T, D, 256}; pg8::StaticOrder S; S.init(T, D, G, bid);
        pg8::EpiGateB E{Gb, TMP, MIX};
        pg8::gemm_phase<pg8::EpiGateB, pg8::StaticOrder, true, true>(lds, g, S, E);
        filler(args, fctl, 6, units_of((T / 256) * 4, G, bid), (unsigned)((T / 256) * 4), MISC, tid);
    }
    SEAM(6);
    if (IN(7)) {
        pg8::Gemm g{MIX, (const bf16*)(ws + WS_W5), T, D, D}; pg8::StaticOrder S; S.init(T, D, G, bid);
        pg8::EpiResid<true> E{X1, X1, X2, X2B, rss2, 1.0f};
        pg8::gemm_phase<pg8::EpiResid<true>, pg8::StaticOrder, true, true>(lds, g, S, E);
        filler(args, fctl, 7, units_of((T / 256) * 4, G, bid), (unsigned)((T / 256) * 4), MISC, tid);
    }
    SEAM(7);
    if (IN(8)) {
        pg8::Gemm g{X2B, (const bf16*)(ws + WS_W6), T, 2 * FF, D}; pg8::StaticOrder S; S.init(T, 2 * FF, G, bid);
        pg8::EpiSwiGLU E{rss2, ACT};
        pg8::gemm_phase<pg8::EpiSwiGLU, pg8::StaticOrder, true, true>(lds, g, S, E);
        filler(args, fctl, 8, units_of((T / 256) * (2 * FF / 256), G, bid), (unsigned)((T / 256) * (2 * FF / 256)), MISC, tid);
    }
    SEAM(8);
    if (IN(9)) {
        pg8::Gemm g{ACT, (const bf16*)(ws + WS_W7), T, D, FF}; pg8::StaticOrder S; S.init(T, D, G, bid);
        pg8::EpiResid<false> E{X2, X2, args.out, nullptr, nullptr, 0.5f};
        pg8::gemm_phase<pg8::EpiResid<false>, pg8::StaticOrder, true, true>(lds, g, S, E);
        filler(args, fctl, 9, units_of((T / 256) * 4, G, bid), 0u, MISC, tid);
    }
#undef IN
#undef SEAM
}

extern "C" void kernel_launch(void* const* d_in, const int* in_sizes, int n_in, void* d_out, int out_size, void* d_ws, size_t ws_size, hipStream_t stream) {
    static int grid = 0;
    if (grid == 0) {
        int dev = 0, cus = 0, per_cu = 0;
        if (n_in != 27 || ws_size < WS_END) { fprintf(stderr, "kernel_launch: unexpected n_in %d / ws %zu (need %zu)\n", n_in, ws_size, (size_t)WS_END); grid = -1; return; }
        (void)hipGetDevice(&dev);
        (void)hipDeviceGetAttribute(&cus, hipDeviceAttributeMultiprocessorCount, dev);
        if (hipFuncSetAttribute((const void*)mk_fwd, hipFuncAttributeMaxDynamicSharedMemorySize, LDS_BYTES) != hipSuccess) { fprintf(stderr, "kernel_launch: hipFuncSetAttribute failed\n"); grid = -1; return; }
        if (hipOccupancyMaxActiveBlocksPerMultiprocessor(&per_cu, (const void*)mk_fwd, 512, LDS_BYTES) != hipSuccess || per_cu < 1) { fprintf(stderr, "kernel_launch: occupancy query failed (%d)\n", per_cu); per_cu = 1; }
        (void)hipGetLastError();
        grid = cus;
        fprintf(stderr, "kernel_launch: cus %d per_cu %d grid %d\n", cus, per_cu, grid);
    }
    if (grid < 0) return;
    Args a{};
    for (int i = 0; i < 27; ++i) a.in[i] = (const float*)d_in[i];
    a.out = (float*)d_out; a.ws = (unsigned char*)d_ws;
#if MK_N_LAUNCHES == 1
    a.ph_lo = 0; a.ph_hi = N_PHASES;
    if (hipMemsetAsync((char*)d_ws + WS_BAR, 0, WS_BAR_BYTES, stream) != hipSuccess) { fprintf(stderr, "kernel_launch: memset failed\n"); return; }
    hipLaunchKernelGGL(mk_fwd, dim3(grid), dim3(512), LDS_BYTES, stream, a);
#else
    for (int p = 0; p < N_PHASES; ++p) { a.ph_lo = p; a.ph_hi = p + 1; hipLaunchKernelGGL(mk_fwd, dim3(grid), dim3(512), LDS_BYTES, stream, a); }
#endif
}
```

```cpp
#include <hip/hip_runtime.h>
#include <cstdio>
#include <cstdint>
namespace pg8 {
#define PG8_LAS __attribute__((address_space(3)))
typedef unsigned short bf16_t;
typedef short bf16x8 __attribute__((ext_vector_type(8)));
typedef float f32x4 __attribute__((ext_vector_type(4)));
typedef unsigned u32x4 __attribute__((ext_vector_type(4)));
constexpr int BM = 256, BK = 64, HALF = 128, HTB = HALF * BK * 2  , STAGE_BYTES = 8 * HTB, NXCD = 8, WGM = 8;

__host__ __device__ __forceinline__ int lds_byte(int r, int c) { const int st = (r >> 4) * 2 + (c >> 5), rr = r & 15, cc = c & 31, ob = rr * 64 + cc * 2; return st * 1024 + (ob ^ (((ob >> 9) & 1) << 5)); }
__host__ __device__ __forceinline__ void stage_rc(int b, int& R, int& C) { const int st = b / 1024, sb = b % 1024, swz = sb ^ (((sb >> 9) & 1) << 5); R = (st >> 1) * 16 + swz / 64; C = (st & 1) * 32 + (swz % 64) / 2; }
__host__ __device__ __forceinline__ int perm32(int rho) { const int n = rho >> 4, i = rho & 15; return 8 * (i >> 2) + 4 * n + (i & 3); }

struct Unit { int pm, pn; };
struct Gemm { const bf16_t* A; const bf16_t* Bt; int M, N, K; };

struct StaticOrder {
    int nM, nN, nwg, G, c;
    __host__ __device__ void init(int M, int N, int G_, int c_) { nM = M / BM; nN = N / BM; nwg = nM * nN; G = G_; c = c_; }
    __host__ __device__ bool next(int i, Unit& u) const {
        const long L = (long)i * G + c; if (L >= nwg) return false;
        int wgid = (int)L; { const int q = nwg / NXCD, r = nwg % NXCD, xcd = wgid % NXCD, off = wgid / NXCD; wgid = (xcd < r ? xcd * (q + 1) : r * (q + 1) + (xcd - r) * q) + off; }
        const int nig = WGM * nN, gid = wgid / nig, fm = gid * WGM, gsz = (nM - fm) < WGM ? (nM - fm) : WGM;
        u.pm = fm + ((wgid % nig) % gsz); u.pn = (wgid % nig) / gsz; return true;
    }
    __device__ __forceinline__ void a_ready(const Unit&) const {}
    __device__ __forceinline__ void done(const Unit&) const {}
};

__device__ __forceinline__ unsigned cvt_pk_bf16(float lo, float hi) { unsigned r; asm volatile("v_cvt_pk_bf16_f32 %0, %1, %2" : "=v"(r) : "v"(lo), "v"(hi)); return r; }
typedef float f32x2 __attribute__((ext_vector_type(2)));
typedef unsigned u32x2 __attribute__((ext_vector_type(2)));
struct SubOrder {
    int nM, nN, nwg, G, c, pm_off;
    __host__ __device__ void init(int nM_, int nN_, int pm_off_, int G_, int c_) { nM = nM_; nN = nN_; nwg = (c_ >= 0 && c_ < G_) ? nM * nN : 0; G = G_; c = c_; pm_off = pm_off_; }
    __host__ __device__ bool next(int i, Unit& u) const {
        const long L = (long)i * G + c; if (c < 0 || L >= nwg) return false;
        int wgid = (int)L; { const int q = nwg / NXCD, r = nwg % NXCD, xcd = wgid % NXCD, off = wgid / NXCD; wgid = (xcd < r ? xcd * (q + 1) : r * (q + 1) + (xcd - r) * q) + off; }
        const int nig = WGM * nN, gid = wgid / nig, fm = gid * WGM, gsz = (nM - fm) < WGM ? (nM - fm) : WGM;
        u.pm = pm_off + fm + ((wgid % nig) % gsz); u.pn = (wgid % nig) / gsz; return true;
    }
    __device__ __forceinline__ void a_ready(const Unit&) const {}
    __device__ __forceinline__ void done(const Unit&) const {}
};
constexpr float NEPS = 1e-6f;
__device__ __forceinline__ float sigmoid_f(float x) { return __builtin_amdgcn_rcpf(1.f + __builtin_amdgcn_exp2f(-1.4426950408889634f * x)); }
__device__ __forceinline__ float silu_f(float x) { return x * sigmoid_f(x); }
__device__ __forceinline__ float bf2f(unsigned short h) { return __builtin_bit_cast(float, (unsigned)h << 16); }
__device__ __forceinline__ float bflo(unsigned w) { return __builtin_bit_cast(float, w << 16); }
__device__ __forceinline__ float bfhi(unsigned w) { return __builtin_bit_cast(float, w & 0xffff0000u); }

struct EpiSwiGLU {
    static constexpr bool PERM = false, AFTER_DRAIN = false;
    const float* rss; bf16_t* O;
    __device__ __forceinline__ void operator()(const f32x4 (&acc)[2][2][4][2], const Unit& u, int wr, int wc, int fr, int fq) const {
        const int row0 = u.pm * BM + wr * 64 + fr, col0 = u.pn * 128 + wc * 32 + 8 * fq;
#pragma unroll
        for (int ai = 0; ai < 2; ++ai)
#pragma unroll
            for (int m = 0; m < 4; ++m) {
                const int row = row0 + ai * HALF + m * 16;
                const float r = __builtin_amdgcn_rsqf(rss[row] * (1.f / 1024.f) + NEPS);
                float o[8];
#pragma unroll
                for (int n = 0; n < 2; ++n)
#pragma unroll
                    for (int e = 0; e < 4; ++e) o[4 * n + e] = silu_f(acc[ai][0][m][n][e] * r) * (acc[ai][1][m][n][e] * r);
                u32x4 w; w.x = cvt_pk_bf16(o[0], o[1]); w.y = cvt_pk_bf16(o[2], o[3]); w.z = cvt_pk_bf16(o[4], o[5]); w.w = cvt_pk_bf16(o[6], o[7]);
                *(u32x4*)(O + (size_t)row * 2816 + col0) = w;
            }
    }
};

template <bool NEXT> struct EpiResid {
    static constexpr bool PERM = false, AFTER_DRAIN = false;
    const float* base_p; const float* base_s; float* out; bf16_t* outb; float* rss; float alpha;
    __device__ __forceinline__ void operator()(const f32x4 (&acc)[2][2][4][2], const Unit& u, int wr, int wc, int fr, int fq) const {
        const int row0 = u.pm * BM + wr * 64 + fr, col0 = u.pn * BM + wc * 32 + 8 * fq;
        const float* base = (u.pm < 64) ? base_p : base_s;
#pragma unroll
        for (int ai = 0; ai < 2; ++ai)
#pragma unroll
            for (int m = 0; m < 4; ++m) {
                const int row = row0 + ai * HALF + m * 16; float ss = 0.f;
#pragma unroll
                for (int bj = 0; bj < 2; ++bj) {
                    const size_t off = (size_t)row * 1024 + col0 + bj * HALF;
                    const f32x4 b0 = *(const f32x4*)(base + off), b1 = *(const f32x4*)(base + off + 4);
                    const f32x4 v0 = b0 + acc[ai][bj][m][0] * alpha, v1 = b1 + acc[ai][bj][m][1] * alpha;
                    *(f32x4*)(out + off) = v0; *(f32x4*)(out + off + 4) = v1;
                    if (NEXT) {
                        u32x4 w; w.x = cvt_pk_bf16(v0[0], v0[1]); w.y = cvt_pk_bf16(v0[2], v0[3]); w.z = cvt_pk_bf16(v1[0], v1[1]); w.w = cvt_pk_bf16(v1[2], v1[3]);
                        *(u32x4*)(outb + off) = w;
                        ss += (v0[0] * v0[0] + v0[1] * v0[1]) + (v0[2] * v0[2] + v0[3] * v0[3]) + (v1[0] * v1[0] + v1[1] * v1[1]) + (v1[2] * v1[2] + v1[3] * v1[3]);
                    }
                }
                if (NEXT) { ss += __shfl_xor(ss, 16); ss += __shfl_xor(ss, 32); if (fq == 0) unsafeAtomicAdd(rss + row, ss); }
            }
    }
};

struct EpiGateA {
    static constexpr bool PERM = false, AFTER_DRAIN = false;
    const bf16_t* gates; float* tmp;
    __device__ __forceinline__ void operator()(const f32x4 (&acc)[2][2][4][2], const Unit& u, int wr, int wc, int fr, int fq) const {
        const int row0 = u.pm * BM + wr * 64 + fr, col0 = u.pn * BM + wc * 32 + 8 * fq;
#pragma unroll
        for (int ai = 0; ai < 2; ++ai)
#pragma unroll
            for (int m = 0; m < 4; ++m) {
                const int row = row0 + ai * HALF + m * 16;
#pragma unroll
                for (int bj = 0; bj < 2; ++bj) {
                    const int c = col0 + bj * HALF;
                    const u32x4 g = *(const u32x4*)(gates + (size_t)row * 2048 + c);
                    f32x4 v0 = acc[ai][bj][m][0], v1 = acc[ai][bj][m][1];
                    v0[0] *= bflo(g.x); v0[1] *= bfhi(g.x); v0[2] *= bflo(g.y); v0[3] *= bfhi(g.y);
                    v1[0] *= bflo(g.z); v1[1] *= bfhi(g.z); v1[2] *= bflo(g.w); v1[3] *= bfhi(g.w);
                    *(f32x4*)(tmp + (size_t)row * 1024 + c) = v0; *(f32x4*)(tmp + (size_t)row * 1024 + c + 4) = v1;
                }
            }
    }
};
struct EpiGateB {
    static constexpr bool PERM = false, AFTER_DRAIN = false;
    const bf16_t* gates; const float* tmp; bf16_t* mix;
    __device__ __forceinline__ void operator()(const f32x4 (&acc)[2][2][4][2], const Unit& u, int wr, int wc, int fr, int fq) const {
        const int row0 = u.pm * BM + wr * 64 + fr, col0 = u.pn * BM + wc * 32 + 8 * fq;
#pragma unroll
        for (int ai = 0; ai < 2; ++ai)
#pragma unroll
            for (int m = 0; m < 4; ++m) {
                const int row = row0 + ai * HALF + m * 16;
#pragma unroll
                for (int bj = 0; bj < 2; ++bj) {
                    const int c = col0 + bj * HALF;
                    const u32x4 g = *(const u32x4*)(gates + (size_t)row * 2048 + 1024 + c);
                    const f32x4 t0 = *(const f32x4*)(tmp + (size_t)row * 1024 + c), t1 = *(const f32x4*)(tmp + (size_t)row * 1024 + c + 4);
                    f32x4 v0 = acc[ai][bj][m][0], v1 = acc[ai][bj][m][1];
                    v0[0] = t0[0] + v0[0] * bflo(g.x); v0[1] = t0[1] + v0[1] * bfhi(g.x); v0[2] = t0[2] + v0[2] * bflo(g.y); v0[3] = t0[3] + v0[3] * bfhi(g.y);
                    v1[0] = t1[0] + v1[0] * bflo(g.z); v1[1] = t1[1] + v1[1] * bfhi(g.z); v1[2] = t1[2] + v1[2] * bflo(g.w); v1[3] = t1[3] + v1[3] * bfhi(g.w);
                    u32x4 w; w.x = cvt_pk_bf16(v0[0], v0[1]); w.y = cvt_pk_bf16(v0[2], v0[3]); w.z = cvt_pk_bf16(v1[0], v1[1]); w.w = cvt_pk_bf16(v1[2], v1[3]);
                    *(u32x4*)(mix + (size_t)row * 1024 + c) = w;
                }
            }
    }
};

struct EpiIn {
    static constexpr bool PERM = false, AFTER_DRAIN = false;
    const float* rss; bf16_t *U, *Q, *G; const float *b_gate, *qk_norm, *rot; float* out;
    static constexpr size_t O_KP0 = 17301504;
    __device__ __forceinline__ void operator()(const f32x4 (&acc)[2][2][4][2], const Unit& u, int wr, int wc, int fr, int fq) const {
        const int row0 = u.pm * BM + wr * 64 + fr; const int pn = u.pn; const bool samp = u.pm >= 64;
        if (pn < 4) {
            const int col0 = pn * 128 + wc * 32 + 8 * fq;
#pragma unroll
            for (int ai = 0; ai < 2; ++ai)
#pragma unroll
                for (int m = 0; m < 4; ++m) {
                    const int row = row0 + ai * HALF + m * 16; const float r = __builtin_amdgcn_rsqf(rss[row] * (1.f / 1024.f) + NEPS);
                    float o[8];
#pragma unroll
                    for (int n = 0; n < 2; ++n)
#pragma unroll
                        for (int e = 0; e < 4; ++e) o[4 * n + e] = (acc[ai][0][m][n][e] * r) * sigmoid_f(acc[ai][1][m][n][e] * r);
                    u32x4 w; w.x = cvt_pk_bf16(o[0], o[1]); w.y = cvt_pk_bf16(o[2], o[3]); w.z = cvt_pk_bf16(o[4], o[5]); w.w = cvt_pk_bf16(o[6], o[7]);
                    *(u32x4*)(U + (size_t)row * 512 + col0) = w;
                    float* cp = nullptr;
                    if (!samp) { const int t = row & 4095, b = row >> 12; if (t >= 4066) cp = out + 22806528 + ((size_t)(b * 30 + (t - 4066))) * 512 + col0; }
                    else { const int sr = row - 16384; cp = out + 199028736 + ((size_t)((sr >> 2) * 30 + 26 + (sr & 3))) * 512 + col0; }
                    if (cp) { *(f32x4*)cp = (f32x4){o[0], o[1], o[2], o[3]}; *(f32x4*)(cp + 4) = (f32x4){o[4], o[5], o[6], o[7]}; }
                }
        } else if (pn < 13) {
            const int kind = (pn - 4) / 3, g = (pn - 4) % 3;
            const int W = 128 << (2 * g);
            const int hcol = (4 * g + wc) * 64;
            int dim0[2][2];
#pragma unroll
            for (int n = 0; n < 2; ++n) { dim0[0][n] = (kind < 2 && fq < 2) ? 4 * fq + 8 * n : 8 * fq + 4 * n; dim0[1][n] = 32 + 8 * fq + 4 * n; }
            f32x4 gn[2][2];
            if (kind < 2) { const float* nw = qk_norm + kind * 768 + hcol;
#pragma unroll
                for (int bj = 0; bj < 2; ++bj)
#pragma unroll
                    for (int n = 0; n < 2; ++n) gn[bj][n] = *(const f32x4*)(nw + dim0[bj][n]); }
            bf16_t* dstb = Q + (size_t)kind * ((size_t)16896 * 768);
            size_t okp = 17301504, oks = 22867968;
            for (int gg = 0; gg < g; ++gg) { okp += (size_t)2 * 4 * (128 << (2 * gg)) * 256; oks += (size_t)2 * 128 * (128 << (2 * gg)) * 256; }
            if (kind == 2) { okp += (size_t)4 * W * 256; oks += (size_t)128 * W * 256; }
#pragma unroll
            for (int ai = 0; ai < 2; ++ai)
#pragma unroll
                for (int m = 0; m < 4; ++m) {
                    const int row = row0 + ai * HALF + m * 16; const float r = __builtin_amdgcn_rsqf(rss[row] * (1.f / 1024.f) + NEPS);
                    f32x4 v[2][2];
#pragma unroll
                    for (int bj = 0; bj < 2; ++bj)
#pragma unroll
                        for (int n = 0; n < 2; ++n) v[bj][n] = acc[ai][bj][m][n] * r;
                    int posidx, b, tt; float* cdst = nullptr;
                    if (!samp) { tt = row & 4095; b = row >> 12; posidx = tt; if (kind >= 1 && tt >= 4096 - W) cdst = out + okp + ((size_t)(b * W + (tt - (4096 - W))) * 4 + wc) * 64; }
                    else { const int sr = row - 16384; b = sr >> 2; tt = sr & 3; posidx = 4096 + tt; if (kind >= 1) cdst = out + oks + ((size_t)(b * W + (W - 4 + tt)) * 4 + wc) * 64; }
                    if (kind < 2) {
                        float ss = 0.f;
#pragma unroll
                        for (int bj = 0; bj < 2; ++bj)
#pragma unroll
                            for (int n = 0; n < 2; ++n) ss += (v[bj][n][0] * v[bj][n][0] + v[bj][n][1] * v[bj][n][1]) + (v[bj][n][2] * v[bj][n][2] + v[bj][n][3] * v[bj][n][3]);
                        ss += __shfl_xor(ss, 16); ss += __shfl_xor(ss, 32);
                        const float rn = __builtin_amdgcn_rsqf(ss * (1.f / 64.f) + NEPS);
#pragma unroll
                        for (int bj = 0; bj < 2; ++bj)
#pragma unroll
                            for (int n = 0; n < 2; ++n) v[bj][n] = v[bj][n] * rn * gn[bj][n];
                        if (fq < 2) {
                            const f32x4 cs = *(const f32x4*)(rot + (size_t)posidx * 16 + 4 * fq), sn = *(const f32x4*)(rot + (size_t)posidx * 16 + 8 + 4 * fq);
                            const f32x4 x1 = v[0][0], x2 = v[0][1];
                            v[0][0] = x1 * cs - x2 * sn; v[0][1] = x2 * cs + x1 * sn;
                        }
                        if (kind == 0) {
#pragma unroll
                            for (int bj = 0; bj < 2; ++bj)
#pragma unroll
                                for (int n = 0; n < 2; ++n) v[bj][n] = v[bj][n] * (0.125f * 1.4426950408889634f);
                        }
                    }
#pragma unroll
                    for (int bj = 0; bj < 2; ++bj)
#pragma unroll
                        for (int n = 0; n < 2; ++n) {
                            u32x2 w; w.x = cvt_pk_bf16(v[bj][n][0], v[bj][n][1]); w.y = cvt_pk_bf16(v[bj][n][2], v[bj][n][3]);
                            *(u32x2*)(dstb + (size_t)row * 768 + hcol + dim0[bj][n]) = w;
                            if (cdst) *(f32x4*)(cdst + dim0[bj][n]) = v[bj][n];
                        }
                }
        } else {
            const int col0 = (pn - 13) * 256 + wc * 32 + 8 * fq;
            f32x4 bv[2][2];
#pragma unroll
            for (int bj = 0; bj < 2; ++bj)
#pragma unroll
                for (int n = 0; n < 2; ++n) bv[bj][n] = *(const f32x4*)(b_gate + col0 + bj * HALF + 4 * n);
#pragma unroll
            for (int ai = 0; ai < 2; ++ai)
#pragma unroll
                for (int m = 0; m < 4; ++m) {
                    const int row = row0 + ai * HALF + m * 16; const float r = __builtin_amdgcn_rsqf(rss[row] * (1.f / 1024.f) + NEPS);
#pragma unroll
                    for (int bj = 0; bj < 2; ++bj) {
                        float o[8];
#pragma unroll
                        for (int n = 0; n < 2; ++n)
#pragma unroll
                            for (int e = 0; e < 4; ++e) o[4 * n + e] = sigmoid_f(acc[ai][bj][m][n][e] * r + bv[bj][n][e]);
                        u32x4 w; w.x = cvt_pk_bf16(o[0], o[1]); w.y = cvt_pk_bf16(o[2], o[3]); w.z = cvt_pk_bf16(o[4], o[5]); w.w = cvt_pk_bf16(o[6], o[7]);
                        *(u32x4*)(G + (size_t)row * 2048 + col0 + bj * HALF) = w;
                    }
                }
        }
    }
};
template <class Epi, class Sched, bool ALIGN_EPI = false, bool SP2 = false>
__device__ __forceinline__ void gemm_phase(PG8_LAS unsigned char* lds, const Gemm g, const Sched& S, const Epi& E) {
    int tid_o = threadIdx.x; asm volatile("" : "+v"(tid_o));
    const int tid = tid_o, wid = __builtin_amdgcn_readfirstlane(tid >> 6), lane = tid & 63, wr = wid >> 2, wc = wid & 3, fr = lane & 15, fq = lane >> 4;
    const int K = g.K, nt = K / BK;
    unsigned voffA[2], voffB[2];
#pragma unroll
    for (int i = 0; i < 2; ++i) { int R, C; stage_rc(tid * 16 + i * 8192, R, C); const int Rb = Epi::PERM ? ((R & ~31) + perm32(R & 31)) : R;
        voffA[i] = (unsigned)(R * K + C) * 2u; voffB[i] = (unsigned)(Rb * K + C) * 2u; }
    const size_t kstep = (size_t)(BK * 2);
    const size_t hstep = (size_t)HALF * K * 2;
    const size_t tstep = 2 * hstep;
    const unsigned ldsw = (unsigned)wid * 1024u;
    const int aoff = lds_byte(wr * 64 + fr, fq * 8), boff = lds_byte(wc * 32 + fr, fq * 8);
#define PG8_SA(b, h) (((b) * 2 + (h)) * HTB)
#define PG8_SB(b, h) ((4 + (b) * 2 + (h)) * HTB)
#define PG8_STAGE(bufoff, gbase, voff) do { _Pragma("unroll") for (int _i = 0; _i < 2; ++_i) \
        __builtin_amdgcn_global_load_lds((const unsigned*)((const char*)(gbase) + (voff)[_i]), (PG8_LAS unsigned*)(lds + (bufoff) + ldsw + _i * 8192), 16, 0, 0); } while (0)
#define PG8_LDA(dst, b, h) do { _Pragma("unroll") for (int m = 0; m < 4; ++m) _Pragma("unroll") for (int k = 0; k < 2; ++k) dst[m][k] = *(const PG8_LAS bf16x8*)(lds + PG8_SA(b, h) + aoff + m * 2048 + k * 1024); } while (0)
#define PG8_LDB(dst, b, h) do { _Pragma("unroll") for (int n = 0; n < 2; ++n) _Pragma("unroll") for (int k = 0; k < 2; ++k) dst[n][k] = *(const PG8_LAS bf16x8*)(lds + PG8_SB(b, h) + boff + n * 2048 + k * 1024); } while (0)
#define PG8_MMA(ai, bj, At, Bt) do { __builtin_amdgcn_s_setprio(1); _Pragma("unroll") for (int m = 0; m < 4; ++m) _Pragma("unroll") for (int n = 0; n < 2; ++n) _Pragma("unroll") for (int k = 0; k < 2; ++k) \
        acc[ai][bj][m][n] = __builtin_amdgcn_mfma_f32_16x16x32_bf16(Bt[n][k], At[m][k], acc[ai][bj][m][n], 0, 0, 0); __builtin_amdgcn_s_setprio(0); } while (0)
#define PG8_WAIT_V(n) asm volatile("s_waitcnt vmcnt(" #n ")" ::: "memory")
#define PG8_WAIT_L(n) asm volatile("s_waitcnt lgkmcnt(" #n ")" ::: "memory")
#define PG8_BAR __builtin_amdgcn_s_barrier()
#define PG8_SCHED __builtin_amdgcn_sched_barrier(0)
    Unit cur, nxt; int ui = 0;
    if (!S.next(0, cur)) return;
    f32x4 acc[2][2][4][2];
#pragma unroll
    for (int a = 0; a < 2; ++a)
#pragma unroll
        for (int b = 0; b < 2; ++b)
#pragma unroll
            for (int m = 0; m < 4; ++m)
#pragma unroll
                for (int n = 0; n < 2; ++n) acc[a][b][m][n] = (f32x4){0.f, 0.f, 0.f, 0.f};
    bf16x8 At[4][2], B0[2][2], B1[2][2];
    const char* cA = (const char*)g.A + (size_t)cur.pm * tstep; const char* cB = (const char*)g.Bt + (size_t)cur.pn * tstep;
    S.a_ready(cur);
    if constexpr (SP2) {
        PG8_STAGE(PG8_SB(0, 0), cB, voffB); PG8_STAGE(PG8_SB(0, 1), cB + hstep, voffB); PG8_STAGE(PG8_SA(0, 0), cA, voffA); PG8_STAGE(PG8_SA(0, 1), cA + hstep, voffA);
        if (wr == 1) PG8_BAR;
        PG8_WAIT_V(2); PG8_BAR;
        PG8_STAGE(PG8_SB(1, 0), cB + kstep, voffB); PG8_STAGE(PG8_SA(1, 0), cA + kstep, voffA); PG8_STAGE(PG8_SB(1, 1), cB + hstep + kstep, voffB);
        PG8_WAIT_V(6); PG8_BAR;
    } else {
        PG8_STAGE(PG8_SB(0, 0), cB, voffB); PG8_STAGE(PG8_SA(0, 0), cA, voffA); PG8_STAGE(PG8_SB(0, 1), cB + hstep, voffB); PG8_STAGE(PG8_SA(0, 1), cA + hstep, voffA);
        if (wr == 1) PG8_BAR;
        PG8_WAIT_V(4); PG8_BAR;
        PG8_STAGE(PG8_SB(1, 0), cB + kstep, voffB); PG8_STAGE(PG8_SA(1, 0), cA + kstep, voffA); PG8_STAGE(PG8_SB(1, 1), cB + hstep + kstep, voffB);
        PG8_WAIT_V(6); PG8_BAR;
    }
    for (;;) {
        const bool has_next = S.next(ui + 1, nxt);
        const char* nA = has_next ? (const char*)g.A + (size_t)nxt.pm * tstep : cA; const char* nB = has_next ? (const char*)g.Bt + (size_t)nxt.pn * tstep : cB;
        for (int t = 0; t < nt; t += 2) {
            const bool last = (t == nt - 2);
            const char* a1 = cA + (size_t)(t + 1) * kstep;
            const char* a2 = last ? nA : cA + (size_t)(t + 2) * kstep; const char* b2 = last ? nB : cB + (size_t)(t + 2) * kstep;
            const char* a3 = a2 + kstep; const char* b3 = b2 + kstep;
            if (last && has_next) S.a_ready(nxt);
            if constexpr (SP2) {
            PG8_LDB(B0, 0, 0); PG8_LDB(B1, 0, 1); PG8_SCHED; PG8_LDA(At, 0, 0); PG8_STAGE(PG8_SA(1, 1), a1 + hstep, voffA);
            PG8_WAIT_V(8); PG8_WAIT_L(0); PG8_BAR; PG8_MMA(0, 0, At, B0); PG8_MMA(0, 1, At, B1); PG8_BAR; PG8_SCHED;
            PG8_LDA(At, 0, 1); PG8_STAGE(PG8_SB(0, 0), b2, voffB); PG8_STAGE(PG8_SB(0, 1), b2 + hstep, voffB); PG8_STAGE(PG8_SA(0, 0), a2, voffA);
            PG8_WAIT_V(8); PG8_WAIT_L(0); PG8_BAR; PG8_MMA(1, 0, At, B0); PG8_MMA(1, 1, At, B1); PG8_BAR; PG8_SCHED;
            PG8_LDB(B0, 1, 0); PG8_LDB(B1, 1, 1); PG8_SCHED; PG8_LDA(At, 1, 0); PG8_STAGE(PG8_SA(0, 1), a2 + hstep, voffA);
            PG8_WAIT_V(8); PG8_WAIT_L(0); PG8_BAR; PG8_MMA(0, 0, At, B0); PG8_MMA(0, 1, At, B1); PG8_BAR; PG8_SCHED;
            PG8_LDA(At, 1, 1); PG8_STAGE(PG8_SB(1, 0), b3, voffB); PG8_STAGE(PG8_SB(1, 1), b3 + hstep, voffB); PG8_STAGE(PG8_SA(1, 0), a3, voffA);
            PG8_WAIT_V(8); PG8_WAIT_L(0); PG8_BAR; PG8_MMA(1, 0, At, B0); PG8_MMA(1, 1, At, B1); PG8_BAR; PG8_SCHED;
            } else {
            PG8_LDB(B0, 0, 0); PG8_SCHED; PG8_LDA(At, 0, 0); PG8_STAGE(PG8_SA(1, 1), a1 + hstep, voffA);
            PG8_WAIT_L(8); PG8_BAR; PG8_WAIT_L(0); PG8_MMA(0, 0, At, B0); PG8_BAR; PG8_SCHED;
            PG8_LDB(B1, 0, 1); PG8_STAGE(PG8_SB(0, 0), b2, voffB);
            PG8_BAR; PG8_WAIT_L(0); PG8_MMA(0, 1, At, B1); PG8_BAR;
            PG8_LDA(At, 0, 1); PG8_STAGE(PG8_SA(0, 0), a2, voffA);
            PG8_BAR; PG8_WAIT_L(0); PG8_MMA(1, 0, At, B0); PG8_BAR; PG8_SCHED;
            PG8_STAGE(PG8_SB(0, 1), b2 + hstep, voffB);
            PG8_WAIT_V(6); PG8_BAR; PG8_MMA(1, 1, At, B1); PG8_BAR;
            PG8_LDB(B0, 1, 0); PG8_SCHED; PG8_LDA(At, 1, 0); PG8_STAGE(PG8_SA(0, 1), a2 + hstep, voffA);
            PG8_WAIT_L(8); PG8_BAR; PG8_WAIT_L(0); PG8_MMA(0, 0, At, B0); PG8_BAR; PG8_SCHED;
            PG8_LDB(B1, 1, 1); PG8_STAGE(PG8_SB(1, 0), b3, voffB);
            PG8_BAR; PG8_WAIT_L(0); PG8_MMA(0, 1, At, B1); PG8_BAR;
            PG8_LDA(At, 1, 1); PG8_STAGE(PG8_SA(1, 0), a3, voffA);
            PG8_BAR; PG8_WAIT_L(0); PG8_MMA(1, 0, At, B0); PG8_BAR; PG8_SCHED;
            PG8_STAGE(PG8_SB(1, 1), b3 + hstep, voffB);
            PG8_WAIT_V(6); PG8_BAR; PG8_MMA(1, 1, At, B1); PG8_BAR;
            }
        }
        if constexpr (ALIGN_EPI) { if (wr == 0) PG8_BAR; }
        if constexpr (!Epi::AFTER_DRAIN) { E(acc, cur, wr, wc, fr, fq); S.done(cur); }
        if (!has_next) break;
#pragma unroll
        for (int a = 0; a < 2; ++a)
#pragma unroll
            for (int b = 0; b < 2; ++b)
#pragma unroll
                for (int m = 0; m < 4; ++m)
#pragma unroll
                    for (int n = 0; n < 2; ++n) acc[a][b][m][n] = (f32x4){0.f, 0.f, 0.f, 0.f};
        cur = nxt; cA = nA; cB = nB; ++ui;
        if constexpr (ALIGN_EPI) { if (wr == 1) PG8_BAR; }
    }
    PG8_WAIT_V(0);
    if constexpr (!ALIGN_EPI) { if (wr == 0) PG8_BAR; }
    PG8_BAR;
    if constexpr (Epi::AFTER_DRAIN) { E.fused(acc, cur, wr, wc, fr, fq, lds, wid, lane); S.done(cur); }
#undef PG8_SA
#undef PG8_SB
#undef PG8_STAGE
#undef PG8_LDA
#undef PG8_LDB
#undef PG8_MMA
#undef PG8_WAIT_V
#undef PG8_WAIT_L
#undef PG8_BAR
#undef PG8_SCHED
}
}

#ifndef MK_N_LAUNCHES
#define MK_N_LAUNCHES 1
#endif
constexpr int N_PHASES = 12;
constexpr int TP = 16384, TS = 512, T = TP + TS, D = 1024, FF = 2816, NIN = 5376;
#define GAS __attribute__((address_space(1)))
#define LAS __attribute__((address_space(3)))
typedef unsigned short bf16;
typedef float f32x4 __attribute__((ext_vector_type(4)));
typedef float f32x16 __attribute__((ext_vector_type(16)));
typedef short bf16x8 __attribute__((ext_vector_type(8)));
typedef unsigned v4u __attribute__((ext_vector_type(4)));
typedef unsigned v2u __attribute__((ext_vector_type(2)));

constexpr size_t al256(size_t x) { return (x + 255) & ~(size_t)255; }
constexpr size_t WS_BAR = 0, WS_CTL = 16384, WS_BAR_BYTES = 32768;
constexpr size_t WS_RSS0 = WS_BAR_BYTES, WS_RSS1 = WS_RSS0 + al256((size_t)T * 4), WS_RSS2 = WS_RSS1 + al256((size_t)T * 4);
constexpr size_t WS_ROT = WS_RSS2 + al256((size_t)T * 4);
constexpr size_t WS_QKN = WS_ROT + al256((size_t)4100 * 16 * 4);
constexpr size_t WS_W1 = WS_QKN + al256((size_t)1536 * 4);
constexpr size_t WS_W2 = WS_W1 + (size_t)2 * FF * D * 2;
constexpr size_t WS_W3 = WS_W2 + (size_t)D * FF * 2;
constexpr size_t WS_W4A = WS_W3 + (size_t)NIN * D * 2;
constexpr size_t WS_W4B = WS_W4A + (size_t)D * 512 * 2;
constexpr size_t WS_W5 = WS_W4B + (size_t)D * 256 * 2;
constexpr size_t WS_W6 = WS_W5 + (size_t)D * D * 2;
constexpr size_t WS_W7 = WS_W6 + (size_t)2 * FF * D * 2;
constexpr size_t WS_XB = WS_W7 + (size_t)D * FF * 2;
constexpr size_t WS_ACT = WS_XB + (size_t)T * D * 2;
constexpr size_t WS_X1 = WS_ACT + (size_t)T * FF * 2;
constexpr size_t WS_X1B = WS_X1 + (size_t)T * D * 4;
constexpr size_t WS_U = WS_X1B + (size_t)T * D * 2;
constexpr size_t WS_Q = WS_U + (size_t)T * 512 * 2;
constexpr size_t WS_K = WS_Q + (size_t)T * 768 * 2;
constexpr size_t WS_V = WS_K + (size_t)T * 768 * 2;
constexpr size_t WS_G = WS_V + (size_t)T * 768 * 2;
constexpr size_t WS_CONVF = WS_G + (size_t)T * 2048 * 2;
constexpr size_t WS_OG = WS_CONVF + (size_t)T * 512 * 2;
constexpr size_t WS_ML = WS_OG + (size_t)3 * T * 256 * 2;
constexpr size_t WS_BATT = WS_ML + (size_t)3 * T * 8 * 4;
constexpr size_t WS_TMP = WS_BATT + (size_t)T * 256 * 2;
constexpr size_t WS_MIX = WS_TMP + (size_t)T * D * 4;
constexpr size_t WS_X2 = WS_MIX + (size_t)T * D * 2;
constexpr size_t WS_X2B = WS_X2 + (size_t)T * D * 4;
constexpr size_t WS_END = WS_X2B + (size_t)T * D * 2;

constexpr size_t O_CP = 22806528, O_KS0 = 22867968, O_CS = 199028736;

constexpr int LDS_BYTES = 131072 + 1024;

__device__ __forceinline__ unsigned f2bf(float f) { unsigned u = __builtin_bit_cast(unsigned, f); return (u + 0x7fffu + ((u >> 16) & 1u)) >> 16; }
__device__ __forceinline__ unsigned pk2(float lo, float hi) { return f2bf(lo) | (f2bf(hi) << 16); }
__device__ __forceinline__ float bf2f_g(unsigned short h) { return __builtin_bit_cast(float, (unsigned)h << 16); }
__device__ __forceinline__ float bfl(unsigned w) { return __builtin_bit_cast(float, w << 16); }
__device__ __forceinline__ float bfh(unsigned w) { return __builtin_bit_cast(float, w & 0xffff0000u); }
__device__ __forceinline__ float wave_sum(float v) {
#pragma unroll
    for (int o = 1; o < 64; o <<= 1) v += __shfl_xor(v, o);
    return v;
}

struct Args { const float* in[27]; float* out; unsigned char* ws; int ph_lo, ph_hi; };

__device__ __forceinline__ int perm32(int rho) { const int n = rho >> 4, i = rho & 15; return 8 * (i >> 2) + 4 * n + (i & 3); }
template <int MAP> __device__ __forceinline__ int src_col(int nd) {
    if (MAP == 0) return (nd & ~31) + perm32(nd & 31);
    const int pn = nd >> 8, w = nd & 255, bj = w >> 7, rem = w & 127, wc = rem >> 5, slot = rem & 31;
    if (MAP == 1) return bj * FF + pn * 128 + wc * 32 + perm32(slot);
    if (pn < 4) return bj * 512 + pn * 128 + wc * 32 + perm32(slot);
    if (pn < 13) {
        int dim;
        if (pn < 10 && bj == 0) { const int fq = (slot & 15) >> 2, n = slot >> 4, e = slot & 3; dim = fq < 2 ? 4 * fq + 8 * n + e : 8 * fq + 4 * n + e; }
        else dim = 32 * bj + perm32(slot);
        return 1024 + (pn - 4) * 256 + wc * 64 + dim;
    }
    return 3328 + (pn - 13) * 256 + bj * 128 + wc * 32 + perm32(slot);
}
template <int MAP> __device__ __forceinline__ void p0_transpose_item(const float* W, int K, int Ns, int Nd, bf16* WT, const float* gain, LAS float* scr, int item, int lane) {
    const int nblk = Nd / 32, kb = item / nblk, nb = item % nblk, k0 = 64 * kb, n0 = 32 * nb;
    const int sc = src_col<MAP>(n0 + (lane & 31));
    float tv[32];
#pragma unroll
    for (int i = 0; i < 32; ++i) { const int kk = 2 * i + (lane >> 5); tv[i] = __builtin_nontemporal_load(W + (size_t)(k0 + kk) * Ns + sc); }
    if (gain) {
#pragma unroll
        for (int i = 0; i < 32; ++i) tv[i] *= gain[k0 + 2 * i + (lane >> 5)]; }
#pragma unroll
    for (int i = 0; i < 32; ++i) scr[(2 * i + (lane >> 5)) * 33 + (lane & 31)] = tv[i];
    asm volatile("s_waitcnt lgkmcnt(0)" ::: "memory");
    const int c = lane & 7;
#pragma unroll
    for (int j = 0; j < 4; ++j) { const int n = (lane >> 3) + 8 * j; const LAS float* s = scr + (8 * c) * 33 + n;
        v4u o; o.x = pk2(s[0 * 33], s[1 * 33]); o.y = pk2(s[2 * 33], s[3 * 33]); o.z = pk2(s[4 * 33], s[5 * 33]); o.w = pk2(s[6 * 33], s[7 * 33]);
        *(v4u*)(WT + (size_t)(n0 + n) * K + k0 + 8 * c) = o; }
    asm volatile("s_waitcnt lgkmcnt(0)" ::: "memory");
}
constexpr int N_CHUNKS = 5376 + 128;
__device__ __forceinline__ void copy_chunk(const Args& a, int id, int tid) {
    const float* src; float* dst; int nrows;
    if (id < 5376) {
        int g, r;
        if (id < 256) { g = 0; r = id; } else if (id < 1280) { g = 1; r = id - 256; } else { g = 2; r = id - 1280; }
        const int W = 128 << (2 * g), cpb = 1 << (2 * g);
        const int kv = r / (128 * cpb), r2 = r % (128 * cpb), b = r2 / cpb, ch = r2 % cpb, row0 = ch * 128;
        nrows = (W - 4 - row0) < 128 ? (W - 4 - row0) : 128;
        size_t oks = O_KS0; for (int gg = 0; gg < g; ++gg) oks += (size_t)2 * 128 * (128 << (2 * gg)) * 256;
        oks += (size_t)kv * 128 * W * 256;
        src = a.in[2 + 2 * g + kv] + ((size_t)b * W + 4 + row0) * 256; dst = a.out + oks + ((size_t)b * W + row0) * 256;
    } else { const int b = id - 5376; src = a.in[8] + ((size_t)b * 30 + 4) * 512; dst = a.out + O_CS + (size_t)b * 30 * 512; nrows = 52; }
    const int n4 = nrows * 64; const f32x4* s4 = (const f32x4*)src; f32x4* d4 = (f32x4*)dst;
    f32x4 v[16];
#pragma unroll
    for (int k = 0; k < 16; ++k) { const int i = tid + 512 * k; if (i < n4) v[k] = __builtin_nontemporal_load(s4 + i); }
#pragma unroll
    for (int k = 0; k < 16; ++k) { const int i = tid + 512 * k; if (i < n4) __builtin_nontemporal_store(v[k], d4 + i); }
}
__device__ __forceinline__ void filler(const Args& a, unsigned* ctl, int phase, unsigned my_units, unsigned total_units, volatile LAS unsigned* misc, int tid) {
    unsigned* done = ctl + 64 * (1 + phase);
    if (tid == 0) { if (total_units) __hip_atomic_fetch_add(done, my_units, __ATOMIC_RELAXED, __HIP_MEMORY_SCOPE_AGENT);
        unsigned id = N_CHUNKS;
        if (!total_units || __hip_atomic_load(done, __ATOMIC_RELAXED, __HIP_MEMORY_SCOPE_AGENT) < total_units) id = __hip_atomic_fetch_add(ctl, 1u, __ATOMIC_RELAXED, __HIP_MEMORY_SCOPE_AGENT);
        misc[16] = id; }
    __syncthreads();
    unsigned id = misc[16];
    for (int it = 1; id < (unsigned)N_CHUNKS; ++it) {
        unsigned nxt = N_CHUNKS;
        if (tid == 0) { if (!total_units || __hip_atomic_load(done, __ATOMIC_RELAXED, __HIP_MEMORY_SCOPE_AGENT) < total_units) nxt = __hip_atomic_fetch_add(ctl, 1u, __ATOMIC_RELAXED, __HIP_MEMORY_SCOPE_AGENT); }
        copy_chunk(a, (int)id, tid);
        if (tid == 0) misc[16 + (it & 1)] = nxt;
        __syncthreads();
        id = misc[16 + (it & 1)];
    }
}
__device__ __forceinline__ unsigned grab(unsigned* ctr, volatile LAS unsigned* misc, int& it, int tid) {
    if (tid == 0) misc[20 + (it & 1)] = __hip_atomic_fetch_add(ctr, 1u, __ATOMIC_RELAXED, __HIP_MEMORY_SCOPE_AGENT);
    __syncthreads();
    const unsigned v = (unsigned)__builtin_amdgcn_readfirstlane((int)misc[20 + (it & 1)]); ++it; return v;
}
__device__ __forceinline__ unsigned units_of(int nwg, int G, int c) { return (c >= 0 && c < G && c < nwg) ? (unsigned)((nwg - c + G - 1) / G) : 0u; }

__device__ __forceinline__ void p0_prologue(const Args& a, LAS unsigned char* lds, int G, int bid, int tid) {
    const int wave = tid >> 6, lane = tid & 63;
    LAS float* scr = (LAS float*)(lds + wave * 16384);
    const int gw = bid * 8 + wave, NGW = G * 8;
    unsigned char* ws = a.ws;
    constexpr int I_IN = (D / 64) * (2 * FF / 32), I_OUT = (FF / 64) * (D / 32), I_3 = (D / 64) * (NIN / 32), I_4A = (512 / 64) * (D / 32), I_4B = (256 / 64) * (D / 32), I_5 = (D / 64) * (D / 32);
    constexpr int NITEMS = 2 * I_IN + 2 * I_OUT + I_3 + I_4A + I_4B + I_5;
    for (int it = gw; it < NITEMS; it += NGW) {
        int r = it;
        if (r < I_IN) { p0_transpose_item<1>(a.in[10], D, 2 * FF, 2 * FF, (bf16*)(ws + WS_W1), a.in[9], scr, r, lane); continue; } r -= I_IN;
        if (r < I_IN) { p0_transpose_item<1>(a.in[25], D, 2 * FF, 2 * FF, (bf16*)(ws + WS_W6), a.in[24], scr, r, lane); continue; } r -= I_IN;
        if (r < I_OUT) { p0_transpose_item<0>(a.in[11], FF, D, D, (bf16*)(ws + WS_W2), nullptr, scr, r, lane); continue; } r -= I_OUT;
        if (r < I_OUT) { p0_transpose_item<0>(a.in[26], FF, D, D, (bf16*)(ws + WS_W7), nullptr, scr, r, lane); continue; } r -= I_OUT;
        if (r < I_3) { p0_transpose_item<2>(a.in[13], D, NIN, NIN, (bf16*)(ws + WS_W3), a.in[12], scr, r, lane); continue; } r -= I_3;
        if (r < I_4A) { p0_transpose_item<0>(a.in[21], 512, D, D, (bf16*)(ws + WS_W4A), nullptr, scr, r, lane); continue; } r -= I_4A;
        if (r < I_4B) { p0_transpose_item<0>(a.in[22], 256, D, D, (bf16*)(ws + WS_W4B), nullptr, scr, r, lane); continue; } r -= I_4B;
        p0_transpose_item<0>(a.in[23], D, D, D, (bf16*)(ws + WS_W5), nullptr, scr, r, lane);
    }
    float* rss0 = (float*)(ws + WS_RSS0); float* rss1 = (float*)(ws + WS_RSS1); float* rss2 = (float*)(ws + WS_RSS2);
    bf16* XB = (bf16*)(ws + WS_XB);
    for (int m0 = gw; m0 < T; m0 += 2 * NGW) {
        f32x4 v[2][4]; float ssq[2];
#pragma unroll
        for (int u = 0; u < 2; ++u) { const int m = m0 + u * NGW; if (m < T) { const float* xr = (m < TP) ? a.in[0] + (size_t)m * D : a.in[1] + (size_t)(m - TP) * D; const f32x4* x4 = (const f32x4*)xr + lane;
#pragma unroll
            for (int j = 0; j < 4; ++j) v[u][j] = __builtin_nontemporal_load(x4 + 64 * j); } }
#pragma unroll
        for (int u = 0; u < 2; ++u) { const int m = m0 + u * NGW; if (m < T) { float sq = 0.f;
#pragma unroll
            for (int j = 0; j < 4; ++j) sq += (v[u][j][0] * v[u][j][0] + v[u][j][1] * v[u][j][1]) + (v[u][j][2] * v[u][j][2] + v[u][j][3] * v[u][j][3]);
            ssq[u] = wave_sum(sq);
            if (lane == 0) { rss0[m] = ssq[u]; rss1[m] = 0.f; rss2[m] = 0.f; }
            v2u* o8 = (v2u*)(XB + (size_t)m * D) + lane;
#pragma unroll
            for (int j = 0; j < 4; ++j) { v2u w; w.x = pk2(v[u][j][0], v[u][j][1]); w.y = pk2(v[u][j][2], v[u][j][3]); o8[64 * j] = w; } } }
    }
    const size_t gtid = (size_t)bid * 512 + tid, nthr = (size_t)G * 512;
    float* rot = (float*)(ws + WS_ROT);
    for (size_t i = gtid; i < (size_t)4100 * 8; i += nthr) {
        const int p = (int)(i >> 3), f = (int)(i & 7); const int pos = p < 4096 ? p : 2048 + (p - 4096);
        const double inv = exp2(-(double)f * (18.931568569324174 / 8.0));
        const double rev = (double)pos * inv * 0.15915494309189535;
        const double fr = rev - rint(rev);
        const float ang = (float)(fr * 6.283185307179586);
        rot[(size_t)p * 16 + f] = __builtin_amdgcn_cosf((float)fr); rot[(size_t)p * 16 + 8 + f] = __builtin_amdgcn_sinf((float)fr); (void)ang;
    }
    { float* qkn = (float*)(ws + WS_QKN); for (size_t i = gtid; i < 1536; i += nthr) qkn[i] = i < 768 ? a.in[15][i] : a.in[16][i - 768]; }
}

__device__ __forceinline__ int crow(int r, int hi) { return (r & 3) + 8 * (r >> 2) + 4 * hi; }
constexpr int KS_STRIDE = 144, VT_OFF = 384 * KS_STRIDE, VT_STRIDE = 776;
struct AttnU { int b, g, h, d, r, i0, hc; };
__device__ __forceinline__ AttnU attn_decode(int unit) {
    AttnU u; u.b = unit / 192; int rem = unit % 192; u.g = rem / 64; rem %= 64; u.h = rem / 16; const int x = rem % 16;
    const int dsh = 2 * u.g, nblk = 16 >> dsh; u.d = 1 << dsh; u.r = x / nblk; u.i0 = (x % nblk) * 256; u.hc = (4 * u.g + u.h) * 64; return u;
}
__device__ __forceinline__ void attn_load(const AttnU& u, const bf16* Kb, const bf16* Vb, int tid, v4u (&kv)[6], v4u (&vv)[6]) {
#pragma unroll
    for (int k = 0; k < 6; ++k) { const int q = tid + 512 * k, s = q >> 3, c = q & 7, i = u.i0 - 128 + s;
        if (i >= 0) { const size_t off = ((size_t)u.b * 4096 + (size_t)i * u.d + u.r) * 768 + u.hc + 8 * c; kv[k] = *(const v4u*)(Kb + off); vv[k] = *(const v4u*)(Vb + off); }
        else { kv[k] = (v4u){0u, 0u, 0u, 0u}; vv[k] = (v4u){0u, 0u, 0u, 0u}; } }
}
__device__ __forceinline__ void attn_write(LAS unsigned char* lds, int tid, const v4u (&kv)[6], const v4u (&vv)[6]) {
#pragma unroll
    for (int k = 0; k < 6; ++k) { const int q = tid + 512 * k, s = q >> 3, c = q & 7;
        *(LAS v4u*)(lds + s * KS_STRIDE + 16 * c) = kv[k];
#pragma unroll
        for (int e = 0; e < 4; ++e) { const unsigned w = vv[k][e];
            *(LAS unsigned short*)(lds + VT_OFF + (8 * c + 2 * e) * VT_STRIDE + s * 2) = (unsigned short)(w & 0xffffu);
            *(LAS unsigned short*)(lds + VT_OFF + (8 * c + 2 * e + 1) * VT_STRIDE + s * 2) = (unsigned short)(w >> 16); } }
}
__device__ __forceinline__ void attn_qload(const AttnU& u, const bf16* Q, int tid, bf16x8 (&qf)[4]) {
    const int w = tid >> 6, lane = tid & 63, ql = lane & 31, hi = lane >> 5;
    const size_t qrow = (size_t)u.b * 4096 + (size_t)(u.i0 + 32 * w + ql) * u.d + u.r;
#pragma unroll
    for (int kk = 0; kk < 4; ++kk) qf[kk] = *(const bf16x8*)(Q + qrow * 768 + u.hc + 16 * kk + 8 * hi);
}
__device__ __forceinline__ void attn_compute(LAS unsigned char* lds, const AttnU& u, const bf16x8 (&qf)[4], bf16* OG, float* ML, int tid) {
    const int w = tid >> 6, lane = tid & 63, ql = lane & 31, hi = lane >> 5;
    const size_t qrow = (size_t)u.b * 4096 + (size_t)(u.i0 + 32 * w + ql) * u.d + u.r;
    f32x16 S[5];
#pragma unroll
    for (int j = 0; j < 5; ++j) {
#pragma unroll
        for (int e = 0; e < 16; ++e) S[j][e] = 0.f;
#pragma unroll
        for (int kk = 0; kk < 4; ++kk) { const bf16x8 af = *(const LAS bf16x8*)(lds + (32 * (w + j) + ql) * KS_STRIDE + (16 * kk + 8 * hi) * 2);
            S[j] = __builtin_amdgcn_mfma_f32_32x32x16_bf16(af, qf[kk], S[j], 0, 0, 0); }
    }
    const bool first = (u.i0 == 0);
#pragma unroll
    for (int e = 0; e < 16; ++e) { const int kl = crow(e, hi); if (kl < ql) S[0][e] = -INFINITY; if (kl > ql) S[4][e] = -INFINITY; }
#pragma unroll
    for (int j = 0; j < 4; ++j) if (first && (w + j < 4)) {
#pragma unroll
        for (int e = 0; e < 16; ++e) S[j][e] = -INFINITY; }
    float mx = -INFINITY;
#pragma unroll
    for (int j = 0; j < 5; ++j)
#pragma unroll
        for (int e = 0; e < 16; ++e) mx = fmaxf(mx, S[j][e]);
    mx = fmaxf(mx, __shfl_xor(mx, 32));
    float l = 0.f;
#pragma unroll
    for (int j = 0; j < 5; ++j)
#pragma unroll
        for (int e = 0; e < 16; ++e) { const float p = __builtin_amdgcn_exp2f(S[j][e] - mx); S[j][e] = p; l += p; }
    l += __shfl_xor(l, 32);
    f32x16 O[2];
#pragma unroll
    for (int e = 0; e < 16; ++e) { O[0][e] = 0.f; O[1][e] = 0.f; }
#pragma unroll
    for (int j = 0; j < 5; ++j)
#pragma unroll
        for (int c = 0; c < 2; ++c) {
            v4u pw; pw.x = pg8::cvt_pk_bf16(S[j][8 * c + 0], S[j][8 * c + 1]); pw.y = pg8::cvt_pk_bf16(S[j][8 * c + 2], S[j][8 * c + 3]); pw.z = pg8::cvt_pk_bf16(S[j][8 * c + 4], S[j][8 * c + 5]); pw.w = pg8::cvt_pk_bf16(S[j][8 * c + 6], S[j][8 * c + 7]);
            const bf16x8 pf = __builtin_bit_cast(bf16x8, pw);
            const int s0 = 32 * (w + j) + 16 * c + 4 * hi;
#pragma unroll
            for (int dt = 0; dt < 2; ++dt) { const int dim = 32 * dt + ql;
                const v2u lo = *(const LAS v2u*)(lds + VT_OFF + dim * VT_STRIDE + s0 * 2), hh = *(const LAS v2u*)(lds + VT_OFF + dim * VT_STRIDE + (s0 + 8) * 2);
                v4u vw; vw.x = lo.x; vw.y = lo.y; vw.z = hh.x; vw.w = hh.y;
                O[dt] = __builtin_amdgcn_mfma_f32_32x32x16_bf16(__builtin_bit_cast(bf16x8, vw), pf, O[dt], 0, 0, 0); }
        }
    const float inv = 1.f / l;
    bf16* og = OG + ((size_t)u.g * T + qrow) * 256 + u.h * 64;
#pragma unroll
    for (int dt = 0; dt < 2; ++dt)
#pragma unroll
        for (int q4 = 0; q4 < 4; ++q4) { v2u w2; w2.x = pg8::cvt_pk_bf16(O[dt][4 * q4] * inv, O[dt][4 * q4 + 1] * inv); w2.y = pg8::cvt_pk_bf16(O[dt][4 * q4 + 2] * inv, O[dt][4 * q4 + 3] * inv);
            *(v2u*)(og + 32 * dt + 8 * q4 + 4 * hi) = w2; }
    if (hi == 0) { float* ml = ML + (((size_t)u.g * T + qrow) * 4 + u.h) * 2; ml[0] = mx; ml[1] = l; }
}

__device__ __forceinline__ void attn_sample_g12(const Args& a, LAS unsigned char* lds, const bf16* Q, const bf16* Kb, const bf16* Vb, bf16* OG, float* ML, int b, int g, int tid) {
    const int w = tid >> 6, lane = tid & 63, s = w >> 1, half = w & 1;
    const int W = 128 << (2 * g), d = 1 << (2 * g);
    const char* ck = (const char*)(a.in[2 + 2 * g] + (size_t)b * W * 256); const char* cv = (const char*)(a.in[3 + 2 * g] + (size_t)b * W * 256); const unsigned voff = (unsigned)lane * 16u;
    const size_t row = (size_t)TP + b * 4 + s; const int head = lane >> 4, dl = (lane & 15) * 4;
    const int hcol = (4 * g + head) * 64 + dl;
    float q[4]; { const v2u qw = *(const v2u*)(Q + row * 768 + hcol); q[0] = bfl(qw.x); q[1] = bfh(qw.x); q[2] = bfl(qw.y); q[3] = bfh(qw.y); }
    float m = -INFINITY, l = 0.f, o[4] = {0.f, 0.f, 0.f, 0.f};
    const int jbeg = half * 65, jend = half ? 129 : 65;
#pragma unroll 1
    for (int j0 = jbeg; j0 < jend; j0 += 16) {
        f32x4 kk[16], vv[16];
#pragma unroll
        for (int jj = 0; jj < 16; ++jj) { const int j = j0 + jj; int idx = W + s - d * j; if (j >= jend) idx = 0;
            if (idx >= W) { const size_t r2 = (size_t)TP + b * 4 + (idx - W); const v2u kw = *(const v2u*)(Kb + r2 * 768 + hcol), vw = *(const v2u*)(Vb + r2 * 768 + hcol);
                kk[jj] = (f32x4){bfl(kw.x), bfh(kw.x), bfl(kw.y), bfh(kw.y)}; vv[jj] = (f32x4){bfl(vw.x), bfh(vw.x), bfl(vw.y), bfh(vw.y)}; }
            else { const int ui = __builtin_amdgcn_readfirstlane(idx); kk[jj] = __builtin_nontemporal_load((const f32x4*)(ck + (size_t)ui * 1024 + voff)); vv[jj] = __builtin_nontemporal_load((const f32x4*)(cv + (size_t)ui * 1024 + voff)); } }
        float sc[16]; float cm = -INFINITY;
#pragma unroll
        for (int jj = 0; jj < 16; ++jj) { float t = (kk[jj][0] * q[0] + kk[jj][1] * q[1]) + (kk[jj][2] * q[2] + kk[jj][3] * q[3]);
            t += __shfl_xor(t, 1); t += __shfl_xor(t, 2); t += __shfl_xor(t, 4); t += __shfl_xor(t, 8);
            sc[jj] = (j0 + jj < jend) ? t : -INFINITY; cm = fmaxf(cm, sc[jj]); }
        const float mn = fmaxf(m, cm), scale = __builtin_amdgcn_exp2f(m - mn);
        l *= scale; o[0] *= scale; o[1] *= scale; o[2] *= scale; o[3] *= scale;
#pragma unroll
        for (int jj = 0; jj < 16; ++jj) { const float p = __builtin_amdgcn_exp2f(sc[jj] - mn); l += p; o[0] += p * vv[jj][0]; o[1] += p * vv[jj][1]; o[2] += p * vv[jj][2]; o[3] += p * vv[jj][3]; }
        m = mn;
    }
    LAS float* P = (LAS float*)lds;
    if (half) { LAS float* pp = P + (w * 64 + lane) * 6; pp[0] = m; pp[1] = l; pp[2] = o[0]; pp[3] = o[1]; pp[4] = o[2]; pp[5] = o[3]; }
    __syncthreads();
    if (!half) { const LAS float* pp = P + ((w + 1) * 64 + lane) * 6; const float m1 = pp[0], l1 = pp[1];
        const float M = fmaxf(m, m1), a0 = __builtin_amdgcn_exp2f(m - M), a1 = __builtin_amdgcn_exp2f(m1 - M);
        const float lt = a0 * l + a1 * l1, inv = 1.f / lt;
        v2u w2; w2.x = pk2((a0 * o[0] + a1 * pp[2]) * inv, (a0 * o[1] + a1 * pp[3]) * inv); w2.y = pk2((a0 * o[2] + a1 * pp[4]) * inv, (a0 * o[3] + a1 * pp[5]) * inv);
        *(v2u*)(OG + ((size_t)g * T + row) * 256 + head * 64 + dl) = w2;
        if ((lane & 15) == 0) { float* ml = ML + (((size_t)g * T + row) * 4 + head) * 2; ml[0] = M; ml[1] = lt; } }
}
template <int NTOK, bool SAMPLE> __device__ __forceinline__ void conv_unit(const Args& a, LAS unsigned char* lds, const bf16* U, bf16* CONVF, const float (&cw)[31], int unit, int tid) {
    const int c = tid; float win[NTOK + 30];
    size_t row0; const unsigned vo2 = (unsigned)c * 2u, vo4 = (unsigned)c * 4u;
    if (!SAMPLE) { row0 = (size_t)unit * NTOK; const int t0 = (int)(row0 & 4095); const char* ub = (const char*)(U + row0 * 512);
#pragma unroll
        for (int jr = 0; jr < NTOK + 30; ++jr) { const int t = t0 - 30 + jr; win[jr] = (t >= 0) ? bf2f_g(*(const unsigned short*)(ub + (jr - 30) * 1024 + vo2)) : 0.f; } }
    else { row0 = (size_t)TP + (size_t)unit * 4; const char* st = (const char*)(a.in[8] + (size_t)unit * 30 * 512); const char* ub = (const char*)(U + row0 * 512);
#pragma unroll
        for (int jr = 0; jr < 30; ++jr) win[jr] = *(const float*)(st + jr * 2048 + vo4);
#pragma unroll
        for (int jr = 0; jr < NTOK; ++jr) win[30 + jr] = bf2f_g(*(const unsigned short*)(ub + jr * 1024 + vo2)); }
    const float cb = *(const float*)((const char*)a.in[18] + vo4);
    LAS float* yb = (LAS float*)lds;
    __syncthreads();
#pragma unroll
    for (int t = 0; t < NTOK; ++t) { float y = cb;
#pragma unroll
        for (int j = 0; j < 31; ++j) y += cw[j] * win[t + j];
        yb[t * 512 + c] = y; }
    __syncthreads();
    const int w = tid >> 6, lane = tid & 63;
    constexpr int TPW = (NTOK + 7) / 8;
#pragma unroll
    for (int tt = 0; tt < TPW; ++tt) { const int t = w * TPW + tt;
        if (t < NTOK) {
            float y[8]; float s = 0.f;
#pragma unroll
            for (int i = 0; i < 8; ++i) { y[i] = yb[t * 512 + lane + 64 * i]; s += y[i]; }
            const float mu = wave_sum(s) * (1.f / 512.f); float q = 0.f;
#pragma unroll
            for (int i = 0; i < 8; ++i) { y[i] -= mu; q += y[i] * y[i]; }
            const float rstd = __builtin_amdgcn_rsqf(wave_sum(q) * (1.f / 512.f) + 1e-6f);
#pragma unroll
            for (int i = 0; i < 8; ++i) { const int cc = lane + 64 * i; const float z = y[i] * rstd * *(const float*)((const char*)a.in[19] + i * 256 + (unsigned)lane * 4u) + *(const float*)((const char*)a.in[20] + i * 256 + (unsigned)lane * 4u);
                const float sw = z * __builtin_amdgcn_rcpf(1.f + __builtin_amdgcn_exp2f(-1.4426950408889634f * z));
                CONVF[(row0 + t) * 512 + cc] = (bf16)f2bf(sw); }
        }
    }
}

__device__ __forceinline__ void combine_groups(const bf16* OG, const float* ML, bf16* BATT, size_t row_lo, size_t row_hi, size_t gtid, size_t nthr) {
    for (size_t i = row_lo * 32 + gtid; i < row_hi * 32; i += nthr) {
        const size_t row = i >> 5; const int c8 = (int)(i & 31), h = c8 >> 3;
        float mg[3], lg[3]; v4u og[3];
#pragma unroll
        for (int g = 0; g < 3; ++g) { const float* ml = ML + (((size_t)g * T + row) * 4 + h) * 2; mg[g] = ml[0]; lg[g] = ml[1]; og[g] = *(const v4u*)(OG + ((size_t)g * T + row) * 256 + c8 * 8); }
        const float M = fmaxf(mg[0], fmaxf(mg[1], mg[2]));
        float wg[3], ws = 0.f;
#pragma unroll
        for (int g = 0; g < 3; ++g) { wg[g] = __builtin_amdgcn_exp2f(mg[g] - M) * lg[g]; ws += wg[g]; }
        const float inv = 1.f / ws; float o[8];
#pragma unroll
        for (int e = 0; e < 8; ++e) o[e] = 0.f;
#pragma unroll
        for (int g = 0; g < 3; ++g) { const float wn = wg[g] * inv;
#pragma unroll
            for (int e = 0; e < 4; ++e) { o[2 * e] += wn * bfl(og[g][e]); o[2 * e + 1] += wn * bfh(og[g][e]); } }
        v4u w; w.x = pk2(o[0], o[1]); w.y = pk2(o[2], o[3]); w.z = pk2(o[4], o[5]); w.w = pk2(o[6], o[7]);
        *(v4u*)(BATT + row * 256 + c8 * 8) = w;
    }
}

#define XB_TMO      128
#define XB_XCNT(j)  (256  + 64 * (j))
#define XB_XSUB(j)  (1280 + 64 * (j))
#define XB_XGEN(j)  (2304 + 64 * (j))
#define XB_TOP      3328
#define XB_TOPGEN   3392
#define XCD_BAR_WORDS 3456
#define XB_SPIN_CAP (1u << 18)

__device__ __forceinline__ unsigned xb_ld(unsigned* p)              { return __hip_atomic_load(p, __ATOMIC_RELAXED, __HIP_MEMORY_SCOPE_AGENT); }
__device__ __forceinline__ unsigned xb_add(unsigned* p, unsigned v) { return __hip_atomic_fetch_add(p, v, __ATOMIC_RELAXED, __HIP_MEMORY_SCOPE_AGENT); }
__device__ __forceinline__ unsigned xb_xcc_id() { return (unsigned)__builtin_amdgcn_s_getreg((3 << 11) | 20) & 0xFu; }
#define XB_SPIN(cond, bar) do { unsigned _sp = 0; while (cond) { __builtin_amdgcn_s_sleep(1); \
    if ((++_sp & 255u) == 0u) { if (xb_ld(&(bar)[XB_TMO])) break; if (_sp > XB_SPIN_CAP) { atomicAdd(&(bar)[XB_TMO], 1u); break; } } } } while (0)

struct XcdBarrier {
    unsigned* bar; unsigned x;
    volatile LAS unsigned* st;
};

__device__ __forceinline__ XcdBarrier xcd_barrier_post(unsigned* bar, volatile LAS unsigned* st) {
    XcdBarrier b; b.bar = bar; b.x = xb_xcc_id(); b.st = st;
    if (threadIdx.x == 0) (void)xb_add(&bar[XB_XCNT(b.x)], 1u);
    return b;
}
__device__ __forceinline__ void xcd_barrier_complete(unsigned* bar, unsigned x, unsigned& nloc, unsigned& nx) {
    const unsigned G = gridDim.x * gridDim.y * gridDim.z;
    unsigned sum, cnt, mine, sp = 0u;
    for (;;) {
        sum = 0u; cnt = 0u; mine = 0u;
#pragma unroll
        for (unsigned j = 0; j < 16; ++j) { const unsigned c = xb_ld(&bar[XB_XCNT(j)]); sum += c; cnt += (c > 0u) ? 1u : 0u; mine = (j == x) ? c : mine; }
        if (sum == G) break;
        __builtin_amdgcn_s_sleep(1);
        if ((++sp & 255u) == 0u) { if (xb_ld(&bar[XB_TMO])) break; if (sp > XB_SPIN_CAP) { atomicAdd(&bar[XB_TMO], 1u); break; } }
    }
    nloc = mine > 0u ? mine : 1u; nx = cnt > 0u ? cnt : 1u;
}

__device__ __forceinline__ void xcd_barrier(const XcdBarrier& b) {
    asm volatile("s_waitcnt vmcnt(0)" ::: "memory");
    __syncthreads();
    if (threadIdx.x == 0) {
        unsigned* bar = b.bar;
        __builtin_amdgcn_s_waitcnt(0);
        unsigned nloc = b.st[0], nx = b.st[1];
        if (nloc == 0u) { xcd_barrier_complete(bar, b.x, nloc, nx); b.st[0] = nloc; b.st[1] = nx; }
        const unsigned old = xb_add(&bar[XB_XSUB(b.x)], 1u);
        const unsigned gen = old / nloc;
        if (old + 1u == (gen + 1u) * nloc) {
            __builtin_amdgcn_fence(__ATOMIC_RELEASE, "agent");
            asm volatile("s_waitcnt vmcnt(0)" ::: "memory");
            const unsigned og = xb_add(&bar[XB_TOP], 1u);
            const unsigned tg = og / nx;
            if (og + 1u == (tg + 1u) * nx) xb_add(&bar[XB_TOPGEN], 1u);
            else XB_SPIN(xb_ld(&bar[XB_TOPGEN]) == tg, bar);
            __builtin_amdgcn_fence(__ATOMIC_ACQUIRE, "agent");
            xb_add(&bar[XB_XGEN(b.x)], 1u);
            asm volatile("s_waitcnt vmcnt(0)" ::: "memory");
        } else {
            XB_SPIN(xb_ld(&bar[XB_XGEN(b.x)]) == gen, bar);
            __builtin_amdgcn_fence(__ATOMIC_ACQUIRE, "agent");
            asm volatile("s_waitcnt vmcnt(0)" ::: "memory");
        }
    }
    __syncthreads();
}
__global__ void __launch_bounds__(512, 2) mk_fwd(Args args) {
    extern __shared__ __attribute__((aligned(16))) unsigned char lds_raw[];
    LAS unsigned char* lds = (LAS unsigned char*)lds_raw;
    const int tid = threadIdx.x, G = gridDim.x, bid = blockIdx.x;
    unsigned char* ws = args.ws;
    const int lo = args.ph_lo, hi = args.ph_hi;
#define IN(k) (lo <= (k) && (k) < hi)
#define SEAM(k) do { if (IN(k) && IN((k) + 1)) { xcd_barrier(bar); } } while (0)
    volatile LAS unsigned* MISC = (volatile LAS unsigned*)(lds + 131072);
    if (tid < 64) MISC[tid] = 0u;
    __syncthreads();
    unsigned* fctl = (unsigned*)(ws + WS_CTL);
    XcdBarrier bar; bar.bar = (unsigned*)(ws + WS_BAR); bar.x = 0; bar.st = nullptr;
    if (hi - lo > 1) bar = xcd_barrier_post((unsigned*)(ws + WS_BAR), MISC + 8);
    float* rss0 = (float*)(ws + WS_RSS0); float* rss1 = (float*)(ws + WS_RSS1); float* rss2 = (float*)(ws + WS_RSS2);
    bf16* XB = (bf16*)(ws + WS_XB); bf16* ACT = (bf16*)(ws + WS_ACT); float* X1 = (float*)(ws + WS_X1); bf16* X1B = (bf16*)(ws + WS_X1B);
    bf16* Ub = (bf16*)(ws + WS_U); bf16* Qb = (bf16*)(ws + WS_Q); bf16* Kb = (bf16*)(ws + WS_K); bf16* Vb = (bf16*)(ws + WS_V); bf16* Gb = (bf16*)(ws + WS_G);
    bf16* CONVF = (bf16*)(ws + WS_CONVF); bf16* OG = (bf16*)(ws + WS_OG); float* ML = (float*)(ws + WS_ML); bf16* BATT = (bf16*)(ws + WS_BATT);
    float* TMP = (float*)(ws + WS_TMP); bf16* MIX = (bf16*)(ws + WS_MIX); float* X2 = (float*)(ws + WS_X2); bf16* X2B = (bf16*)(ws + WS_X2B);

    if (IN(0)) { p0_prologue(args, lds, G, bid, tid); }
    SEAM(0);
    const bf16* W1 = (const bf16*)(ws + WS_W1); const bf16* W2 = (const bf16*)(ws + WS_W2); const bf16* W3 = (const bf16*)(ws + WS_W3); const bf16* W4A = (const bf16*)(ws + WS_W4A);
    const bf16* W4B = (const bf16*)(ws + WS_W4B); const bf16* W5 = (const bf16*)(ws + WS_W5); const bf16* W6 = (const bf16*)(ws + WS_W6); const bf16* W7 = (const bf16*)(ws + WS_W7);
#define GEMM(EPI, Aop, Bop, Nn, Kk, nM_, pmoff, Gs, cs, Eobj) do { pg8::Gemm g_{Aop, Bop, T, Nn, Kk}; pg8::SubOrder S_; S_.init(nM_, (Nn) / 256, pmoff, Gs, cs); \
        pg8::gemm_phase<EPI, pg8::SubOrder, true, true>(lds, g_, S_, Eobj); } while (0)
    if (IN(1)) {
        pg8::EpiSwiGLU E{rss0, ACT};
        GEMM(pg8::EpiSwiGLU, XB, W1, 2 * FF, D, 64, 0, G, bid, E);
        GEMM(pg8::EpiSwiGLU, XB, W1, 2 * FF, D, 2, 64, 44, bid - 128, E);
        filler(args, fctl, 1, units_of(64 * 22, G, bid) + units_of(44, 44, bid - 128), 64 * 22 + 44, MISC, tid);
    }
    SEAM(1);
    if (IN(2)) {
        pg8::EpiResid<true> E{args.in[0], args.in[1] - (size_t)TP * D, X1, X1B, rss1, 0.5f};
        GEMM(pg8::EpiResid<true>, ACT, W2, D, FF, 64, 0, G, bid, E);
    }
    SEAM(2);
    if (IN(3)) {
        { pg8::EpiIn E{rss1, Ub, Qb, Gb, args.in[14], (const float*)(ws + WS_QKN), (const float*)(ws + WS_ROT), args.out};
          GEMM(pg8::EpiIn, X1B, W3, NIN, D, 64, 0, G - 8, bid < G - 8 ? bid : -1, E); }
        { pg8::EpiResid<true> E{args.in[0], args.in[1] - (size_t)TP * D, X1, X1B, rss1, 0.5f};
          GEMM(pg8::EpiResid<true>, ACT, W2, D, FF, 2, 64, 8, bid - (G - 8), E); }
        filler(args, fctl, 3, units_of(64 * 21, G - 8, bid < G - 8 ? bid : 1 << 30) + units_of(8, 8, bid - (G - 8)), 64 * 21 + 8, MISC, tid);
    }
    SEAM(3);
    if (IN(4)) {
        { pg8::EpiIn E{rss1, Ub, Qb, Gb, args.in[14], (const float*)(ws + WS_QKN), (const float*)(ws + WS_ROT), args.out};
          GEMM(pg8::EpiIn, X1B, W3, NIN, D, 2, 64, 42, bid, E); }
        int it = 0; unsigned id = grab(fctl + 64 * 20, MISC, it, tid);
        {
            v4u kv[6], vv[6]; AttnU cur = attn_decode(id < 768u ? (int)id : 0);
            if (id < 768u) attn_load(cur, Kb, Vb, tid, kv, vv);
            while (id < 768u) {
                __syncthreads();
                attn_write(lds, tid, kv, vv);
                __syncthreads();
                bf16x8 qf[4]; attn_qload(cur, Qb, tid, qf);
                const unsigned nid = grab(fctl + 64 * 20, MISC, it, tid);
                const AttnU nxt = attn_decode(nid < 768u ? (int)nid : 0);
                if (nid < 768u) attn_load(nxt, Kb, Vb, tid, kv, vv);
                attn_compute(lds, cur, qf, OG, ML, tid);
                cur = nxt; id = nid;
            }
        }
        {   float cw[31];
#pragma unroll
            for (int j = 0; j < 31; ++j) cw[j] = *(const float*)((const char*)args.in[17] + j * 2048 + (unsigned)tid * 4u);
            while (id < 768u + 512u) { conv_unit<32, false>(args, lds, Ub, CONVF, cw, (int)id - 768, tid); id = grab(fctl + 64 * 20, MISC, it, tid); }
        }
    }
    SEAM(4);
    if (IN(5)) {
        combine_groups(OG, ML, BATT, 0, TP, (size_t)bid * 512 + tid, (size_t)G * 512);
        __syncthreads();
        { pg8::EpiGateA E{Gb, TMP}; GEMM(pg8::EpiGateA, CONVF, W4A, D, 512, 64, 0, G, bid, E); }
        int it = 0; int tq = tid; asm volatile("" : "+v"(tq));
        for (;;) { const unsigned id = grab(fctl + 64 * 21, MISC, it, tq); if (id >= 512u) break;
            if (id < 384u) attn_sample_g12(args, lds, Qb, Kb, Vb, OG, ML, (int)(id / 3u), (int)(id % 3u), tq);
            else { float cw[31];
#pragma unroll
                for (int j = 0; j < 31; ++j) cw[j] = *(const float*)((const char*)args.in[17] + j * 2048 + (unsigned)tq * 4u);
                conv_unit<4, true>(args, lds, Ub, CONVF, cw, (int)id - 384, tq); } }
    }
    SEAM(5);
    if (IN(6)) {
        { pg8::EpiGateB E{Gb, TMP, MIX}; GEMM(pg8::EpiGateB, BATT, W4B, D, 256, 64, 0, G, bid, E); }
        combine_groups(OG, ML, BATT, TP, T, (size_t)bid * 512 + tid, (size_t)G * 512);
        __syncthreads();
        { pg8::EpiGateA E{Gb, TMP}; GEMM(pg8::EpiGateA, CONVF, W4A, D, 512, 2, 64, 8, bid, E); }
        filler(args, fctl, 6, 1u + units_of(8, 8, bid), 256 + 8, MISC, tid);
    }
    SEAM(6);
    if (IN(7)) {
        { pg8::EpiResid<true> E{X1, X1, X2, X2B, rss2, 1.0f}; GEMM(pg8::EpiResid<true>, MIX, W5, D, D, 64, 0, G, bid, E); }
        { pg8::EpiGateB E{Gb, TMP, MIX}; GEMM(pg8::EpiGateB, BATT, W4B, D, 256, 2, 64, 8, bid, E); }
        filler(args, fctl, 7, 1u + units_of(8, 8, bid), 256 + 8, MISC, tid);
    }
    SEAM(7);
    if (IN(8)) {
        { pg8::EpiSwiGLU E{rss2, ACT}; GEMM(pg8::EpiSwiGLU, X2B, W6, 2 * FF, D, 64, 0, G - 8, bid < G - 8 ? bid : -1, E); }
        { pg8::EpiResid<true> E{X1, X1, X2, X2B, rss2, 1.0f}; GEMM(pg8::EpiResid<true>, MIX, W5, D, D, 2, 64, 8, bid - (G - 8), E); }
        filler(args, fctl, 8, units_of(64 * 22, G - 8, bid < G - 8 ? bid : 1 << 30) + units_of(8, 8, bid - (G - 8)), 64 * 22 + 8, MISC, tid);
    }
    SEAM(8);
    if (IN(9)) {
        pg8::EpiResid<false> E{X2, X2, args.out, nullptr, nullptr, 0.5f};
        GEMM(pg8::EpiResid<false>, ACT, W7, D, FF, 64, 0, G, bid, E);
    }
    SEAM(9);
    if (IN(10)) {
        { pg8::EpiSwiGLU E{rss2, ACT}; GEMM(pg8::EpiSwiGLU, X2B, W6, 2 * FF, D, 2, 64, 44, bid, E); }
        filler(args, fctl, 10, units_of(44, 44, bid), 44, MISC, tid);
    }
    SEAM(10);
    if (IN(11)) {
        { pg8::EpiResid<false> E{X2, X2, args.out, nullptr, nullptr, 0.5f}; GEMM(pg8::EpiResid<false>, ACT, W7, D, FF, 2, 64, 8, bid, E); }
        filler(args, fctl, 11, 0u, 0u, MISC, tid);
    }
#undef IN
#undef SEAM
}

extern "C" void kernel_launch(void* const* d_in, const int* in_sizes, int n_in, void* d_out, int out_size, void* d_ws, size_t ws_size, hipStream_t stream) {
    static int grid = 0;
    if (grid == 0) {
        int dev = 0, cus = 0, per_cu = 0;
        if (n_in != 27 || ws_size < WS_END) { fprintf(stderr, "kernel_launch: unexpected n_in %d / ws %zu (need %zu)\n", n_in, ws_size, (size_t)WS_END); grid = -1; return; }
        (void)hipGetDevice(&dev);
        (void)hipDeviceGetAttribute(&cus, hipDeviceAttributeMultiprocessorCount, dev);
        if (hipFuncSetAttribute((const void*)mk_fwd, hipFuncAttributeMaxDynamicSharedMemorySize, LDS_BYTES) != hipSuccess) { fprintf(stderr, "kernel_launch: hipFuncSetAttribute failed\n"); grid = -1; return; }
        if (hipOccupancyMaxActiveBlocksPerMultiprocessor(&per_cu, (const void*)mk_fwd, 512, LDS_BYTES) != hipSuccess || per_cu < 1) { fprintf(stderr, "kernel_launch: occupancy query failed (%d)\n", per_cu); per_cu = 1; }
        (void)hipGetLastError();
        grid = cus;
        fprintf(stderr, "kernel_launch: cus %d per_cu %d grid %d\n", cus, per_cu, grid);
    }
    if (grid < 0) return;
    Args a{};
    for (int i = 0; i < 27; ++i) a.in[i] = (const float*)d_in[i];
    a.out = (float*)d_out; a.ws = (unsigned char*)d_ws;
    if (hipMemsetAsync((char*)d_ws + WS_BAR, 0, WS_BAR_BYTES, stream) != hipSuccess) { fprintf(stderr, "kernel_launch: memset failed\n"); return; }
#if MK_N_LAUNCHES == 1
    a.ph_lo = 0; a.ph_hi = N_PHASES;
    hipLaunchKernelGGL(mk_fwd, dim3(grid), dim3(512), LDS_BYTES, stream, a);
#else
    for (int p = 0; p < N_PHASES; ++p) { a.ph_lo = p; a.ph_hi = p + 1; hipLaunchKernelGGL(mk_fwd, dim3(grid), dim3(512), LDS_BYTES, stream, a); }
#endif
}
```

```cpp
#include <hip/hip_runtime.h>
#include <cstdio>
#include <cstdint>
namespace pg8 {
#define PG8_LAS __attribute__((address_space(3)))
typedef unsigned short bf16_t;
typedef short bf16x8 __attribute__((ext_vector_type(8)));
typedef float f32x4 __attribute__((ext_vector_type(4)));
typedef unsigned u32x4 __attribute__((ext_vector_type(4)));
constexpr int BM = 256, BK = 64, HALF = 128, HTB = HALF * BK * 2  , STAGE_BYTES = 8 * HTB, NXCD = 8, WGM = 8;

__host__ __device__ __forceinline__ int lds_byte(int r, int c) { const int st = (r >> 4) * 2 + (c >> 5), rr = r & 15, cc = c & 31, ob = rr * 64 + cc * 2; return st * 1024 + (ob ^ (((ob >> 9) & 1) << 5)); }
__host__ __device__ __forceinline__ void stage_rc(int b, int& R, int& C) { const int st = b / 1024, sb = b % 1024, swz = sb ^ (((sb >> 9) & 1) << 5); R = (st >> 1) * 16 + swz / 64; C = (st & 1) * 32 + (swz % 64) / 2; }
__host__ __device__ __forceinline__ int perm32(int rho) { const int n = rho >> 4, i = rho & 15; return 8 * (i >> 2) + 4 * n + (i & 3); }

struct Unit { int pm, pn; };
struct Gemm { const bf16_t* A; const bf16_t* Bt; int M, N, K; };

struct StaticOrder {
    int nM, nN, nwg, G, c;
    __host__ __device__ void init(int M, int N, int G_, int c_) { nM = M / BM; nN = N / BM; nwg = nM * nN; G = G_; c = c_; }
    __host__ __device__ bool next(int i, Unit& u) const {
        const long L = (long)i * G + c; if (L >= nwg) return false;
        int wgid = (int)L; { const int q = nwg / NXCD, r = nwg % NXCD, xcd = wgid % NXCD, off = wgid / NXCD; wgid = (xcd < r ? xcd * (q + 1) : r * (q + 1) + (xcd - r) * q) + off; }
        const int nig = WGM * nN, gid = wgid / nig, fm = gid * WGM, gsz = (nM - fm) < WGM ? (nM - fm) : WGM;
        u.pm = fm + ((wgid % nig) % gsz); u.pn = (wgid % nig) / gsz; return true;
    }
    __device__ __forceinline__ void a_ready(const Unit&) const {}
    __device__ __forceinline__ void done(const Unit&) const {}
};

__device__ __forceinline__ unsigned cvt_pk_bf16(float lo, float hi) { unsigned r; asm volatile("v_cvt_pk_bf16_f32 %0, %1, %2" : "=v"(r) : "v"(lo), "v"(hi)); return r; }
typedef float f32x2 __attribute__((ext_vector_type(2)));
typedef unsigned u32x2 __attribute__((ext_vector_type(2)));
struct SubOrder {
    int nM, nN, nwg, G, c, pm_off;
    __host__ __device__ void init(int nM_, int nN_, int pm_off_, int G_, int c_) { nM = nM_; nN = nN_; nwg = (c_ >= 0 && c_ < G_) ? nM * nN : 0; G = G_; c = c_; pm_off = pm_off_; }
    __host__ __device__ bool next(int i, Unit& u) const {
        const long L = (long)i * G + c; if (c < 0 || L >= nwg) return false;
        int wgid = (int)L; { const int q = nwg / NXCD, r = nwg % NXCD, xcd = wgid % NXCD, off = wgid / NXCD; wgid = (xcd < r ? xcd * (q + 1) : r * (q + 1) + (xcd - r) * q) + off; }
        const int nig = WGM * nN, gid = wgid / nig, fm = gid * WGM, gsz = (nM - fm) < WGM ? (nM - fm) : WGM;
        u.pm = pm_off + fm + ((wgid % nig) % gsz); u.pn = (wgid % nig) / gsz; return true;
    }
    __device__ __forceinline__ void a_ready(const Unit&) const {}
    __device__ __forceinline__ void done(const Unit&) const {}
};
constexpr float NEPS = 1e-6f;
__device__ __forceinline__ float sigmoid_f(float x) { return __builtin_amdgcn_rcpf(1.f + __builtin_amdgcn_exp2f(-1.4426950408889634f * x)); }
__device__ __forceinline__ float silu_f(float x) { return x * sigmoid_f(x); }
__device__ __forceinline__ float bf2f(unsigned short h) { return __builtin_bit_cast(float, (unsigned)h << 16); }
__device__ __forceinline__ float bflo(unsigned w) { return __builtin_bit_cast(float, w << 16); }
__device__ __forceinline__ float bfhi(unsigned w) { return __builtin_bit_cast(float, w & 0xffff0000u); }

struct EpiSwiGLU {
    static constexpr bool PERM = false, AFTER_DRAIN = false;
    const float* rss; bf16_t* O;
    __device__ __forceinline__ void operator()(const f32x4 (&acc)[2][2][4][2], const Unit& u, int wr, int wc, int fr, int fq) const {
        const int row0 = u.pm * BM + wr * 64 + fr, col0 = u.pn * 128 + wc * 32 + 8 * fq;
#pragma unroll
        for (int ai = 0; ai < 2; ++ai)
#pragma unroll
            for (int m = 0; m < 4; ++m) {
                const int row = row0 + ai * HALF + m * 16;
                const float r = __builtin_amdgcn_rsqf(rss[row] * (1.f / 1024.f) + NEPS);
                float o[8];
#pragma unroll
                for (int n = 0; n < 2; ++n)
#pragma unroll
                    for (int e = 0; e < 4; ++e) o[4 * n + e] = silu_f(acc[ai][0][m][n][e] * r) * (acc[ai][1][m][n][e] * r);
                u32x4 w; w.x = cvt_pk_bf16(o[0], o[1]); w.y = cvt_pk_bf16(o[2], o[3]); w.z = cvt_pk_bf16(o[4], o[5]); w.w = cvt_pk_bf16(o[6], o[7]);
                *(u32x4*)(O + (size_t)row * 2816 + col0) = w;
            }
    }
};

template <bool NEXT> struct EpiResid {
    static constexpr bool PERM = false, AFTER_DRAIN = false;
    const float* base_p; const float* base_s; float* out; bf16_t* outb; float* rss; float alpha;
    __device__ __forceinline__ void operator()(const f32x4 (&acc)[2][2][4][2], const Unit& u, int wr, int wc, int fr, int fq) const {
        const int row0 = u.pm * BM + wr * 64 + fr, col0 = u.pn * BM + wc * 32 + 8 * fq;
        const float* base = (u.pm < 64) ? base_p : base_s;
#pragma unroll
        for (int ai = 0; ai < 2; ++ai)
#pragma unroll
            for (int m = 0; m < 4; ++m) {
                const int row = row0 + ai * HALF + m * 16; float ss = 0.f;
#pragma unroll
                for (int bj = 0; bj < 2; ++bj) {
                    const size_t off = (size_t)row * 1024 + col0 + bj * HALF;
                    const f32x4 b0 = *(const f32x4*)(base + off), b1 = *(const f32x4*)(base + off + 4);
                    const f32x4 v0 = b0 + acc[ai][bj][m][0] * alpha, v1 = b1 + acc[ai][bj][m][1] * alpha;
                    *(f32x4*)(out + off) = v0; *(f32x4*)(out + off + 4) = v1;
                    if (NEXT) {
                        u32x4 w; w.x = cvt_pk_bf16(v0[0], v0[1]); w.y = cvt_pk_bf16(v0[2], v0[3]); w.z = cvt_pk_bf16(v1[0], v1[1]); w.w = cvt_pk_bf16(v1[2], v1[3]);
                        *(u32x4*)(outb + off) = w;
                        ss += (v0[0] * v0[0] + v0[1] * v0[1]) + (v0[2] * v0[2] + v0[3] * v0[3]) + (v1[0] * v1[0] + v1[1] * v1[1]) + (v1[2] * v1[2] + v1[3] * v1[3]);
                    }
                }
                if (NEXT) { ss += __shfl_xor(ss, 16); ss += __shfl_xor(ss, 32); if (fq == 0) unsafeAtomicAdd(rss + row, ss); }
            }
    }
};

struct EpiGateA {
    static constexpr bool PERM = false, AFTER_DRAIN = false;
    const bf16_t* gates; float* tmp;
    __device__ __forceinline__ void operator()(const f32x4 (&acc)[2][2][4][2], const Unit& u, int wr, int wc, int fr, int fq) const {
        const int row0 = u.pm * BM + wr * 64 + fr, col0 = u.pn * BM + wc * 32 + 8 * fq;
#pragma unroll
        for (int ai = 0; ai < 2; ++ai)
#pragma unroll
            for (int m = 0; m < 4; ++m) {
                const int row = row0 + ai * HALF + m * 16;
#pragma unroll
                for (int bj = 0; bj < 2; ++bj) {
                    const int c = col0 + bj * HALF;
                    const u32x4 g = *(const u32x4*)(gates + (size_t)row * 2048 + c);
                    f32x4 v0 = acc[ai][bj][m][0], v1 = acc[ai][bj][m][1];
                    v0[0] *= bflo(g.x); v0[1] *= bfhi(g.x); v0[2] *= bflo(g.y); v0[3] *= bfhi(g.y);
                    v1[0] *= bflo(g.z); v1[1] *= bfhi(g.z); v1[2] *= bflo(g.w); v1[3] *= bfhi(g.w);
                    *(f32x4*)(tmp + (size_t)row * 1024 + c) = v0; *(f32x4*)(tmp + (size_t)row * 1024 + c + 4) = v1;
                }
            }
    }
};
struct EpiGateB {
    static constexpr bool PERM = false, AFTER_DRAIN = false;
    const bf16_t* gates; const float* tmp; bf16_t* mix;
    __device__ __forceinline__ void operator()(const f32x4 (&acc)[2][2][4][2], const Unit& u, int wr, int wc, int fr, int fq) const {
        const int row0 = u.pm * BM + wr * 64 + fr, col0 = u.pn * BM + wc * 32 + 8 * fq;
#pragma unroll
        for (int ai = 0; ai < 2; ++ai)
#pragma unroll
            for (int m = 0; m < 4; ++m) {
                const int row = row0 + ai * HALF + m * 16;
#pragma unroll
                for (int bj = 0; bj < 2; ++bj) {
                    const int c = col0 + bj * HALF;
                    const u32x4 g = *(const u32x4*)(gates + (size_t)row * 2048 + 1024 + c);
                    const f32x4 t0 = *(const f32x4*)(tmp + (size_t)row * 1024 + c), t1 = *(const f32x4*)(tmp + (size_t)row * 1024 + c + 4);
                    f32x4 v0 = acc[ai][bj][m][0], v1 = acc[ai][bj][m][1];
                    v0[0] = t0[0] + v0[0] * bflo(g.x); v0[1] = t0[1] + v0[1] * bfhi(g.x); v0[2] = t0[2] + v0[2] * bflo(g.y); v0[3] = t0[3] + v0[3] * bfhi(g.y);
                    v1[0] = t1[0] + v1[0] * bflo(g.z); v1[1] = t1[1] + v1[1] * bfhi(g.z); v1[2] = t1[2] + v1[2] * bflo(g.w); v1[3] = t1[3] + v1[3] * bfhi(g.w);
                    u32x4 w; w.x = cvt_pk_bf16(v0[0], v0[1]); w.y = cvt_pk_bf16(v0[2], v0[3]); w.z = cvt_pk_bf16(v1[0], v1[1]); w.w = cvt_pk_bf16(v1[2], v1[3]);
                    *(u32x4*)(mix + (size_t)row * 1024 + c) = w;
                }
            }
    }
};

struct EpiIn {
    static constexpr bool PERM = false, AFTER_DRAIN = false;
    const float* rss; bf16_t *U, *Q, *G; const float *b_gate, *qk_norm, *rot; float* out;
    static constexpr size_t O_KP0 = 17301504;
    __device__ __forceinline__ void operator()(const f32x4 (&acc)[2][2][4][2], const Unit& u, int wr, int wc, int fr, int fq) const {
        const int row0 = u.pm * BM + wr * 64 + fr; const int pn = u.pn; const bool samp = u.pm >= 64;
        if (pn < 4) {
            const int col0 = pn * 128 + wc * 32 + 8 * fq;
#pragma unroll
            for (int ai = 0; ai < 2; ++ai)
#pragma unroll
                for (int m = 0; m < 4; ++m) {
                    const int row = row0 + ai * HALF + m * 16; const float r = __builtin_amdgcn_rsqf(rss[row] * (1.f / 1024.f) + NEPS);
                    float o[8];
#pragma unroll
                    for (int n = 0; n < 2; ++n)
#pragma unroll
                        for (int e = 0; e < 4; ++e) o[4 * n + e] = (acc[ai][0][m][n][e] * r) * sigmoid_f(acc[ai][1][m][n][e] * r);
                    u32x4 w; w.x = cvt_pk_bf16(o[0], o[1]); w.y = cvt_pk_bf16(o[2], o[3]); w.z = cvt_pk_bf16(o[4], o[5]); w.w = cvt_pk_bf16(o[6], o[7]);
                    *(u32x4*)(U + (size_t)row * 512 + col0) = w;
                    float* cp = nullptr;
                    if (!samp) { const int t = row & 4095, b = row >> 12; if (t >= 4066) cp = out + 22806528 + ((size_t)(b * 30 + (t - 4066))) * 512 + col0; }
                    else { const int sr = row - 16384; cp = out + 199028736 + ((size_t)((sr >> 2) * 30 + 26 + (sr & 3))) * 512 + col0; }
                    if (cp) { *(f32x4*)cp = (f32x4){o[0], o[1], o[2], o[3]}; *(f32x4*)(cp + 4) = (f32x4){o[4], o[5], o[6], o[7]}; }
                }
        } else if (pn < 13) {
            const int kind = (pn - 4) / 3, g = (pn - 4) % 3;
            const int W = 128 << (2 * g);
            const int hcol = (4 * g + wc) * 64;
            int dim0[2][2];
#pragma unroll
            for (int n = 0; n < 2; ++n) { dim0[0][n] = (kind < 2 && fq < 2) ? 4 * fq + 8 * n : 8 * fq + 4 * n; dim0[1][n] = 32 + 8 * fq + 4 * n; }
            f32x4 gn[2][2];
            if (kind < 2) { const float* nw = qk_norm + kind * 768 + hcol;
#pragma unroll
                for (int bj = 0; bj < 2; ++bj)
#pragma unroll
                    for (int n = 0; n < 2; ++n) gn[bj][n] = *(const f32x4*)(nw + dim0[bj][n]); }
            bf16_t* dstb = Q + (size_t)kind * ((size_t)16896 * 768);
            size_t okp = 17301504, oks = 22867968;
            for (int gg = 0; gg < g; ++gg) { okp += (size_t)2 * 4 * (128 << (2 * gg)) * 256; oks += (size_t)2 * 128 * (128 << (2 * gg)) * 256; }
            if (kind == 2) { okp += (size_t)4 * W * 256; oks += (size_t)128 * W * 256; }
#pragma unroll
            for (int ai = 0; ai < 2; ++ai)
#pragma unroll
                for (int m = 0; m < 4; ++m) {
                    const int row = row0 + ai * HALF + m * 16; const float r = __builtin_amdgcn_rsqf(rss[row] * (1.f / 1024.f) + NEPS);
                    f32x4 v[2][2];
#pragma unroll
                    for (int bj = 0; bj < 2; ++bj)
#pragma unroll
                        for (int n = 0; n < 2; ++n) v[bj][n] = acc[ai][bj][m][n] * r;
                    int posidx, b, tt; float* cdst = nullptr;
                    if (!samp) { tt = row & 4095; b = row >> 12; posidx = tt; if (kind >= 1 && tt >= 4096 - W) cdst = out + okp + ((size_t)(b * W + (tt - (4096 - W))) * 4 + wc) * 64; }
                    else { const int sr = row - 16384; b = sr >> 2; tt = sr & 3; posidx = 4096 + tt; if (kind >= 1) cdst = out + oks + ((size_t)(b * W + (W - 4 + tt)) * 4 + wc) * 64; }
                    if (kind < 2) {
                        float ss = 0.f;
#pragma unroll
                        for (int bj = 0; bj < 2; ++bj)
#pragma unroll
                            for (int n = 0; n < 2; ++n) ss += (v[bj][n][0] * v[bj][n][0] + v[bj][n][1] * v[bj][n][1]) + (v[bj][n][2] * v[bj][n][2] + v[bj][n][3] * v[bj][n][3]);
                        ss += __shfl_xor(ss, 16); ss += __shfl_xor(ss, 32);
                        const float rn = __builtin_amdgcn_rsqf(ss * (1.f / 64.f) + NEPS);
#pragma unroll
                        for (int bj = 0; bj < 2; ++bj)
#pragma unroll
                            for (int n = 0; n < 2; ++n) v[bj][n] = v[bj][n] * rn * gn[bj][n];
                        if (fq < 2) {
                            const f32x4 cs = *(const f32x4*)(rot + (size_t)posidx * 16 + 4 * fq), sn = *(const f32x4*)(rot + (size_t)posidx * 16 + 8 + 4 * fq);
                            const f32x4 x1 = v[0][0], x2 = v[0][1];
                            v[0][0] = x1 * cs - x2 * sn; v[0][1] = x2 * cs + x1 * sn;
                        }
                        if (kind == 0) {
#pragma unroll
                            for (int bj = 0; bj < 2; ++bj)
#pragma unroll
                                for (int n = 0; n < 2; ++n) v[bj][n] = v[bj][n] * (0.125f * 1.4426950408889634f);
                        }
                    }
#pragma unroll
                    for (int bj = 0; bj < 2; ++bj)
#pragma unroll
                        for (int n = 0; n < 2; ++n) {
                            u32x2 w; w.x = cvt_pk_bf16(v[bj][n][0], v[bj][n][1]); w.y = cvt_pk_bf16(v[bj][n][2], v[bj][n][3]);
                            *(u32x2*)(dstb + (size_t)row * 768 + hcol + dim0[bj][n]) = w;
                            if (cdst) *(f32x4*)(cdst + dim0[bj][n]) = v[bj][n];
                        }
                }
        } else {
            const int col0 = (pn - 13) * 256 + wc * 32 + 8 * fq;
            f32x4 bv[2][2];
#pragma unroll
            for (int bj = 0; bj < 2; ++bj)
#pragma unroll
                for (int n = 0; n < 2; ++n) bv[bj][n] = *(const f32x4*)(b_gate + col0 + bj * HALF + 4 * n);
#pragma unroll
            for (int ai = 0; ai < 2; ++ai)
#pragma unroll
                for (int m = 0; m < 4; ++m) {
                    const int row = row0 + ai * HALF + m * 16; const float r = __builtin_amdgcn_rsqf(rss[row] * (1.f / 1024.f) + NEPS);
#pragma unroll
                    for (int bj = 0; bj < 2; ++bj) {
                        float o[8];
#pragma unroll
                        for (int n = 0; n < 2; ++n)
#pragma unroll
                            for (int e = 0; e < 4; ++e) o[4 * n + e] = sigmoid_f(acc[ai][bj][m][n][e] * r + bv[bj][n][e]);
                        u32x4 w; w.x = cvt_pk_bf16(o[0], o[1]); w.y = cvt_pk_bf16(o[2], o[3]); w.z = cvt_pk_bf16(o[4], o[5]); w.w = cvt_pk_bf16(o[6], o[7]);
                        *(u32x4*)(G + (size_t)row * 2048 + col0 + bj * HALF) = w;
                    }
                }
        }
    }
};
template <class Epi, class Sched, bool ALIGN_EPI = false, bool SP2 = false>
__device__ __forceinline__ void gemm_phase(PG8_LAS unsigned char* lds, const Gemm g, const Sched& S, const Epi& E) {
    int tid_o = threadIdx.x; asm volatile("" : "+v"(tid_o));
    const int tid = tid_o, wid = __builtin_amdgcn_readfirstlane(tid >> 6), lane = tid & 63, wr = wid >> 2, wc = wid & 3, fr = lane & 15, fq = lane >> 4;
    const int K = g.K, nt = K / BK;
    unsigned voffA[2], voffB[2];
#pragma unroll
    for (int i = 0; i < 2; ++i) { int R, C; stage_rc(tid * 16 + i * 8192, R, C); const int Rb = Epi::PERM ? ((R & ~31) + perm32(R & 31)) : R;
        voffA[i] = (unsigned)(R * K + C) * 2u; voffB[i] = (unsigned)(Rb * K + C) * 2u; }
    const size_t kstep = (size_t)(BK * 2);
    const size_t hstep = (size_t)HALF * K * 2;
    const size_t tstep = 2 * hstep;
    const unsigned ldsw = (unsigned)wid * 1024u;
    const int aoff = lds_byte(wr * 64 + fr, fq * 8), boff = lds_byte(wc * 32 + fr, fq * 8);
#define PG8_SA(b, h) (((b) * 2 + (h)) * HTB)
#define PG8_SB(b, h) ((4 + (b) * 2 + (h)) * HTB)
#define PG8_STAGE(bufoff, gbase, voff) do { _Pragma("unroll") for (int _i = 0; _i < 2; ++_i) \
        __builtin_amdgcn_global_load_lds((const unsigned*)((const char*)(gbase) + (voff)[_i]), (PG8_LAS unsigned*)(lds + (bufoff) + ldsw + _i * 8192), 16, 0, 0); } while (0)
#define PG8_LDA(dst, b, h) do { _Pragma("unroll") for (int m = 0; m < 4; ++m) _Pragma("unroll") for (int k = 0; k < 2; ++k) dst[m][k] = *(const PG8_LAS bf16x8*)(lds + PG8_SA(b, h) + aoff + m * 2048 + k * 1024); } while (0)
#define PG8_LDB(dst, b, h) do { _Pragma("unroll") for (int n = 0; n < 2; ++n) _Pragma("unroll") for (int k = 0; k < 2; ++k) dst[n][k] = *(const PG8_LAS bf16x8*)(lds + PG8_SB(b, h) + boff + n * 2048 + k * 1024); } while (0)
#define PG8_MMA(ai, bj, At, Bt) do { __builtin_amdgcn_s_setprio(1); _Pragma("unroll") for (int m = 0; m < 4; ++m) _Pragma("unroll") for (int n = 0; n < 2; ++n) _Pragma("unroll") for (int k = 0; k < 2; ++k) \
        acc[ai][bj][m][n] = __builtin_amdgcn_mfma_f32_16x16x32_bf16(Bt[n][k], At[m][k], acc[ai][bj][m][n], 0, 0, 0); __builtin_amdgcn_s_setprio(0); } while (0)
#define PG8_WAIT_V(n) asm volatile("s_waitcnt vmcnt(" #n ")" ::: "memory")
#define PG8_WAIT_L(n) asm volatile("s_waitcnt lgkmcnt(" #n ")" ::: "memory")
#define PG8_BAR __builtin_amdgcn_s_barrier()
#define PG8_SCHED __builtin_amdgcn_sched_barrier(0)
    Unit cur, nxt; int ui = 0;
    if (!S.next(0, cur)) return;
    f32x4 acc[2][2][4][2];
#pragma unroll
    for (int a = 0; a < 2; ++a)
#pragma unroll
        for (int b = 0; b < 2; ++b)
#pragma unroll
            for (int m = 0; m < 4; ++m)
#pragma unroll
                for (int n = 0; n < 2; ++n) acc[a][b][m][n] = (f32x4){0.f, 0.f, 0.f, 0.f};
    bf16x8 At[4][2], B0[2][2], B1[2][2];
    const char* cA = (const char*)g.A + (size_t)cur.pm * tstep; const char* cB = (const char*)g.Bt + (size_t)cur.pn * tstep;
    S.a_ready(cur);
    if constexpr (SP2) {
        PG8_STAGE(PG8_SB(0, 0), cB, voffB); PG8_STAGE(PG8_SB(0, 1), cB + hstep, voffB); PG8_STAGE(PG8_SA(0, 0), cA, voffA); PG8_STAGE(PG8_SA(0, 1), cA + hstep, voffA);
        if (wr == 1) PG8_BAR;
        PG8_WAIT_V(2); PG8_BAR;
        PG8_STAGE(PG8_SB(1, 0), cB + kstep, voffB); PG8_STAGE(PG8_SA(1, 0), cA + kstep, voffA); PG8_STAGE(PG8_SB(1, 1), cB + hstep + kstep, voffB);
        PG8_WAIT_V(6); PG8_BAR;
    } else {
        PG8_STAGE(PG8_SB(0, 0), cB, voffB); PG8_STAGE(PG8_SA(0, 0), cA, voffA); PG8_STAGE(PG8_SB(0, 1), cB + hstep, voffB); PG8_STAGE(PG8_SA(0, 1), cA + hstep, voffA);
        if (wr == 1) PG8_BAR;
        PG8_WAIT_V(4); PG8_BAR;
        PG8_STAGE(PG8_SB(1, 0), cB + kstep, voffB); PG8_STAGE(PG8_SA(1, 0), cA + kstep, voffA); PG8_STAGE(PG8_SB(1, 1), cB + hstep + kstep, voffB);
        PG8_WAIT_V(6); PG8_BAR;
    }
    for (;;) {
        const bool has_next = S.next(ui + 1, nxt);
        const char* nA = has_next ? (const char*)g.A + (size_t)nxt.pm * tstep : cA; const char* nB = has_next ? (const char*)g.Bt + (size_t)nxt.pn * tstep : cB;
        for (int t = 0; t < nt; t += 2) {
            const bool last = (t == nt - 2);
            const char* a1 = cA + (size_t)(t + 1) * kstep;
            const char* a2 = last ? nA : cA + (size_t)(t + 2) * kstep; const char* b2 = last ? nB : cB + (size_t)(t + 2) * kstep;
            const char* a3 = a2 + kstep; const char* b3 = b2 + kstep;
            if (last && has_next) S.a_ready(nxt);
            if constexpr (SP2) {
            PG8_LDB(B0, 0, 0); PG8_LDB(B1, 0, 1); PG8_SCHED; PG8_LDA(At, 0, 0); PG8_STAGE(PG8_SA(1, 1), a1 + hstep, voffA);
            PG8_WAIT_V(8); PG8_WAIT_L(0); PG8_BAR; PG8_MMA(0, 0, At, B0); PG8_MMA(0, 1, At, B1); PG8_BAR; PG8_SCHED;
            PG8_LDA(At, 0, 1); PG8_STAGE(PG8_SB(0, 0), b2, voffB); PG8_STAGE(PG8_SB(0, 1), b2 + hstep, voffB); PG8_STAGE(PG8_SA(0, 0), a2, voffA);
            PG8_WAIT_V(8); PG8_WAIT_L(0); PG8_BAR; PG8_MMA(1, 0, At, B0); PG8_MMA(1, 1, At, B1); PG8_BAR; PG8_SCHED;
            PG8_LDB(B0, 1, 0); PG8_LDB(B1, 1, 1); PG8_SCHED; PG8_LDA(At, 1, 0); PG8_STAGE(PG8_SA(0, 1), a2 + hstep, voffA);
            PG8_WAIT_V(8); PG8_WAIT_L(0); PG8_BAR; PG8_MMA(0, 0, At, B0); PG8_MMA(0, 1, At, B1); PG8_BAR; PG8_SCHED;
            PG8_LDA(At, 1, 1); PG8_STAGE(PG8_SB(1, 0), b3, voffB); PG8_STAGE(PG8_SB(1, 1), b3 + hstep, voffB); PG8_STAGE(PG8_SA(1, 0), a3, voffA);
            PG8_WAIT_V(8); PG8_WAIT_L(0); PG8_BAR; PG8_MMA(1, 0, At, B0); PG8_MMA(1, 1, At, B1); PG8_BAR; PG8_SCHED;
            } else {
            PG8_LDB(B0, 0, 0); PG8_SCHED; PG8_LDA(At, 0, 0); PG8_STAGE(PG8_SA(1, 1), a1 + hstep, voffA);
            PG8_WAIT_L(8); PG8_BAR; PG8_WAIT_L(0); PG8_MMA(0, 0, At, B0); PG8_BAR; PG8_SCHED;
            PG8_LDB(B1, 0, 1); PG8_STAGE(PG8_SB(0, 0), b2, voffB);
            PG8_BAR; PG8_WAIT_L(0); PG8_MMA(0, 1, At, B1); PG8_BAR;
            PG8_LDA(At, 0, 1); PG8_STAGE(PG8_SA(0, 0), a2, voffA);
            PG8_BAR; PG8_WAIT_L(0); PG8_MMA(1, 0, At, B0); PG8_BAR; PG8_SCHED;
            PG8_STAGE(PG8_SB(0, 1), b2 + hstep, voffB);
            PG8_WAIT_V(6); PG8_BAR; PG8_MMA(1, 1, At, B1); PG8_BAR;
            PG8_LDB(B0, 1, 0); PG8_SCHED; PG8_LDA(At, 1, 0); PG8_STAGE(PG8_SA(0, 1), a2 + hstep, voffA);
            PG8_WAIT_L(8); PG8_BAR; PG8_WAIT_L(0); PG8_MMA(0, 0, At, B0); PG8_BAR; PG8_SCHED;
            PG8_LDB(B1, 1, 1); PG8_STAGE(PG8_SB(1, 0), b3, voffB);
            PG8_BAR; PG8_WAIT_L(0); PG8_MMA(0, 1, At, B1); PG8_BAR;
            PG8_LDA(At, 1, 1); PG8_STAGE(PG8_SA(1, 0), a3, voffA);
            PG8_BAR; PG8_WAIT_L(0); PG8_MMA(1, 0, At, B0); PG8_BAR; PG8_SCHED;
            PG8_STAGE(PG8_SB(1, 1), b3 + hstep, voffB);
            PG8_WAIT_V(6); PG8_BAR; PG8_MMA(1, 1, At, B1); PG8_BAR;
            }
        }
        if constexpr (ALIGN_EPI) { if (wr == 0) PG8_BAR; }
        if constexpr (!Epi::AFTER_DRAIN) { E(acc, cur, wr, wc, fr, fq); S.done(cur); }
        if (!has_next) break;
#pragma unroll
        for (int a = 0; a < 2; ++a)
#pragma unroll
            for (int b = 0; b < 2; ++b)
#pragma unroll
                for (int m = 0; m < 4; ++m)
#pragma unroll
                    for (int n = 0; n < 2; ++n) acc[a][b][m][n] = (f32x4){0.f, 0.f, 0.f, 0.f};
        cur = nxt; cA = nA; cB = nB; ++ui;
        if constexpr (ALIGN_EPI) { if (wr == 1) PG8_BAR; }
    }
    PG8_WAIT_V(0);
    if constexpr (!ALIGN_EPI) { if (wr == 0) PG8_BAR; }
    PG8_BAR;
    if constexpr (Epi::AFTER_DRAIN) { E.fused(acc, cur, wr, wc, fr, fq, lds, wid, lane); S.done(cur); }
#undef PG8_SA
#undef PG8_SB
#undef PG8_STAGE
#undef PG8_LDA
#undef PG8_LDB
#undef PG8_MMA
#undef PG8_WAIT_V
#undef PG8_WAIT_L
#undef PG8_BAR
#undef PG8_SCHED
}
}

#ifndef MK_N_LAUNCHES
#define MK_N_LAUNCHES 1
#endif
constexpr int N_PHASES = 11;
constexpr int TP = 16384, TS = 512, T = TP + TS, D = 1024, FF = 2816, NIN = 5376;
#define GAS __attribute__((address_space(1)))
#define LAS __attribute__((address_space(3)))
typedef unsigned short bf16;
typedef float f32x4 __attribute__((ext_vector_type(4)));
typedef float f32x16 __attribute__((ext_vector_type(16)));
typedef short bf16x8 __attribute__((ext_vector_type(8)));
typedef unsigned v4u __attribute__((ext_vector_type(4)));
typedef unsigned v2u __attribute__((ext_vector_type(2)));

constexpr size_t al256(size_t x) { return (x + 255) & ~(size_t)255; }
constexpr size_t WS_BAR = 0, WS_CTL = 16384, WS_BAR_BYTES = 32768;
constexpr size_t WS_RSS0 = WS_BAR_BYTES, WS_RSS1 = WS_RSS0 + al256((size_t)T * 4), WS_RSS2 = WS_RSS1 + al256((size_t)T * 4);
constexpr size_t WS_ROT = WS_RSS2 + al256((size_t)T * 4);
constexpr size_t WS_QKN = WS_ROT + al256((size_t)4100 * 16 * 4);
constexpr size_t WS_W1 = WS_QKN + al256((size_t)1536 * 4);
constexpr size_t WS_W2 = WS_W1 + (size_t)2 * FF * D * 2;
constexpr size_t WS_W3 = WS_W2 + (size_t)D * FF * 2;
constexpr size_t WS_W4A = WS_W3 + (size_t)NIN * D * 2;
constexpr size_t WS_W4B = WS_W4A + (size_t)D * 512 * 2;
constexpr size_t WS_W5 = WS_W4B + (size_t)D * 256 * 2;
constexpr size_t WS_W6 = WS_W5 + (size_t)D * D * 2;
constexpr size_t WS_W7 = WS_W6 + (size_t)2 * FF * D * 2;
constexpr size_t WS_XB = WS_W7 + (size_t)D * FF * 2;
constexpr size_t WS_ACT = WS_XB + (size_t)T * D * 2;
constexpr size_t WS_X1 = WS_ACT + (size_t)T * FF * 2;
constexpr size_t WS_X1B = WS_X1 + (size_t)T * D * 4;
constexpr size_t WS_U = WS_X1B + (size_t)T * D * 2;
constexpr size_t WS_Q = WS_U + (size_t)T * 512 * 2;
constexpr size_t WS_K = WS_Q + (size_t)T * 768 * 2;
constexpr size_t WS_V = WS_K + (size_t)T * 768 * 2;
constexpr size_t WS_G = WS_V + (size_t)T * 768 * 2;
constexpr size_t WS_CONVF = WS_G + (size_t)T * 2048 * 2;
constexpr size_t WS_OG = WS_CONVF + (size_t)T * 512 * 2;
constexpr size_t WS_ML = WS_OG + (size_t)3 * T * 256 * 2;
constexpr size_t WS_BATT = WS_ML + (size_t)3 * T * 8 * 4;
constexpr size_t WS_TMP = WS_BATT + (size_t)T * 256 * 2;
constexpr size_t WS_MIX = WS_TMP + (size_t)T * D * 4;
constexpr size_t WS_X2 = WS_MIX + (size_t)T * D * 2;
constexpr size_t WS_X2B = WS_X2 + (size_t)T * D * 4;
constexpr size_t WS_END = WS_X2B + (size_t)T * D * 2;

constexpr size_t O_CP = 22806528, O_KS0 = 22867968, O_CS = 199028736;

constexpr int LDS_BYTES = 131072 + 1024;

__device__ __forceinline__ unsigned f2bf(float f) { unsigned u = __builtin_bit_cast(unsigned, f); return (u + 0x7fffu + ((u >> 16) & 1u)) >> 16; }
__device__ __forceinline__ unsigned pk2(float lo, float hi) { return f2bf(lo) | (f2bf(hi) << 16); }
__device__ __forceinline__ float bf2f_g(unsigned short h) { return __builtin_bit_cast(float, (unsigned)h << 16); }
__device__ __forceinline__ float bfl(unsigned w) { return __builtin_bit_cast(float, w << 16); }
__device__ __forceinline__ float bfh(unsigned w) { return __builtin_bit_cast(float, w & 0xffff0000u); }
__device__ __forceinline__ float wave_sum(float v) {
#pragma unroll
    for (int o = 1; o < 64; o <<= 1) v += __shfl_xor(v, o);
    return v;
}

struct Args { const float* in[27]; float* out; unsigned char* ws; int ph_lo, ph_hi; };

__device__ __forceinline__ int perm32(int rho) { const int n = rho >> 4, i = rho & 15; return 8 * (i >> 2) + 4 * n + (i & 3); }
template <int MAP> __device__ __forceinline__ int src_col(int nd) {
    if (MAP == 0) return (nd & ~31) + perm32(nd & 31);
    const int pn = nd >> 8, w = nd & 255, bj = w >> 7, rem = w & 127, wc = rem >> 5, slot = rem & 31;
    if (MAP == 1) return bj * FF + pn * 128 + wc * 32 + perm32(slot);
    if (pn < 4) return bj * 512 + pn * 128 + wc * 32 + perm32(slot);
    if (pn < 13) {
        int dim;
        if (pn < 10 && bj == 0) { const int fq = (slot & 15) >> 2, n = slot >> 4, e = slot & 3; dim = fq < 2 ? 4 * fq + 8 * n + e : 8 * fq + 4 * n + e; }
        else dim = 32 * bj + perm32(slot);
        return 1024 + (pn - 4) * 256 + wc * 64 + dim;
    }
    return 3328 + (pn - 13) * 256 + bj * 128 + wc * 32 + perm32(slot);
}
template <int MAP> __device__ __forceinline__ void p0_transpose_item(const float* W, int K, int Ns, int Nd, bf16* WT, const float* gain, LAS float* scr, int item, int lane) {
    const int nblk = Nd / 32, kb = item / nblk, nb = item % nblk, k0 = 64 * kb, n0 = 32 * nb;
    const int sc = src_col<MAP>(n0 + (lane & 31));
    float tv[32];
#pragma unroll
    for (int i = 0; i < 32; ++i) { const int kk = 2 * i + (lane >> 5); tv[i] = __builtin_nontemporal_load(W + (size_t)(k0 + kk) * Ns + sc); }
    if (gain) {
#pragma unroll
        for (int i = 0; i < 32; ++i) tv[i] *= gain[k0 + 2 * i + (lane >> 5)]; }
#pragma unroll
    for (int i = 0; i < 32; ++i) scr[(2 * i + (lane >> 5)) * 33 + (lane & 31)] = tv[i];
    asm volatile("s_waitcnt lgkmcnt(0)" ::: "memory");
    const int c = lane & 7;
#pragma unroll
    for (int j = 0; j < 4; ++j) { const int n = (lane >> 3) + 8 * j; const LAS float* s = scr + (8 * c) * 33 + n;
        v4u o; o.x = pk2(s[0 * 33], s[1 * 33]); o.y = pk2(s[2 * 33], s[3 * 33]); o.z = pk2(s[4 * 33], s[5 * 33]); o.w = pk2(s[6 * 33], s[7 * 33]);
        *(v4u*)(WT + (size_t)(n0 + n) * K + k0 + 8 * c) = o; }
    asm volatile("s_waitcnt lgkmcnt(0)" ::: "memory");
}
constexpr int N_CHUNKS = 5376 + 128;
struct ChunkD { const f32x4* s4; f32x4* d4; int n4; };
__device__ __forceinline__ ChunkD chunk_desc(const Args& a, int id) {
    const float* src; float* dst; int nrows;
    if (id < 5376) {
        int g, r;
        if (id < 256) { g = 0; r = id; } else if (id < 1280) { g = 1; r = id - 256; } else { g = 2; r = id - 1280; }
        const int W = 128 << (2 * g), cpb = 1 << (2 * g);
        const int kv = r / (128 * cpb), r2 = r % (128 * cpb), b = r2 / cpb, ch = r2 % cpb, row0 = ch * 128;
        nrows = (W - 4 - row0) < 128 ? (W - 4 - row0) : 128;
        size_t oks = O_KS0; for (int gg = 0; gg < g; ++gg) oks += (size_t)2 * 128 * (128 << (2 * gg)) * 256;
        oks += (size_t)kv * 128 * W * 256;
        src = a.in[2 + 2 * g + kv] + ((size_t)b * W + 4 + row0) * 256; dst = a.out + oks + ((size_t)b * W + row0) * 256;
    } else { const int b = id - 5376; src = a.in[8] + ((size_t)b * 30 + 4) * 512; dst = a.out + O_CS + (size_t)b * 30 * 512; nrows = 52; }
    ChunkD d; d.s4 = (const f32x4*)src; d.d4 = (f32x4*)dst; d.n4 = nrows * 64; return d;
}
__device__ __forceinline__ void copy_chunk(const Args& a, int id, int tid) {
    const ChunkD c0 = chunk_desc(a, id);
    f32x4 v0[16];
#pragma unroll
    for (int k = 0; k < 16; ++k) { const int i = tid + 512 * k; if (i < c0.n4) v0[k] = __builtin_nontemporal_load(c0.s4 + i); }
#pragma unroll
    for (int k = 0; k < 16; ++k) { const int i = tid + 512 * k; if (i < c0.n4) __builtin_nontemporal_store(v0[k], c0.d4 + i); }
}
__device__ __forceinline__ void filler(const Args& a, unsigned* ctl, int phase, unsigned my_units, unsigned total_units, volatile LAS unsigned* misc, int tid) {
    unsigned* done = ctl + 64 * (1 + phase);
    if (tid == 0) { if (total_units) __hip_atomic_fetch_add(done, my_units, __ATOMIC_RELAXED, __HIP_MEMORY_SCOPE_AGENT);
        unsigned id = N_CHUNKS;
        if (!total_units || __hip_atomic_load(done, __ATOMIC_RELAXED, __HIP_MEMORY_SCOPE_AGENT) < total_units) id = __hip_atomic_fetch_add(ctl, 1u, __ATOMIC_RELAXED, __HIP_MEMORY_SCOPE_AGENT);
        misc[16] = id; }
    __syncthreads();
    unsigned id = (unsigned)__builtin_amdgcn_readfirstlane((int)misc[16]);
    for (int it = 1; id < (unsigned)N_CHUNKS; ++it) {
        unsigned nxt = N_CHUNKS;
        if (tid == 0) { if (!total_units || __hip_atomic_load(done, __ATOMIC_RELAXED, __HIP_MEMORY_SCOPE_AGENT) < total_units) nxt = __hip_atomic_fetch_add(ctl, 1u, __ATOMIC_RELAXED, __HIP_MEMORY_SCOPE_AGENT); }
        copy_chunk(a, (int)id, tid);
        if (tid == 0) misc[16 + (it & 1)] = nxt;
        __syncthreads();
        id = (unsigned)__builtin_amdgcn_readfirstlane((int)misc[16 + (it & 1)]);
    }
}
__device__ __forceinline__ unsigned grab(unsigned* ctr, volatile LAS unsigned* misc, int& it, int tid) {
    if (tid == 0) misc[20 + (it & 1)] = __hip_atomic_fetch_add(ctr, 1u, __ATOMIC_RELAXED, __HIP_MEMORY_SCOPE_AGENT);
    __syncthreads();
    const unsigned v = (unsigned)__builtin_amdgcn_readfirstlane((int)misc[20 + (it & 1)]); ++it; return v;
}
__device__ __forceinline__ unsigned units_of(int nwg, int G, int c) { return (c >= 0 && c < G && c < nwg) ? (unsigned)((nwg - c + G - 1) / G) : 0u; }

__device__ __forceinline__ void p0_prologue(const Args& a, LAS unsigned char* lds, int G, int bid, int tid) {
    const int wave = tid >> 6, lane = tid & 63;
    LAS float* scr = (LAS float*)(lds + wave * 16384);
    const int gw = bid * 8 + wave, NGW = G * 8;
    unsigned char* ws = a.ws;
    constexpr int I_IN = (D / 64) * (2 * FF / 32), I_OUT = (FF / 64) * (D / 32), I_3 = (D / 64) * (NIN / 32), I_4A = (512 / 64) * (D / 32), I_4B = (256 / 64) * (D / 32), I_5 = (D / 64) * (D / 32);
    constexpr int NITEMS = 2 * I_IN + 2 * I_OUT + I_3 + I_4A + I_4B + I_5;
    for (int it = gw; it < NITEMS; it += NGW) {
        int r = it;
        if (r < I_IN) { p0_transpose_item<1>(a.in[10], D, 2 * FF, 2 * FF, (bf16*)(ws + WS_W1), a.in[9], scr, r, lane); continue; } r -= I_IN;
        if (r < I_IN) { p0_transpose_item<1>(a.in[25], D, 2 * FF, 2 * FF, (bf16*)(ws + WS_W6), a.in[24], scr, r, lane); continue; } r -= I_IN;
        if (r < I_OUT) { p0_transpose_item<0>(a.in[11], FF, D, D, (bf16*)(ws + WS_W2), nullptr, scr, r, lane); continue; } r -= I_OUT;
        if (r < I_OUT) { p0_transpose_item<0>(a.in[26], FF, D, D, (bf16*)(ws + WS_W7), nullptr, scr, r, lane); continue; } r -= I_OUT;
        if (r < I_3) { p0_transpose_item<2>(a.in[13], D, NIN, NIN, (bf16*)(ws + WS_W3), a.in[12], scr, r, lane); continue; } r -= I_3;
        if (r < I_4A) { p0_transpose_item<0>(a.in[21], 512, D, D, (bf16*)(ws + WS_W4A), nullptr, scr, r, lane); continue; } r -= I_4A;
        if (r < I_4B) { p0_transpose_item<0>(a.in[22], 256, D, D, (bf16*)(ws + WS_W4B), nullptr, scr, r, lane); continue; } r -= I_4B;
        p0_transpose_item<0>(a.in[23], D, D, D, (bf16*)(ws + WS_W5), nullptr, scr, r, lane);
    }
    float* rss0 = (float*)(ws + WS_RSS0); float* rss1 = (float*)(ws + WS_RSS1); float* rss2 = (float*)(ws + WS_RSS2);
    bf16* XB = (bf16*)(ws + WS_XB);
    for (int m0 = gw; m0 < T; m0 += 2 * NGW) {
        f32x4 v[2][4]; float ssq[2];
#pragma unroll
        for (int u = 0; u < 2; ++u) { const int m = m0 + u * NGW; if (m < T) { const float* xr = (m < TP) ? a.in[0] + (size_t)m * D : a.in[1] + (size_t)(m - TP) * D; const f32x4* x4 = (const f32x4*)xr + lane;
#pragma unroll
            for (int j = 0; j < 4; ++j) v[u][j] = __builtin_nontemporal_load(x4 + 64 * j); } }
#pragma unroll
        for (int u = 0; u < 2; ++u) { const int m = m0 + u * NGW; if (m < T) { float sq = 0.f;
#pragma unroll
            for (int j = 0; j < 4; ++j) sq += (v[u][j][0] * v[u][j][0] + v[u][j][1] * v[u][j][1]) + (v[u][j][2] * v[u][j][2] + v[u][j][3] * v[u][j][3]);
            ssq[u] = wave_sum(sq);
            if (lane == 0) { rss0[m] = ssq[u]; rss1[m] = 0.f; rss2[m] = 0.f; }
            v2u* o8 = (v2u*)(XB + (size_t)m * D) + lane;
#pragma unroll
            for (int j = 0; j < 4; ++j) { v2u w; w.x = pk2(v[u][j][0], v[u][j][1]); w.y = pk2(v[u][j][2], v[u][j][3]); o8[64 * j] = w; } } }
    }
    const size_t gtid = (size_t)bid * 512 + tid, nthr = (size_t)G * 512;
    float* rot = (float*)(ws + WS_ROT);
    for (size_t i = gtid; i < (size_t)4100 * 8; i += nthr) {
        const int p = (int)(i >> 3), f = (int)(i & 7); const int pos = p < 4096 ? p : 2048 + (p - 4096);
        const double inv = exp2(-(double)f * (18.931568569324174 / 8.0));
        const double rev = (double)pos * inv * 0.15915494309189535;
        const double fr = rev - rint(rev);
        const float ang = (float)(fr * 6.283185307179586);
        rot[(size_t)p * 16 + f] = __builtin_amdgcn_cosf((float)fr); rot[(size_t)p * 16 + 8 + f] = __builtin_amdgcn_sinf((float)fr); (void)ang;
    }
    { float* qkn = (float*)(ws + WS_QKN); for (size_t i = gtid; i < 1536; i += nthr) qkn[i] = i < 768 ? a.in[15][i] : a.in[16][i - 768]; }
}

__device__ __forceinline__ int crow(int r, int hi) { return (r & 3) + 8 * (r >> 2) + 4 * hi; }
constexpr int KS_STRIDE = 144, VT_OFF = 384 * KS_STRIDE, VT_STRIDE = 776;
struct AttnU { int b, g, h, d, r, i0, hc; };
__device__ __forceinline__ AttnU attn_decode(int unit) {
    AttnU u; u.b = unit / 192; int rem = unit % 192; u.g = rem / 64; rem %= 64; u.h = rem / 16; const int x = rem % 16;
    const int dsh = 2 * u.g, nblk = 16 >> dsh; u.d = 1 << dsh; u.r = x / nblk; u.i0 = (x % nblk) * 256; u.hc = (4 * u.g + u.h) * 64; return u;
}
__device__ __forceinline__ void attn_load(const AttnU& u, const bf16* Kb, const bf16* Vb, int tid, v4u (&kv)[6], v4u (&vv)[6]) {
#pragma unroll
    for (int k = 0; k < 6; ++k) { const int q = tid + 512 * k, s = q >> 3, c = q & 7, i = u.i0 - 128 + s;
        if (i >= 0) { const size_t off = ((size_t)u.b * 4096 + (size_t)i * u.d + u.r) * 768 + u.hc + 8 * c; kv[k] = *(const v4u*)(Kb + off); vv[k] = *(const v4u*)(Vb + off); }
        else { kv[k] = (v4u){0u, 0u, 0u, 0u}; vv[k] = (v4u){0u, 0u, 0u, 0u}; } }
}
__device__ __forceinline__ void attn_write(LAS unsigned char* lds, int tid, const v4u (&kv)[6], const v4u (&vv)[6]) {
#pragma unroll
    for (int k = 0; k < 6; ++k) { const int q = tid + 512 * k, s = q >> 3, c = q & 7;
        *(LAS v4u*)(lds + s * KS_STRIDE + 16 * c) = kv[k];
#pragma unroll
        for (int e = 0; e < 4; ++e) { const unsigned w = vv[k][e];
            *(LAS unsigned short*)(lds + VT_OFF + (8 * c + 2 * e) * VT_STRIDE + s * 2) = (unsigned short)(w & 0xffffu);
            *(LAS unsigned short*)(lds + VT_OFF + (8 * c + 2 * e + 1) * VT_STRIDE + s * 2) = (unsigned short)(w >> 16); } }
}
__device__ __forceinline__ void attn_qload(const AttnU& u, const bf16* Q, int tid, bf16x8 (&qf)[4]) {
    const int w = tid >> 6, lane = tid & 63, ql = lane & 31, hi = lane >> 5;
    const size_t qrow = (size_t)u.b * 4096 + (size_t)(u.i0 + 32 * w + ql) * u.d + u.r;
#pragma unroll
    for (int kk = 0; kk < 4; ++kk) qf[kk] = *(const bf16x8*)(Q + qrow * 768 + u.hc + 16 * kk + 8 * hi);
}
__device__ __forceinline__ void attn_compute(LAS unsigned char* lds, const AttnU& u, const bf16x8 (&qf)[4], bf16* OG, float* ML, int tid) {
    const int w = tid >> 6, lane = tid & 63, ql = lane & 31, hi = lane >> 5;
    const size_t qrow = (size_t)u.b * 4096 + (size_t)(u.i0 + 32 * w + ql) * u.d + u.r;
    f32x16 S[5];
#pragma unroll
    for (int j = 0; j < 5; ++j) {
#pragma unroll
        for (int e = 0; e < 16; ++e) S[j][e] = 0.f;
#pragma unroll
        for (int kk = 0; kk < 4; ++kk) { const bf16x8 af = *(const LAS bf16x8*)(lds + (32 * (w + j) + ql) * KS_STRIDE + (16 * kk + 8 * hi) * 2);
            S[j] = __builtin_amdgcn_mfma_f32_32x32x16_bf16(af, qf[kk], S[j], 0, 0, 0); }
    }
    const bool first = (u.i0 == 0);
#pragma unroll
    for (int e = 0; e < 16; ++e) { const int kl = crow(e, hi); if (kl < ql) S[0][e] = -INFINITY; if (kl > ql) S[4][e] = -INFINITY; }
#pragma unroll
    for (int j = 0; j < 4; ++j) if (first && (w + j < 4)) {
#pragma unroll
        for (int e = 0; e < 16; ++e) S[j][e] = -INFINITY; }
    float mx = -INFINITY;
#pragma unroll
    for (int j = 0; j < 5; ++j)
#pragma unroll
        for (int e = 0; e < 16; ++e) mx = fmaxf(mx, S[j][e]);
    mx = fmaxf(mx, __shfl_xor(mx, 32));
    float l = 0.f;
#pragma unroll
    for (int j = 0; j < 5; ++j)
#pragma unroll
        for (int e = 0; e < 16; ++e) { const float p = __builtin_amdgcn_exp2f(S[j][e] - mx); S[j][e] = p; l += p; }
    l += __shfl_xor(l, 32);
    f32x16 O[2];
#pragma unroll
    for (int e = 0; e < 16; ++e) { O[0][e] = 0.f; O[1][e] = 0.f; }
#pragma unroll
    for (int j = 0; j < 5; ++j)
#pragma unroll
        for (int c = 0; c < 2; ++c) {
            v4u pw; pw.x = pg8::cvt_pk_bf16(S[j][8 * c + 0], S[j][8 * c + 1]); pw.y = pg8::cvt_pk_bf16(S[j][8 * c + 2], S[j][8 * c + 3]); pw.z = pg8::cvt_pk_bf16(S[j][8 * c + 4], S[j][8 * c + 5]); pw.w = pg8::cvt_pk_bf16(S[j][8 * c + 6], S[j][8 * c + 7]);
            const bf16x8 pf = __builtin_bit_cast(bf16x8, pw);
            const int s0 = 32 * (w + j) + 16 * c + 4 * hi;
#pragma unroll
            for (int dt = 0; dt < 2; ++dt) { const int dim = 32 * dt + ql;
                const v2u lo = *(const LAS v2u*)(lds + VT_OFF + dim * VT_STRIDE + s0 * 2), hh = *(const LAS v2u*)(lds + VT_OFF + dim * VT_STRIDE + (s0 + 8) * 2);
                v4u vw; vw.x = lo.x; vw.y = lo.y; vw.z = hh.x; vw.w = hh.y;
                O[dt] = __builtin_amdgcn_mfma_f32_32x32x16_bf16(__builtin_bit_cast(bf16x8, vw), pf, O[dt], 0, 0, 0); }
        }
    const float inv = 1.f / l;
    bf16* og = OG + ((size_t)u.g * T + qrow) * 256 + u.h * 64;
#pragma unroll
    for (int dt = 0; dt < 2; ++dt)
#pragma unroll
        for (int q4 = 0; q4 < 4; ++q4) { v2u w2; w2.x = pg8::cvt_pk_bf16(O[dt][4 * q4] * inv, O[dt][4 * q4 + 1] * inv); w2.y = pg8::cvt_pk_bf16(O[dt][4 * q4 + 2] * inv, O[dt][4 * q4 + 3] * inv);
            *(v2u*)(og + 32 * dt + 8 * q4 + 4 * hi) = w2; }
    if (hi == 0) { float* ml = ML + (((size_t)u.g * T + qrow) * 4 + u.h) * 2; ml[0] = mx; ml[1] = l; }
}

__device__ __forceinline__ void attn_sample_g12(const Args& a, LAS unsigned char* lds, const bf16* Q, const bf16* Kb, const bf16* Vb, bf16* OG, float* ML, int b, int g, int tid) {
    const int w = tid >> 6, lane = tid & 63, s = w >> 1, half = w & 1;
    const int W = 128 << (2 * g), d = 1 << (2 * g);
    const char* ck = (const char*)(a.in[2 + 2 * g] + (size_t)b * W * 256); const char* cv = (const char*)(a.in[3 + 2 * g] + (size_t)b * W * 256); const unsigned voff = (unsigned)lane * 16u;
    const size_t row = (size_t)TP + b * 4 + s; const int head = lane >> 4, dl = (lane & 15) * 4;
    const int hcol = (4 * g + head) * 64 + dl;
    float q[4]; { const v2u qw = *(const v2u*)(Q + row * 768 + hcol); q[0] = bfl(qw.x); q[1] = bfh(qw.x); q[2] = bfl(qw.y); q[3] = bfh(qw.y); }
    float m = -INFINITY, l = 0.f, o[4] = {0.f, 0.f, 0.f, 0.f};
    const int jbeg = half * 65, jend = half ? 129 : 65;
#pragma unroll 1
    for (int j0 = jbeg; j0 < jend; j0 += 16) {
        f32x4 kk[16], vv[16];
#pragma unroll
        for (int jj = 0; jj < 16; ++jj) { const int j = j0 + jj; int idx = W + s - d * j; if (j >= jend) idx = 0;
            if (idx >= W) { const size_t r2 = (size_t)TP + b * 4 + (idx - W); const v2u kw = *(const v2u*)(Kb + r2 * 768 + hcol), vw = *(const v2u*)(Vb + r2 * 768 + hcol);
                kk[jj] = (f32x4){bfl(kw.x), bfh(kw.x), bfl(kw.y), bfh(kw.y)}; vv[jj] = (f32x4){bfl(vw.x), bfh(vw.x), bfl(vw.y), bfh(vw.y)}; }
            else { const int ui = __builtin_amdgcn_readfirstlane(idx); kk[jj] = __builtin_nontemporal_load((const f32x4*)(ck + (size_t)ui * 1024 + voff)); vv[jj] = __builtin_nontemporal_load((const f32x4*)(cv + (size_t)ui * 1024 + voff)); } }
        float sc[16]; float cm = -INFINITY;
#pragma unroll
        for (int jj = 0; jj < 16; ++jj) { float t = (kk[jj][0] * q[0] + kk[jj][1] * q[1]) + (kk[jj][2] * q[2] + kk[jj][3] * q[3]);
            t += __shfl_xor(t, 1); t += __shfl_xor(t, 2); t += __shfl_xor(t, 4); t += __shfl_xor(t, 8);
            sc[jj] = (j0 + jj < jend) ? t : -INFINITY; cm = fmaxf(cm, sc[jj]); }
        const float mn = fmaxf(m, cm), scale = __builtin_amdgcn_exp2f(m - mn);
        l *= scale; o[0] *= scale; o[1] *= scale; o[2] *= scale; o[3] *= scale;
#pragma unroll
        for (int jj = 0; jj < 16; ++jj) { const float p = __builtin_amdgcn_exp2f(sc[jj] - mn); l += p; o[0] += p * vv[jj][0]; o[1] += p * vv[jj][1]; o[2] += p * vv[jj][2]; o[3] += p * vv[jj][3]; }
        m = mn;
    }
    LAS float* P = (LAS float*)lds;
    if (half) { LAS float* pp = P + (w * 64 + lane) * 6; pp[0] = m; pp[1] = l; pp[2] = o[0]; pp[3] = o[1]; pp[4] = o[2]; pp[5] = o[3]; }
    __syncthreads();
    if (!half) { const LAS float* pp = P + ((w + 1) * 64 + lane) * 6; const float m1 = pp[0], l1 = pp[1];
        const float M = fmaxf(m, m1), a0 = __builtin_amdgcn_exp2f(m - M), a1 = __builtin_amdgcn_exp2f(m1 - M);
        const float lt = a0 * l + a1 * l1, inv = 1.f / lt;
        v2u w2; w2.x = pk2((a0 * o[0] + a1 * pp[2]) * inv, (a0 * o[1] + a1 * pp[3]) * inv); w2.y = pk2((a0 * o[2] + a1 * pp[4]) * inv, (a0 * o[3] + a1 * pp[5]) * inv);
        *(v2u*)(OG + ((size_t)g * T + row) * 256 + head * 64 + dl) = w2;
        if ((lane & 15) == 0) { float* ml = ML + (((size_t)g * T + row) * 4 + head) * 2; ml[0] = M; ml[1] = lt; } }
}
template <int NTOK, bool SAMPLE> __device__ __forceinline__ void conv_unit(const Args& a, LAS unsigned char* lds, const bf16* U, bf16* CONVF, const float (&cw)[31], int unit, int tid) {
    const int c = tid; float win[NTOK + 30];
    size_t row0; const unsigned vo2 = (unsigned)c * 2u, vo4 = (unsigned)c * 4u;
    if (!SAMPLE) { row0 = (size_t)unit * NTOK; const int t0 = (int)(row0 & 4095); const char* ub = (const char*)(U + row0 * 512);
#pragma unroll
        for (int jr = 0; jr < NTOK + 30; ++jr) { const int t = t0 - 30 + jr; win[jr] = (t >= 0) ? bf2f_g(*(const unsigned short*)(ub + (jr - 30) * 1024 + vo2)) : 0.f; } }
    else { row0 = (size_t)TP + (size_t)unit * 4; const char* st = (const char*)(a.in[8] + (size_t)unit * 30 * 512); const char* ub = (const char*)(U + row0 * 512);
#pragma unroll
        for (int jr = 0; jr < 30; ++jr) win[jr] = *(const float*)(st + jr * 2048 + vo4);
#pragma unroll
        for (int jr = 0; jr < NTOK; ++jr) win[30 + jr] = bf2f_g(*(const unsigned short*)(ub + jr * 1024 + vo2)); }
    const float cb = *(const float*)((const char*)a.in[18] + vo4);
    LAS float* yb = (LAS float*)lds;
    __syncthreads();
#pragma unroll
    for (int t = 0; t < NTOK; ++t) { float y = cb;
#pragma unroll
        for (int j = 0; j < 31; ++j) y += cw[j] * win[t + j];
        yb[t * 512 + c] = y; }
    __syncthreads();
    const int w = tid >> 6, lane = tid & 63;
    constexpr int TPW = (NTOK + 7) / 8;
#pragma unroll
    for (int tt = 0; tt < TPW; ++tt) { const int t = w * TPW + tt;
        if (t < NTOK) {
            float y[8]; float s = 0.f;
#pragma unroll
            for (int i = 0; i < 8; ++i) { y[i] = yb[t * 512 + lane + 64 * i]; s += y[i]; }
            const float mu = wave_sum(s) * (1.f / 512.f); float q = 0.f;
#pragma unroll
            for (int i = 0; i < 8; ++i) { y[i] -= mu; q += y[i] * y[i]; }
            const float rstd = __builtin_amdgcn_rsqf(wave_sum(q) * (1.f / 512.f) + 1e-6f);
#pragma unroll
            for (int i = 0; i < 8; ++i) { const int cc = lane + 64 * i; const float z = y[i] * rstd * *(const float*)((const char*)a.in[19] + i * 256 + (unsigned)lane * 4u) + *(const float*)((const char*)a.in[20] + i * 256 + (unsigned)lane * 4u);
                const float sw = z * __builtin_amdgcn_rcpf(1.f + __builtin_amdgcn_exp2f(-1.4426950408889634f * z));
                CONVF[(row0 + t) * 512 + cc] = (bf16)f2bf(sw); }
        }
    }
}

__device__ __forceinline__ void combine_groups(const bf16* OG, const float* ML, bf16* BATT, size_t row_lo, size_t row_hi, size_t gtid, size_t nthr) {
    for (size_t i = row_lo * 32 + gtid; i < row_hi * 32; i += nthr) {
        const size_t row = i >> 5; const int c8 = (int)(i & 31), h = c8 >> 3;
        float mg[3], lg[3]; v4u og[3];
#pragma unroll
        for (int g = 0; g < 3; ++g) { const float* ml = ML + (((size_t)g * T + row) * 4 + h) * 2; mg[g] = ml[0]; lg[g] = ml[1]; og[g] = *(const v4u*)(OG + ((size_t)g * T + row) * 256 + c8 * 8); }
        const float M = fmaxf(mg[0], fmaxf(mg[1], mg[2]));
        float wg[3], ws = 0.f;
#pragma unroll
        for (int g = 0; g < 3; ++g) { wg[g] = __builtin_amdgcn_exp2f(mg[g] - M) * lg[g]; ws += wg[g]; }
        const float inv = 1.f / ws; float o[8];
#pragma unroll
        for (int e = 0; e < 8; ++e) o[e] = 0.f;
#pragma unroll
        for (int g = 0; g < 3; ++g) { const float wn = wg[g] * inv;
#pragma unroll
            for (int e = 0; e < 4; ++e) { o[2 * e] += wn * bfl(og[g][e]); o[2 * e + 1] += wn * bfh(og[g][e]); } }
        v4u w; w.x = pk2(o[0], o[1]); w.y = pk2(o[2], o[3]); w.z = pk2(o[4], o[5]); w.w = pk2(o[6], o[7]);
        *(v4u*)(BATT + row * 256 + c8 * 8) = w;
    }
}

#define XB_TMO      128
#define XB_XCNT(j)  (256  + 64 * (j))
#define XB_XSUB(j)  (1280 + 64 * (j))
#define XB_XGEN(j)  (2304 + 64 * (j))
#define XB_TOP      3328
#define XB_TOPGEN   3392
#define XCD_BAR_WORDS 3456
#define XB_SPIN_CAP (1u << 18)

__device__ __forceinline__ unsigned xb_ld(unsigned* p)              { return __hip_atomic_load(p, __ATOMIC_RELAXED, __HIP_MEMORY_SCOPE_AGENT); }
__device__ __forceinline__ unsigned xb_add(unsigned* p, unsigned v) { return __hip_atomic_fetch_add(p, v, __ATOMIC_RELAXED, __HIP_MEMORY_SCOPE_AGENT); }
__device__ __forceinline__ unsigned xb_xcc_id() { return (unsigned)__builtin_amdgcn_s_getreg((3 << 11) | 20) & 0xFu; }
#define XB_SPIN(cond, bar) do { unsigned _sp = 0; while (cond) { __builtin_amdgcn_s_sleep(1); \
    if ((++_sp & 255u) == 0u) { if (xb_ld(&(bar)[XB_TMO])) break; if (_sp > XB_SPIN_CAP) { atomicAdd(&(bar)[XB_TMO], 1u); break; } } } } while (0)

struct XcdBarrier {
    unsigned* bar; unsigned x;
    volatile LAS unsigned* st;
};

__device__ __forceinline__ XcdBarrier xcd_barrier_post(unsigned* bar, volatile LAS unsigned* st) {
    XcdBarrier b; b.bar = bar; b.x = xb_xcc_id(); b.st = st;
    if (threadIdx.x == 0) (void)xb_add(&bar[XB_XCNT(b.x)], 1u);
    return b;
}
__device__ __forceinline__ void xcd_barrier_complete(unsigned* bar, unsigned x, unsigned& nloc, unsigned& nx) {
    const unsigned G = gridDim.x * gridDim.y * gridDim.z;
    unsigned sum, cnt, mine, sp = 0u;
    for (;;) {
        sum = 0u; cnt = 0u; mine = 0u;
#pragma unroll
        for (unsigned j = 0; j < 16; ++j) { const unsigned c = xb_ld(&bar[XB_XCNT(j)]); sum += c; cnt += (c > 0u) ? 1u : 0u; mine = (j == x) ? c : mine; }
        if (sum == G) break;
        __builtin_amdgcn_s_sleep(1);
        if ((++sp & 255u) == 0u) { if (xb_ld(&bar[XB_TMO])) break; if (sp > XB_SPIN_CAP) { atomicAdd(&bar[XB_TMO], 1u); break; } }
    }
    nloc = mine > 0u ? mine : 1u; nx = cnt > 0u ? cnt : 1u;
}

__device__ __forceinline__ void xcd_barrier(const XcdBarrier& b) {
    asm volatile("s_waitcnt vmcnt(0)" ::: "memory");
    __syncthreads();
    if (threadIdx.x == 0) {
        unsigned* bar = b.bar;
        __builtin_amdgcn_s_waitcnt(0);
        unsigned nloc = b.st[0], nx = b.st[1];
        if (nloc == 0u) { xcd_barrier_complete(bar, b.x, nloc, nx); b.st[0] = nloc; b.st[1] = nx; }
        const unsigned old = xb_add(&bar[XB_XSUB(b.x)], 1u);
        const unsigned gen = old / nloc;
        if (old + 1u == (gen + 1u) * nloc) {
            __builtin_amdgcn_fence(__ATOMIC_RELEASE, "agent");
            asm volatile("s_waitcnt vmcnt(0)" ::: "memory");
            const unsigned og = xb_add(&bar[XB_TOP], 1u);
            const unsigned tg = og / nx;
            if (og + 1u == (tg + 1u) * nx) xb_add(&bar[XB_TOPGEN], 1u);
            else XB_SPIN(xb_ld(&bar[XB_TOPGEN]) == tg, bar);
            __builtin_amdgcn_fence(__ATOMIC_ACQUIRE, "agent");
            xb_add(&bar[XB_XGEN(b.x)], 1u);
            asm volatile("s_waitcnt vmcnt(0)" ::: "memory");
        } else {
            XB_SPIN(xb_ld(&bar[XB_XGEN(b.x)]) == gen, bar);
            __builtin_amdgcn_fence(__ATOMIC_ACQUIRE, "agent");
            asm volatile("s_waitcnt vmcnt(0)" ::: "memory");
        }
    }
    __syncthreads();
}
__global__ void __launch_bounds__(512, 2) mk_fwd(Args args) {
    extern __shared__ __attribute__((aligned(16))) unsigned char lds_raw[];
    LAS unsigned char* lds = (LAS unsigned char*)lds_raw;
    const int tid = threadIdx.x, G = gridDim.x, bid = blockIdx.x;
    unsigned char* ws = args.ws;
    const int lo = args.ph_lo, hi = args.ph_hi;
#define IN(k) (lo <= (k) && (k) < hi)
#define SEAM(k) do { if (IN(k) && IN((k) + 1)) { xcd_barrier(bar); } } while (0)
    volatile LAS unsigned* MISC = (volatile LAS unsigned*)(lds + 131072);
    if (tid < 64) MISC[tid] = 0u;
    __syncthreads();
    unsigned* fctl = (unsigned*)(ws + WS_CTL);
    XcdBarrier bar; bar.bar = (unsigned*)(ws + WS_BAR); bar.x = 0; bar.st = nullptr;
    if (hi - lo > 1) bar = xcd_barrier_post((unsigned*)(ws + WS_BAR), MISC + 8);
    float* rss0 = (float*)(ws + WS_RSS0); float* rss1 = (float*)(ws + WS_RSS1); float* rss2 = (float*)(ws + WS_RSS2);
    bf16* XB = (bf16*)(ws + WS_XB); bf16* ACT = (bf16*)(ws + WS_ACT); float* X1 = (float*)(ws + WS_X1); bf16* X1B = (bf16*)(ws + WS_X1B);
    bf16* Ub = (bf16*)(ws + WS_U); bf16* Qb = (bf16*)(ws + WS_Q); bf16* Kb = (bf16*)(ws + WS_K); bf16* Vb = (bf16*)(ws + WS_V); bf16* Gb = (bf16*)(ws + WS_G);
    bf16* CONVF = (bf16*)(ws + WS_CONVF); bf16* OG = (bf16*)(ws + WS_OG); float* ML = (float*)(ws + WS_ML); bf16* BATT = (bf16*)(ws + WS_BATT);
    float* TMP = (float*)(ws + WS_TMP); bf16* MIX = (bf16*)(ws + WS_MIX); float* X2 = (float*)(ws + WS_X2); bf16* X2B = (bf16*)(ws + WS_X2B);

    if (IN(0)) { p0_prologue(args, lds, G, bid, tid); }
    SEAM(0);
    const bf16* W1 = (const bf16*)(ws + WS_W1); const bf16* W2 = (const bf16*)(ws + WS_W2); const bf16* W3 = (const bf16*)(ws + WS_W3); const bf16* W4A = (const bf16*)(ws + WS_W4A);
    const bf16* W4B = (const bf16*)(ws + WS_W4B); const bf16* W5 = (const bf16*)(ws + WS_W5); const bf16* W6 = (const bf16*)(ws + WS_W6); const bf16* W7 = (const bf16*)(ws + WS_W7);
#define GEMM(EPI, Aop, Bop, Nn, Kk, nM_, pmoff, Gs, cs, Eobj) do { pg8::Gemm g_{Aop, Bop, T, Nn, Kk}; pg8::SubOrder S_; S_.init(nM_, (Nn) / 256, pmoff, Gs, cs); \
        pg8::gemm_phase<EPI, pg8::SubOrder, true, true>(lds, g_, S_, Eobj); } while (0)
    if (IN(1)) {
        pg8::EpiSwiGLU E{rss0, ACT};
        GEMM(pg8::EpiSwiGLU, XB, W1, 2 * FF, D, 64, 0, G - 12, bid < G - 12 ? bid : -1, E);
        GEMM(pg8::EpiSwiGLU, XB, W1, 2 * FF, D, 2, 64, 44, bid - 192, E);
        filler(args, fctl, 1, units_of(64 * 22, G - 12, bid < G - 12 ? bid : -1) + units_of(44, 44, bid - 192), 64 * 22 + 44, MISC, tid);
    }
    SEAM(1);
    if (IN(2)) {
        pg8::EpiResid<true> E{args.in[0], args.in[1] - (size_t)TP * D, X1, X1B, rss1, 0.5f};
        GEMM(pg8::EpiResid<true>, ACT, W2, D, FF, 64, 0, G, bid, E);
    }
    SEAM(2);
    if (IN(3)) {
        { pg8::EpiIn E{rss1, Ub, Qb, Gb, args.in[14], (const float*)(ws + WS_QKN), (const float*)(ws + WS_ROT), args.out};
          GEMM(pg8::EpiIn, X1B, W3, NIN, D, 64, 0, G - 24, bid < G - 24 ? bid : -1, E); }
        { pg8::EpiResid<true> E{args.in[0], args.in[1] - (size_t)TP * D, X1, X1B, rss1, 0.5f};
          GEMM(pg8::EpiResid<true>, ACT, W2, D, FF, 2, 64, 8, bid - (G - 8), E); }
        filler(args, fctl, 3, units_of(64 * 21, G - 24, bid < G - 24 ? bid : -1) + units_of(8, 8, bid - (G - 8)), 64 * 21 + 8, MISC, tid);
    }
    SEAM(3);
    if (IN(4)) {
        { pg8::EpiIn E{rss1, Ub, Qb, Gb, args.in[14], (const float*)(ws + WS_QKN), (const float*)(ws + WS_ROT), args.out};
          GEMM(pg8::EpiIn, X1B, W3, NIN, D, 2, 64, 42, bid, E); }
        int it = 0; unsigned id = grab(fctl + 64 * 20, MISC, it, tid);
        {
            v4u kv[6], vv[6]; AttnU cur = attn_decode(id < 768u ? (int)id : 0);
            if (id < 768u) attn_load(cur, Kb, Vb, tid, kv, vv);
            while (id < 768u) {
                __syncthreads();
                attn_write(lds, tid, kv, vv);
                __syncthreads();
                bf16x8 qf[4]; attn_qload(cur, Qb, tid, qf);
                const unsigned nid = grab(fctl + 64 * 20, MISC, it, tid);
                const AttnU nxt = attn_decode(nid < 768u ? (int)nid : 0);
                if (nid < 768u) attn_load(nxt, Kb, Vb, tid, kv, vv);
                attn_compute(lds, cur, qf, OG, ML, tid);
                cur = nxt; id = nid;
            }
        }
        {   float cw[31];
#pragma unroll
            for (int j = 0; j < 31; ++j) cw[j] = *(const float*)((const char*)args.in[17] + j * 2048 + (unsigned)tid * 4u);
            while (id < 768u + 512u) { conv_unit<32, false>(args, lds, Ub, CONVF, cw, (int)id - 768, tid); id = grab(fctl + 64 * 20, MISC, it, tid); }
        }
    }
    SEAM(4);
    if (IN(5)) {
        combine_groups(OG, ML, BATT, 0, TP, (size_t)bid * 512 + tid, (size_t)G * 512);
        __syncthreads();
        { pg8::EpiGateA E{Gb, TMP}; GEMM(pg8::EpiGateA, CONVF, W4A, D, 512, 64, 0, G, bid, E); }
        int it = 0; int tq = tid; asm volatile("" : "+v"(tq));
        for (;;) { const unsigned id = grab(fctl + 64 * 21, MISC, it, tq); if (id >= 512u) break;
            if (id < 384u) attn_sample_g12(args, lds, Qb, Kb, Vb, OG, ML, (int)(id / 3u), (int)(id % 3u), tq);
            else { float cw[31];
#pragma unroll
                for (int j = 0; j < 31; ++j) cw[j] = *(const float*)((const char*)args.in[17] + j * 2048 + (unsigned)tq * 4u);
                conv_unit<4, true>(args, lds, Ub, CONVF, cw, (int)id - 384, tq); } }
    }
    SEAM(5);
    if (IN(6)) {
        { pg8::EpiGateB E{Gb, TMP, MIX}; GEMM(pg8::EpiGateB, BATT, W4B, D, 256, 64, 0, G, bid, E); }
        combine_groups(OG, ML, BATT, TP, T, (size_t)bid * 512 + tid, (size_t)G * 512);
        __syncthreads();
        { pg8::EpiGateA E{Gb, TMP}; GEMM(pg8::EpiGateA, CONVF, W4A, D, 512, 2, 64, 8, bid, E); }
        filler(args, fctl, 6, 1u + units_of(8, 8, bid), 256 + 8, MISC, tid);
    }
    SEAM(6);
    if (IN(7)) {
        { pg8::EpiResid<true> E{X1, X1, X2, X2B, rss2, 1.0f}; GEMM(pg8::EpiResid<true>, MIX, W5, D, D, 64, 0, G, bid, E); }
        { pg8::EpiGateB E{Gb, TMP, MIX}; GEMM(pg8::EpiGateB, BATT, W4B, D, 256, 2, 64, 8, bid, E); }
        filler(args, fctl, 7, 1u + units_of(8, 8, bid), 256 + 8, MISC, tid);
    }
    SEAM(7);
    if (IN(8)) {
        { pg8::EpiSwiGLU E{rss2, ACT}; GEMM(pg8::EpiSwiGLU, X2B, W6, 2 * FF, D, 64, 0, G - 20, bid < G - 20 ? bid : -1, E); }
        { pg8::EpiResid<true> E{X1, X1, X2, X2B, rss2, 1.0f}; GEMM(pg8::EpiResid<true>, MIX, W5, D, D, 2, 64, 8, bid - (G - 8), E); }
        if (bid >= G - 20) {
            unsigned* cnt = fctl + 64 * 24;
            if (bid >= G - 8) { __threadfence(); __syncthreads(); if (tid == 0) __hip_atomic_fetch_add(cnt, 1u, __ATOMIC_RELEASE, __HIP_MEMORY_SCOPE_AGENT); }
            if (tid == 0) { unsigned sp = 0; while (__hip_atomic_load(cnt, __ATOMIC_ACQUIRE, __HIP_MEMORY_SCOPE_AGENT) < 8u) { __builtin_amdgcn_s_sleep(8); if (++sp > (1u << 22)) break; } }
            __syncthreads(); __threadfence();
            pg8::EpiSwiGLU E{rss2, ACT}; GEMM(pg8::EpiSwiGLU, X2B, W6, 2 * FF, D, 2, 64, 20, bid - (G - 20), E);
        }
        filler(args, fctl, 8, units_of(64 * 22, G - 20, bid < G - 20 ? bid : -1) + units_of(8, 8, bid - (G - 8)) + units_of(44, 20, bid - (G - 20)), 64 * 22 + 8 + 44, MISC, tid);
    }
    SEAM(8);
    if (IN(9)) {
        pg8::EpiResid<false> E{X2, X2, args.out, nullptr, nullptr, 0.5f};
        GEMM(pg8::EpiResid<false>, ACT, W7, D, FF, 64, 0, G, bid, E);
    }
    SEAM(9);
    if (IN(10)) {
        { pg8::EpiResid<false> E{X2, X2, args.out, nullptr, nullptr, 0.5f}; GEMM(pg8::EpiResid<false>, ACT, W7, D, FF, 2, 64, 8, bid, E); }
        filler(args, fctl, 10, 0u, 0u, MISC, tid);
    }
#undef IN
#undef SEAM
}

extern "C" void kernel_launch(void* const* d_in, const int* in_sizes, int n_in, void* d_out, int out_size, void* d_ws, size_t ws_size, hipStream_t stream) {
    static int grid = 0;
    if (grid == 0) {
        int dev = 0, cus = 0, per_cu = 0;
        if (n_in != 27 || ws_size < WS_END) { fprintf(stderr, "kernel_launch: unexpected n_in %d / ws %zu (need %zu)\n", n_in, ws_size, (size_t)WS_END); grid = -1; return; }
        (void)hipGetDevice(&dev);
        (void)hipDeviceGetAttribute(&cus, hipDeviceAttributeMultiprocessorCount, dev);
        if (hipFuncSetAttribute((const void*)mk_fwd, hipFuncAttributeMaxDynamicSharedMemorySize, LDS_BYTES) != hipSuccess) { fprintf(stderr, "kernel_launch: hipFuncSetAttribute failed\n"); grid = -1; return; }
        if (hipOccupancyMaxActiveBlocksPerMultiprocessor(&per_cu, (const void*)mk_fwd, 512, LDS_BYTES) != hipSuccess || per_cu < 1) { fprintf(stderr, "kernel_launch: occupancy query failed (%d)\n", per_cu); per_cu = 1; }
        (void)hipGetLastError();
        grid = cus;
        fprintf(stderr, "kernel_launch: cus %d per_cu %d grid %d\n", cus, per_cu, grid);
    }
    if (grid < 0) return;
    Args a{};
    for (int i = 0; i < 27; ++i) a.in[i] = (const float*)d_in[i];
    a.out = (float*)d_out; a.ws = (unsigned char*)d_ws;
    if (hipMemsetAsync((char*)d_ws + WS_BAR, 0, WS_BAR_BYTES, stream) != hipSuccess) { fprintf(stderr, "kernel_launch: memset failed\n"); return; }
#if MK_N_LAUNCHES == 1
    a.ph_lo = 0; a.ph_hi = N_PHASES;
    hipLaunchKernelGGL(mk_fwd, dim3(grid), dim3(512), LDS_BYTES, stream, a);
#else
    for (int p = 0; p < N_PHASES; ++p) { a.ph_lo = p; a.ph_hi = p + 1; hipLaunchKernelGGL(mk_fwd, dim3(grid), dim3(512), LDS_BYTES, stream, a); }
#endif
}
```

```cpp
#include <hip/hip_runtime.h>
#include <cstdio>
#include <cstdint>
namespace pg8 {
#define PG8_LAS __attribute__((address_space(3)))
typedef unsigned short bf16_t;
typedef short bf16x8 __attribute__((ext_vector_type(8)));
typedef float f32x4 __attribute__((ext_vector_type(4)));
typedef unsigned u32x4 __attribute__((ext_vector_type(4)));
constexpr int BM = 256, BK = 64, HALF = 128, HTB = HALF * BK * 2  , STAGE_BYTES = 8 * HTB, NXCD = 8, WGM = 8;

__host__ __device__ __forceinline__ int lds_byte(int r, int c) { const int st = (r >> 4) * 2 + (c >> 5), rr = r & 15, cc = c & 31, ob = rr * 64 + cc * 2; return st * 1024 + (ob ^ (((ob >> 9) & 1) << 5)); }
__host__ __device__ __forceinline__ void stage_rc(int b, int& R, int& C) { const int st = b / 1024, sb = b % 1024, swz = sb ^ (((sb >> 9) & 1) << 5); R = (st >> 1) * 16 + swz / 64; C = (st & 1) * 32 + (swz % 64) / 2; }
__host__ __device__ __forceinline__ int perm32(int rho) { const int n = rho >> 4, i = rho & 15; return 8 * (i >> 2) + 4 * n + (i & 3); }

struct Unit { int pm, pn; };
struct Gemm { const bf16_t* A; const bf16_t* Bt; int M, N, K; };

struct StaticOrder {
    int nM, nN, nwg, G, c;
    __host__ __device__ void init(int M, int N, int G_, int c_) { nM = M / BM; nN = N / BM; nwg = nM * nN; G = G_; c = c_; }
    __host__ __device__ bool next(int i, Unit& u) const {
        const long L = (long)i * G + c; if (L >= nwg) return false;
        int wgid = (int)L; { const int q = nwg / NXCD, r = nwg % NXCD, xcd = wgid % NXCD, off = wgid / NXCD; wgid = (xcd < r ? xcd * (q + 1) : r * (q + 1) + (xcd - r) * q) + off; }
        const int nig = WGM * nN, gid = wgid / nig, fm = gid * WGM, gsz = (nM - fm) < WGM ? (nM - fm) : WGM;
        u.pm = fm + ((wgid % nig) % gsz); u.pn = (wgid % nig) / gsz; return true;
    }
    __device__ __forceinline__ void a_ready(const Unit&) const {}
    __device__ __forceinline__ void done(const Unit&) const {}
};

__device__ __forceinline__ unsigned cvt_pk_bf16(float lo, float hi) { unsigned r; asm volatile("v_cvt_pk_bf16_f32 %0, %1, %2" : "=v"(r) : "v"(lo), "v"(hi)); return r; }
typedef float f32x2 __attribute__((ext_vector_type(2)));
typedef unsigned u32x2 __attribute__((ext_vector_type(2)));
struct SubOrder {
    int nM, nN, nwg, G, c, pm_off;
    __host__ __device__ void init(int nM_, int nN_, int pm_off_, int G_, int c_) { nM = nM_; nN = nN_; nwg = (c_ >= 0 && c_ < G_) ? nM * nN : 0; G = G_; c = c_; pm_off = pm_off_; }
    __host__ __device__ bool next(int i, Unit& u) const {
        const long L = (long)i * G + c; if (c < 0 || L >= nwg) return false;
        int wgid = (int)L; { const int q = nwg / NXCD, r = nwg % NXCD, xcd = wgid % NXCD, off = wgid / NXCD; wgid = (xcd < r ? xcd * (q + 1) : r * (q + 1) + (xcd - r) * q) + off; }
        const int nig = WGM * nN, gid = wgid / nig, fm = gid * WGM, gsz = (nM - fm) < WGM ? (nM - fm) : WGM;
        u.pm = pm_off + fm + ((wgid % nig) % gsz); u.pn = (wgid % nig) / gsz; return true;
    }
    __device__ __forceinline__ void a_ready(const Unit&) const {}
    __device__ __forceinline__ void done(const Unit&) const {}
};
constexpr float NEPS = 1e-6f;
__device__ __forceinline__ float sigmoid_f(float x) { return __builtin_amdgcn_rcpf(1.f + __builtin_amdgcn_exp2f(-1.4426950408889634f * x)); }
__device__ __forceinline__ float silu_f(float x) { return x * sigmoid_f(x); }
__device__ __forceinline__ float bf2f(unsigned short h) { return __builtin_bit_cast(float, (unsigned)h << 16); }
__device__ __forceinline__ float bflo(unsigned w) { return __builtin_bit_cast(float, w << 16); }
__device__ __forceinline__ float bfhi(unsigned w) { return __builtin_bit_cast(float, w & 0xffff0000u); }

struct EpiSwiGLU {
    static constexpr bool PERM = false, AFTER_DRAIN = false;
    const float* rss; bf16_t* O;
    __device__ __forceinline__ void operator()(const f32x4 (&acc)[2][2][4][2], const Unit& u, int wr, int wc, int fr, int fq) const {
        const int row0 = u.pm * BM + wr * 64 + fr, col0 = u.pn * 128 + wc * 32 + 8 * fq;
#pragma unroll
        for (int ai = 0; ai < 2; ++ai)
#pragma unroll
            for (int m = 0; m < 4; ++m) {
                const int row = row0 + ai * HALF + m * 16;
                const float r = __builtin_amdgcn_rsqf(rss[row] * (1.f / 1024.f) + NEPS);
                float o[8];
#pragma unroll
                for (int n = 0; n < 2; ++n)
#pragma unroll
                    for (int e = 0; e < 4; ++e) o[4 * n + e] = silu_f(acc[ai][0][m][n][e] * r) * (acc[ai][1][m][n][e] * r);
                u32x4 w; w.x = cvt_pk_bf16(o[0], o[1]); w.y = cvt_pk_bf16(o[2], o[3]); w.z = cvt_pk_bf16(o[4], o[5]); w.w = cvt_pk_bf16(o[6], o[7]);
                *(u32x4*)(O + (size_t)row * 2816 + col0) = w;
            }
    }
};

template <bool NEXT> struct EpiResid {
    static constexpr bool PERM = false, AFTER_DRAIN = false;
    const float* base_p; const float* base_s; float* out; bf16_t* outb; float* rss; float alpha;
    __device__ __forceinline__ void operator()(const f32x4 (&acc)[2][2][4][2], const Unit& u, int wr, int wc, int fr, int fq) const {
        const int row0 = u.pm * BM + wr * 64 + fr, col0 = u.pn * BM + wc * 32 + 8 * fq;
        const float* base = (u.pm < 64) ? base_p : base_s;
#pragma unroll
        for (int ai = 0; ai < 2; ++ai)
#pragma unroll
            for (int m = 0; m < 4; ++m) {
                const int row = row0 + ai * HALF + m * 16; float ss = 0.f;
#pragma unroll
                for (int bj = 0; bj < 2; ++bj) {
                    const size_t off = (size_t)row * 1024 + col0 + bj * HALF;
                    const f32x4 b0 = *(const f32x4*)(base + off), b1 = *(const f32x4*)(base + off + 4);
                    const f32x4 v0 = b0 + acc[ai][bj][m][0] * alpha, v1 = b1 + acc[ai][bj][m][1] * alpha;
                    *(f32x4*)(out + off) = v0; *(f32x4*)(out + off + 4) = v1;
                    if (NEXT) {
                        u32x4 w; w.x = cvt_pk_bf16(v0[0], v0[1]); w.y = cvt_pk_bf16(v0[2], v0[3]); w.z = cvt_pk_bf16(v1[0], v1[1]); w.w = cvt_pk_bf16(v1[2], v1[3]);
                        *(u32x4*)(outb + off) = w;
                        ss += (v0[0] * v0[0] + v0[1] * v0[1]) + (v0[2] * v0[2] + v0[3] * v0[3]) + (v1[0] * v1[0] + v1[1] * v1[1]) + (v1[2] * v1[2] + v1[3] * v1[3]);
                    }
                }
                if (NEXT) { ss += __shfl_xor(ss, 16); ss += __shfl_xor(ss, 32); if (fq == 0) unsafeAtomicAdd(rss + row, ss); }
            }
    }
};

struct EpiGateA {
    static constexpr bool PERM = false, AFTER_DRAIN = false;
    const bf16_t* gates; bf16_t* tmp;
    __device__ __forceinline__ void operator()(const f32x4 (&acc)[2][2][4][2], const Unit& u, int wr, int wc, int fr, int fq) const {
        const int row0 = u.pm * BM + wr * 64 + fr, col0 = u.pn * BM + wc * 32 + 8 * fq;
#pragma unroll
        for (int ai = 0; ai < 2; ++ai)
#pragma unroll
            for (int m = 0; m < 4; ++m) {
                const int row = row0 + ai * HALF + m * 16;
#pragma unroll
                for (int bj = 0; bj < 2; ++bj) {
                    const int c = col0 + bj * HALF;
                    const u32x4 g = *(const u32x4*)(gates + (size_t)row * 2048 + c);
                    f32x4 v0 = acc[ai][bj][m][0], v1 = acc[ai][bj][m][1];
                    v0[0] *= bflo(g.x); v0[1] *= bfhi(g.x); v0[2] *= bflo(g.y); v0[3] *= bfhi(g.y);
                    v1[0] *= bflo(g.z); v1[1] *= bfhi(g.z); v1[2] *= bflo(g.w); v1[3] *= bfhi(g.w);
                    u32x4 w; w.x = cvt_pk_bf16(v0[0], v0[1]); w.y = cvt_pk_bf16(v0[2], v0[3]); w.z = cvt_pk_bf16(v1[0], v1[1]); w.w = cvt_pk_bf16(v1[2], v1[3]);
                    *(u32x4*)(tmp + (size_t)row * 1024 + c) = w;
                }
            }
    }
};
struct EpiGateB {
    static constexpr bool PERM = false, AFTER_DRAIN = false;
    const bf16_t* gates; const bf16_t* tmp; bf16_t* mix;
    __device__ __forceinline__ void operator()(const f32x4 (&acc)[2][2][4][2], const Unit& u, int wr, int wc, int fr, int fq) const {
        const int row0 = u.pm * BM + wr * 64 + fr, col0 = u.pn * BM + wc * 32 + 8 * fq;
#pragma unroll
        for (int ai = 0; ai < 2; ++ai)
#pragma unroll
            for (int m = 0; m < 4; ++m) {
                const int row = row0 + ai * HALF + m * 16;
#pragma unroll
                for (int bj = 0; bj < 2; ++bj) {
                    const int c = col0 + bj * HALF;
                    const u32x4 g = *(const u32x4*)(gates + (size_t)row * 2048 + 1024 + c);
                    const u32x4 tw = *(const u32x4*)(tmp + (size_t)row * 1024 + c); const f32x4 t0 = (f32x4){bflo(tw.x), bfhi(tw.x), bflo(tw.y), bfhi(tw.y)}, t1 = (f32x4){bflo(tw.z), bfhi(tw.z), bflo(tw.w), bfhi(tw.w)};
                    f32x4 v0 = acc[ai][bj][m][0], v1 = acc[ai][bj][m][1];
                    v0[0] = t0[0] + v0[0] * bflo(g.x); v0[1] = t0[1] + v0[1] * bfhi(g.x); v0[2] = t0[2] + v0[2] * bflo(g.y); v0[3] = t0[3] + v0[3] * bfhi(g.y);
                    v1[0] = t1[0] + v1[0] * bflo(g.z); v1[1] = t1[1] + v1[1] * bfhi(g.z); v1[2] = t1[2] + v1[2] * bflo(g.w); v1[3] = t1[3] + v1[3] * bfhi(g.w);
                    u32x4 w; w.x = cvt_pk_bf16(v0[0], v0[1]); w.y = cvt_pk_bf16(v0[2], v0[3]); w.z = cvt_pk_bf16(v1[0], v1[1]); w.w = cvt_pk_bf16(v1[2], v1[3]);
                    *(u32x4*)(mix + (size_t)row * 1024 + c) = w;
                }
            }
    }
};

struct EpiIn {
    static constexpr bool PERM = false, AFTER_DRAIN = false;
    const float* rss; bf16_t *U, *Q, *G; const float *b_gate, *qk_norm, *rot; float* out;
    static constexpr size_t O_KP0 = 17301504;
    __device__ __forceinline__ void operator()(const f32x4 (&acc)[2][2][4][2], const Unit& u, int wr, int wc, int fr, int fq) const {
        const int row0 = u.pm * BM + wr * 64 + fr; const int pn = u.pn; const bool samp = u.pm >= 64;
        if (pn < 4) {
            const int col0 = pn * 128 + wc * 32 + 8 * fq;
#pragma unroll
            for (int ai = 0; ai < 2; ++ai)
#pragma unroll
                for (int m = 0; m < 4; ++m) {
                    const int row = row0 + ai * HALF + m * 16; const float r = __builtin_amdgcn_rsqf(rss[row] * (1.f / 1024.f) + NEPS);
                    float o[8];
#pragma unroll
                    for (int n = 0; n < 2; ++n)
#pragma unroll
                        for (int e = 0; e < 4; ++e) o[4 * n + e] = (acc[ai][0][m][n][e] * r) * sigmoid_f(acc[ai][1][m][n][e] * r);
                    u32x4 w; w.x = cvt_pk_bf16(o[0], o[1]); w.y = cvt_pk_bf16(o[2], o[3]); w.z = cvt_pk_bf16(o[4], o[5]); w.w = cvt_pk_bf16(o[6], o[7]);
                    *(u32x4*)(U + (size_t)row * 512 + col0) = w;
                    float* cp = nullptr;
                    if (!samp) { const int t = row & 4095, b = row >> 12; if (t >= 4066) cp = out + 22806528 + ((size_t)(b * 30 + (t - 4066))) * 512 + col0; }
                    else { const int sr = row - 16384; cp = out + 199028736 + ((size_t)((sr >> 2) * 30 + 26 + (sr & 3))) * 512 + col0; }
                    if (cp) { *(f32x4*)cp = (f32x4){o[0], o[1], o[2], o[3]}; *(f32x4*)(cp + 4) = (f32x4){o[4], o[5], o[6], o[7]}; }
                }
        } else if (pn < 13) {
            const int kind = (pn - 4) / 3, g = (pn - 4) % 3;
            const int W = 128 << (2 * g);
            const int hcol = (4 * g + wc) * 64;
            int dim0[2][2];
#pragma unroll
            for (int n = 0; n < 2; ++n) { dim0[0][n] = (kind < 2 && fq < 2) ? 4 * fq + 8 * n : 8 * fq + 4 * n; dim0[1][n] = 32 + 8 * fq + 4 * n; }
            f32x4 gn[2][2];
            if (kind < 2) { const float* nw = qk_norm + kind * 768 + hcol;
#pragma unroll
                for (int bj = 0; bj < 2; ++bj)
#pragma unroll
                    for (int n = 0; n < 2; ++n) gn[bj][n] = *(const f32x4*)(nw + dim0[bj][n]); }
            bf16_t* dstb = Q + (size_t)kind * ((size_t)16896 * 768);
            size_t okp = 17301504, oks = 22867968;
            for (int gg = 0; gg < g; ++gg) { okp += (size_t)2 * 4 * (128 << (2 * gg)) * 256; oks += (size_t)2 * 128 * (128 << (2 * gg)) * 256; }
            if (kind == 2) { okp += (size_t)4 * W * 256; oks += (size_t)128 * W * 256; }
#pragma unroll
            for (int ai = 0; ai < 2; ++ai)
#pragma unroll
                for (int m = 0; m < 4; ++m) {
                    const int row = row0 + ai * HALF + m * 16; const float r = __builtin_amdgcn_rsqf(rss[row] * (1.f / 1024.f) + NEPS);
                    f32x4 v[2][2];
#pragma unroll
                    for (int bj = 0; bj < 2; ++bj)
#pragma unroll
                        for (int n = 0; n < 2; ++n) v[bj][n] = acc[ai][bj][m][n] * r;
                    int posidx, b, tt; float* cdst = nullptr;
                    if (!samp) { tt = row & 4095; b = row >> 12; posidx = tt; if (kind >= 1 && tt >= 4096 - W) cdst = out + okp + ((size_t)(b * W + (tt - (4096 - W))) * 4 + wc) * 64; }
                    else { const int sr = row - 16384; b = sr >> 2; tt = sr & 3; posidx = 4096 + tt; if (kind >= 1) cdst = out + oks + ((size_t)(b * W + (W - 4 + tt)) * 4 + wc) * 64; }
                    if (kind < 2) {
                        float ss = 0.f;
#pragma unroll
                        for (int bj = 0; bj < 2; ++bj)
#pragma unroll
                            for (int n = 0; n < 2; ++n) ss += (v[bj][n][0] * v[bj][n][0] + v[bj][n][1] * v[bj][n][1]) + (v[bj][n][2] * v[bj][n][2] + v[bj][n][3] * v[bj][n][3]);
                        ss += __shfl_xor(ss, 16); ss += __shfl_xor(ss, 32);
                        const float rn = __builtin_amdgcn_rsqf(ss * (1.f / 64.f) + NEPS);
#pragma unroll
                        for (int bj = 0; bj < 2; ++bj)
#pragma unroll
                            for (int n = 0; n < 2; ++n) v[bj][n] = v[bj][n] * rn * gn[bj][n];
                        if (fq < 2) {
                            const f32x4 cs = *(const f32x4*)(rot + (size_t)posidx * 16 + 4 * fq), sn = *(const f32x4*)(rot + (size_t)posidx * 16 + 8 + 4 * fq);
                            const f32x4 x1 = v[0][0], x2 = v[0][1];
                            v[0][0] = x1 * cs - x2 * sn; v[0][1] = x2 * cs + x1 * sn;
                        }
                        if (kind == 0) {
#pragma unroll
                            for (int bj = 0; bj < 2; ++bj)
#pragma unroll
                                for (int n = 0; n < 2; ++n) v[bj][n] = v[bj][n] * (0.125f * 1.4426950408889634f);
                        }
                    }
#pragma unroll
                    for (int bj = 0; bj < 2; ++bj)
#pragma unroll
                        for (int n = 0; n < 2; ++n) {
                            u32x2 w; w.x = cvt_pk_bf16(v[bj][n][0], v[bj][n][1]); w.y = cvt_pk_bf16(v[bj][n][2], v[bj][n][3]);
                            *(u32x2*)(dstb + (size_t)row * 768 + hcol + dim0[bj][n]) = w;
                            if (cdst) *(f32x4*)(cdst + dim0[bj][n]) = v[bj][n];
                        }
                }
        } else {
            const int col0 = (pn - 13) * 256 + wc * 32 + 8 * fq;
            f32x4 bv[2][2];
#pragma unroll
            for (int bj = 0; bj < 2; ++bj)
#pragma unroll
                for (int n = 0; n < 2; ++n) bv[bj][n] = *(const f32x4*)(b_gate + col0 + bj * HALF + 4 * n);
#pragma unroll
            for (int ai = 0; ai < 2; ++ai)
#pragma unroll
                for (int m = 0; m < 4; ++m) {
                    const int row = row0 + ai * HALF + m * 16; const float r = __builtin_amdgcn_rsqf(rss[row] * (1.f / 1024.f) + NEPS);
#pragma unroll
                    for (int bj = 0; bj < 2; ++bj) {
                        float o[8];
#pragma unroll
                        for (int n = 0; n < 2; ++n)
#pragma unroll
                            for (int e = 0; e < 4; ++e) o[4 * n + e] = sigmoid_f(acc[ai][bj][m][n][e] * r + bv[bj][n][e]);
                        u32x4 w; w.x = cvt_pk_bf16(o[0], o[1]); w.y = cvt_pk_bf16(o[2], o[3]); w.z = cvt_pk_bf16(o[4], o[5]); w.w = cvt_pk_bf16(o[6], o[7]);
                        *(u32x4*)(G + (size_t)row * 2048 + col0 + bj * HALF) = w;
                    }
                }
        }
    }
};
template <class Epi, class Sched, bool ALIGN_EPI = false, bool SP2 = false>
__device__ __forceinline__ void gemm_phase(PG8_LAS unsigned char* lds, const Gemm g, const Sched& S, const Epi& E) {
    int tid_o = threadIdx.x; asm volatile("" : "+v"(tid_o));
    const int tid = tid_o, wid = __builtin_amdgcn_readfirstlane(tid >> 6), lane = tid & 63, wr = wid >> 2, wc = wid & 3, fr = lane & 15, fq = lane >> 4;
    const int K = g.K, nt = K / BK;
    unsigned voffA[2], voffB[2];
#pragma unroll
    for (int i = 0; i < 2; ++i) { int R, C; stage_rc(tid * 16 + i * 8192, R, C); const int Rb = Epi::PERM ? ((R & ~31) + perm32(R & 31)) : R;
        voffA[i] = (unsigned)(R * K + C) * 2u; voffB[i] = (unsigned)(Rb * K + C) * 2u; }
    const size_t kstep = (size_t)(BK * 2);
    const size_t hstep = (size_t)HALF * K * 2;
    const size_t tstep = 2 * hstep;
    const unsigned ldsw = (unsigned)wid * 1024u;
    const int aoff = lds_byte(wr * 64 + fr, fq * 8), boff = lds_byte(wc * 32 + fr, fq * 8);
#define PG8_SA(b, h) (((b) * 2 + (h)) * HTB)
#define PG8_SB(b, h) ((4 + (b) * 2 + (h)) * HTB)
#define PG8_STAGE(bufoff, gbase, voff) do { _Pragma("unroll") for (int _i = 0; _i < 2; ++_i) \
        __builtin_amdgcn_global_load_lds((const unsigned*)((const char*)(gbase) + (voff)[_i]), (PG8_LAS unsigned*)(lds + (bufoff) + ldsw + _i * 8192), 16, 0, 0); } while (0)
#define PG8_LDA(dst, b, h) do { _Pragma("unroll") for (int m = 0; m < 4; ++m) _Pragma("unroll") for (int k = 0; k < 2; ++k) dst[m][k] = *(const PG8_LAS bf16x8*)(lds + PG8_SA(b, h) + aoff + m * 2048 + k * 1024); } while (0)
#define PG8_LDB(dst, b, h) do { _Pragma("unroll") for (int n = 0; n < 2; ++n) _Pragma("unroll") for (int k = 0; k < 2; ++k) dst[n][k] = *(const PG8_LAS bf16x8*)(lds + PG8_SB(b, h) + boff + n * 2048 + k * 1024); } while (0)
#define PG8_MMA(ai, bj, At, Bt) do { __builtin_amdgcn_s_setprio(1); _Pragma("unroll") for (int m = 0; m < 4; ++m) _Pragma("unroll") for (int n = 0; n < 2; ++n) _Pragma("unroll") for (int k = 0; k < 2; ++k) \
        acc[ai][bj][m][n] = __builtin_amdgcn_mfma_f32_16x16x32_bf16(Bt[n][k], At[m][k], acc[ai][bj][m][n], 0, 0, 0); __builtin_amdgcn_s_setprio(0); } while (0)
#define PG8_WAIT_V(n) asm volatile("s_waitcnt vmcnt(" #n ")" ::: "memory")
#define PG8_WAIT_L(n) asm volatile("s_waitcnt lgkmcnt(" #n ")" ::: "memory")
#define PG8_BAR __builtin_amdgcn_s_barrier()
#define PG8_SCHED __builtin_amdgcn_sched_barrier(0)
    Unit cur, nxt; int ui = 0;
    if (!S.next(0, cur)) return;
    f32x4 acc[2][2][4][2];
#pragma unroll
    for (int a = 0; a < 2; ++a)
#pragma unroll
        for (int b = 0; b < 2; ++b)
#pragma unroll
            for (int m = 0; m < 4; ++m)
#pragma unroll
                for (int n = 0; n < 2; ++n) acc[a][b][m][n] = (f32x4){0.f, 0.f, 0.f, 0.f};
    bf16x8 At[4][2], B0[2][2], B1[2][2];
    const char* cA = (const char*)g.A + (size_t)cur.pm * tstep; const char* cB = (const char*)g.Bt + (size_t)cur.pn * tstep;
    S.a_ready(cur);
    if constexpr (SP2) {
        PG8_STAGE(PG8_SB(0, 0), cB, voffB); PG8_STAGE(PG8_SB(0, 1), cB + hstep, voffB); PG8_STAGE(PG8_SA(0, 0), cA, voffA); PG8_STAGE(PG8_SA(0, 1), cA + hstep, voffA);
        if (wr == 1) PG8_BAR;
        PG8_WAIT_V(2); PG8_BAR;
        PG8_STAGE(PG8_SB(1, 0), cB + kstep, voffB); PG8_STAGE(PG8_SA(1, 0), cA + kstep, voffA); PG8_STAGE(PG8_SB(1, 1), cB + hstep + kstep, voffB);
        PG8_WAIT_V(6); PG8_BAR;
    } else {
        PG8_STAGE(PG8_SB(0, 0), cB, voffB); PG8_STAGE(PG8_SA(0, 0), cA, voffA); PG8_STAGE(PG8_SB(0, 1), cB + hstep, voffB); PG8_STAGE(PG8_SA(0, 1), cA + hstep, voffA);
        if (wr == 1) PG8_BAR;
        PG8_WAIT_V(4); PG8_BAR;
        PG8_STAGE(PG8_SB(1, 0), cB + kstep, voffB); PG8_STAGE(PG8_SA(1, 0), cA + kstep, voffA); PG8_STAGE(PG8_SB(1, 1), cB + hstep + kstep, voffB);
        PG8_WAIT_V(6); PG8_BAR;
    }
    for (;;) {
        const bool has_next = S.next(ui + 1, nxt);
        const char* nA = has_next ? (const char*)g.A + (size_t)nxt.pm * tstep : cA; const char* nB = has_next ? (const char*)g.Bt + (size_t)nxt.pn * tstep : cB;
        for (int t = 0; t < nt; t += 2) {
            const bool last = (t == nt - 2);
            const char* a1 = cA + (size_t)(t + 1) * kstep;
            const char* a2 = last ? nA : cA + (size_t)(t + 2) * kstep; const char* b2 = last ? nB : cB + (size_t)(t + 2) * kstep;
            const char* a3 = a2 + kstep; const char* b3 = b2 + kstep;
            if (last && has_next) S.a_ready(nxt);
            if constexpr (SP2) {
            PG8_LDB(B0, 0, 0); PG8_LDB(B1, 0, 1); PG8_SCHED; PG8_LDA(At, 0, 0); PG8_STAGE(PG8_SA(1, 1), a1 + hstep, voffA);
            PG8_WAIT_V(8); PG8_WAIT_L(0); PG8_BAR; PG8_MMA(0, 0, At, B0); PG8_MMA(0, 1, At, B1); PG8_BAR; PG8_SCHED;
            PG8_LDA(At, 0, 1); PG8_STAGE(PG8_SB(0, 0), b2, voffB); PG8_STAGE(PG8_SB(0, 1), b2 + hstep, voffB); PG8_STAGE(PG8_SA(0, 0), a2, voffA);
            PG8_WAIT_V(8); PG8_WAIT_L(0); PG8_BAR; PG8_MMA(1, 0, At, B0); PG8_MMA(1, 1, At, B1); PG8_BAR; PG8_SCHED;
            PG8_LDB(B0, 1, 0); PG8_LDB(B1, 1, 1); PG8_SCHED; PG8_LDA(At, 1, 0); PG8_STAGE(PG8_SA(0, 1), a2 + hstep, voffA);
            PG8_WAIT_V(8); PG8_WAIT_L(0); PG8_BAR; PG8_MMA(0, 0, At, B0); PG8_MMA(0, 1, At, B1); PG8_BAR; PG8_SCHED;
            PG8_LDA(At, 1, 1); PG8_STAGE(PG8_SB(1, 0), b3, voffB); PG8_STAGE(PG8_SB(1, 1), b3 + hstep, voffB); PG8_STAGE(PG8_SA(1, 0), a3, voffA);
            PG8_WAIT_V(8); PG8_WAIT_L(0); PG8_BAR; PG8_MMA(1, 0, At, B0); PG8_MMA(1, 1, At, B1); PG8_BAR; PG8_SCHED;
            } else {
            PG8_LDB(B0, 0, 0); PG8_SCHED; PG8_LDA(At, 0, 0); PG8_STAGE(PG8_SA(1, 1), a1 + hstep, voffA);
            PG8_WAIT_L(8); PG8_BAR; PG8_WAIT_L(0); PG8_MMA(0, 0, At, B0); PG8_BAR; PG8_SCHED;
            PG8_LDB(B1, 0, 1); PG8_STAGE(PG8_SB(0, 0), b2, voffB);
            PG8_BAR; PG8_WAIT_L(0); PG8_MMA(0, 1, At, B1); PG8_BAR;
            PG8_LDA(At, 0, 1); PG8_STAGE(PG8_SA(0, 0), a2, voffA);
            PG8_BAR; PG8_WAIT_L(0); PG8_MMA(1, 0, At, B0); PG8_BAR; PG8_SCHED;
            PG8_STAGE(PG8_SB(0, 1), b2 + hstep, voffB);
            PG8_WAIT_V(6); PG8_BAR; PG8_MMA(1, 1, At, B1); PG8_BAR;
            PG8_LDB(B0, 1, 0); PG8_SCHED; PG8_LDA(At, 1, 0); PG8_STAGE(PG8_SA(0, 1), a2 + hstep, voffA);
            PG8_WAIT_L(8); PG8_BAR; PG8_WAIT_L(0); PG8_MMA(0, 0, At, B0); PG8_BAR; PG8_SCHED;
            PG8_LDB(B1, 1, 1); PG8_STAGE(PG8_SB(1, 0), b3, voffB);
            PG8_BAR; PG8_WAIT_L(0); PG8_MMA(0, 1, At, B1); PG8_BAR;
            PG8_LDA(At, 1, 1); PG8_STAGE(PG8_SA(1, 0), a3, voffA);
            PG8_BAR; PG8_WAIT_L(0); PG8_MMA(1, 0, At, B0); PG8_BAR; PG8_SCHED;
            PG8_STAGE(PG8_SB(1, 1), b3 + hstep, voffB);
            PG8_WAIT_V(6); PG8_BAR; PG8_MMA(1, 1, At, B1); PG8_BAR;
            }
        }
        if constexpr (ALIGN_EPI) { if (wr == 0) PG8_BAR; }
        if constexpr (!Epi::AFTER_DRAIN) { E(acc, cur, wr, wc, fr, fq); S.done(cur); }
        if (!has_next) break;
#pragma unroll
        for (int a = 0; a < 2; ++a)
#pragma unroll
            for (int b = 0; b < 2; ++b)
#pragma unroll
                for (int m = 0; m < 4; ++m)
#pragma unroll
                    for (int n = 0; n < 2; ++n) acc[a][b][m][n] = (f32x4){0.f, 0.f, 0.f, 0.f};
        cur = nxt; cA = nA; cB = nB; ++ui;
        if constexpr (ALIGN_EPI) { if (wr == 1) PG8_BAR; }
    }
    PG8_WAIT_V(0);
    if constexpr (!ALIGN_EPI) { if (wr == 0) PG8_BAR; }
    PG8_BAR;
    if constexpr (Epi::AFTER_DRAIN) { E.fused(acc, cur, wr, wc, fr, fq, lds, wid, lane); S.done(cur); }
#undef PG8_SA
#undef PG8_SB
#undef PG8_STAGE
#undef PG8_LDA
#undef PG8_LDB
#undef PG8_MMA
#undef PG8_WAIT_V
#undef PG8_WAIT_L
#undef PG8_BAR
#undef PG8_SCHED
}
}

#ifndef MK_N_LAUNCHES
#define MK_N_LAUNCHES 1
#endif
constexpr int N_PHASES = 11;
constexpr int TP = 16384, TS = 512, T = TP + TS, D = 1024, FF = 2816, NIN = 5376;
#define GAS __attribute__((address_space(1)))
#define LAS __attribute__((address_space(3)))
typedef unsigned short bf16;
typedef float f32x4 __attribute__((ext_vector_type(4)));
typedef float f32x16 __attribute__((ext_vector_type(16)));
typedef short bf16x8 __attribute__((ext_vector_type(8)));
typedef unsigned v4u __attribute__((ext_vector_type(4)));
typedef unsigned v2u __attribute__((ext_vector_type(2)));

constexpr size_t al256(size_t x) { return (x + 255) & ~(size_t)255; }
constexpr size_t WS_BAR = 0, WS_CTL = 16384, WS_BAR_BYTES = 32768;
constexpr size_t WS_RSS0 = WS_BAR_BYTES, WS_RSS1 = WS_RSS0 + al256((size_t)T * 4), WS_RSS2 = WS_RSS1 + al256((size_t)T * 4);
constexpr size_t WS_ROT = WS_RSS2 + al256((size_t)T * 4);
constexpr size_t WS_QKN = WS_ROT + al256((size_t)4100 * 16 * 4);
constexpr size_t WS_W1 = WS_QKN + al256((size_t)1536 * 4);
constexpr size_t WS_W2 = WS_W1 + (size_t)2 * FF * D * 2;
constexpr size_t WS_W3 = WS_W2 + (size_t)D * FF * 2;
constexpr size_t WS_W4A = WS_W3 + (size_t)NIN * D * 2;
constexpr size_t WS_W4B = WS_W4A + (size_t)D * 512 * 2;
constexpr size_t WS_W5 = WS_W4B + (size_t)D * 256 * 2;
constexpr size_t WS_W6 = WS_W5 + (size_t)D * D * 2;
constexpr size_t WS_W7 = WS_W6 + (size_t)2 * FF * D * 2;
constexpr size_t WS_XB = WS_W7 + (size_t)D * FF * 2;
constexpr size_t WS_ACT = WS_XB + (size_t)T * D * 2;
constexpr size_t WS_X1 = WS_ACT + (size_t)T * FF * 2;
constexpr size_t WS_X1B = WS_X1 + (size_t)T * D * 4;
constexpr size_t WS_U = WS_X1B + (size_t)T * D * 2;
constexpr size_t WS_Q = WS_U + (size_t)T * 512 * 2;
constexpr size_t WS_K = WS_Q + (size_t)T * 768 * 2;
constexpr size_t WS_V = WS_K + (size_t)T * 768 * 2;
constexpr size_t WS_G = WS_V + (size_t)T * 768 * 2;
constexpr size_t WS_CONVF = WS_G + (size_t)T * 2048 * 2;
constexpr size_t WS_OG = WS_CONVF + (size_t)T * 512 * 2;
constexpr size_t WS_ML = WS_OG + (size_t)3 * T * 256 * 2;
constexpr size_t WS_BATT = WS_ML + (size_t)3 * T * 8 * 4;
constexpr size_t WS_TMP = WS_BATT + (size_t)T * 256 * 2;
constexpr size_t WS_MIX = WS_TMP + (size_t)T * D * 4;
constexpr size_t WS_X2 = WS_MIX + (size_t)T * D * 2;
constexpr size_t WS_X2B = WS_X2 + (size_t)T * D * 4;
constexpr size_t WS_END = WS_X2B + (size_t)T * D * 2;

constexpr size_t O_CP = 22806528, O_KS0 = 22867968, O_CS = 199028736;

constexpr int LDS_BYTES = 131072 + 1024;

__device__ __forceinline__ unsigned f2bf(float f) { unsigned u = __builtin_bit_cast(unsigned, f); return (u + 0x7fffu + ((u >> 16) & 1u)) >> 16; }
__device__ __forceinline__ unsigned pk2(float lo, float hi) { return f2bf(lo) | (f2bf(hi) << 16); }
__device__ __forceinline__ float bf2f_g(unsigned short h) { return __builtin_bit_cast(float, (unsigned)h << 16); }
__device__ __forceinline__ float bfl(unsigned w) { return __builtin_bit_cast(float, w << 16); }
__device__ __forceinline__ float bfh(unsigned w) { return __builtin_bit_cast(float, w & 0xffff0000u); }
__device__ __forceinline__ float wave_sum(float v) {
#pragma unroll
    for (int o = 1; o < 64; o <<= 1) v += __shfl_xor(v, o);
    return v;
}

struct Args { const float* in[27]; float* out; unsigned char* ws; int ph_lo, ph_hi; };

__device__ __forceinline__ int perm32(int rho) { const int n = rho >> 4, i = rho & 15; return 8 * (i >> 2) + 4 * n + (i & 3); }
template <int MAP> __device__ __forceinline__ int src_col(int nd) {
    if (MAP == 0) return (nd & ~31) + perm32(nd & 31);
    const int pn = nd >> 8, w = nd & 255, bj = w >> 7, rem = w & 127, wc = rem >> 5, slot = rem & 31;
    if (MAP == 1) return bj * FF + pn * 128 + wc * 32 + perm32(slot);
    if (pn < 4) return bj * 512 + pn * 128 + wc * 32 + perm32(slot);
    if (pn < 13) {
        int dim;
        if (pn < 10 && bj == 0) { const int fq = (slot & 15) >> 2, n = slot >> 4, e = slot & 3; dim = fq < 2 ? 4 * fq + 8 * n + e : 8 * fq + 4 * n + e; }
        else dim = 32 * bj + perm32(slot);
        return 1024 + (pn - 4) * 256 + wc * 64 + dim;
    }
    return 3328 + (pn - 13) * 256 + bj * 128 + wc * 32 + perm32(slot);
}
template <int MAP> __device__ __forceinline__ void p0_transpose_item(const float* W, int K, int Ns, int Nd, bf16* WT, const float* gain, LAS float* scr, int item, int lane) {
    const int nblk = Nd / 32, kb = item / nblk, nb = item % nblk, k0 = 64 * kb, n0 = 32 * nb;
    const int sc = src_col<MAP>(n0 + (lane & 31));
    float tv[32];
#pragma unroll
    for (int i = 0; i < 32; ++i) { const int kk = 2 * i + (lane >> 5); tv[i] = __builtin_nontemporal_load(W + (size_t)(k0 + kk) * Ns + sc); }
    if (gain) {
#pragma unroll
        for (int i = 0; i < 32; ++i) tv[i] *= gain[k0 + 2 * i + (lane >> 5)]; }
#pragma unroll
    for (int i = 0; i < 32; ++i) scr[(2 * i + (lane >> 5)) * 33 + (lane & 31)] = tv[i];
    asm volatile("s_waitcnt lgkmcnt(0)" ::: "memory");
    const int c = lane & 7;
#pragma unroll
    for (int j = 0; j < 4; ++j) { const int n = (lane >> 3) + 8 * j; const LAS float* s = scr + (8 * c) * 33 + n;
        v4u o; o.x = pk2(s[0 * 33], s[1 * 33]); o.y = pk2(s[2 * 33], s[3 * 33]); o.z = pk2(s[4 * 33], s[5 * 33]); o.w = pk2(s[6 * 33], s[7 * 33]);
        *(v4u*)(WT + (size_t)(n0 + n) * K + k0 + 8 * c) = o; }
    asm volatile("s_waitcnt lgkmcnt(0)" ::: "memory");
}
constexpr int N_CHUNKS = 5376 + 128;
struct ChunkD { const f32x4* s4; f32x4* d4; int n4; };
__device__ __forceinline__ ChunkD chunk_desc(const Args& a, int id) {
    const float* src; float* dst; int nrows;
    if (id < 5376) {
        int g, r;
        if (id < 256) { g = 0; r = id; } else if (id < 1280) { g = 1; r = id - 256; } else { g = 2; r = id - 1280; }
        const int W = 128 << (2 * g), cpb = 1 << (2 * g);
        const int kv = r / (128 * cpb), r2 = r % (128 * cpb), b = r2 / cpb, ch = r2 % cpb, row0 = ch * 128;
        nrows = (W - 4 - row0) < 128 ? (W - 4 - row0) : 128;
        size_t oks = O_KS0; for (int gg = 0; gg < g; ++gg) oks += (size_t)2 * 128 * (128 << (2 * gg)) * 256;
        oks += (size_t)kv * 128 * W * 256;
        src = a.in[2 + 2 * g + kv] + ((size_t)b * W + 4 + row0) * 256; dst = a.out + oks + ((size_t)b * W + row0) * 256;
    } else { const int b = id - 5376; src = a.in[8] + ((size_t)b * 30 + 4) * 512; dst = a.out + O_CS + (size_t)b * 30 * 512; nrows = 52; }
    ChunkD d; d.s4 = (const f32x4*)src; d.d4 = (f32x4*)dst; d.n4 = nrows * 64; return d;
}
__device__ __forceinline__ void copy_chunk(const Args& a, int id, int tid) {
    const ChunkD c0 = chunk_desc(a, id);
    f32x4 v0[16];
#pragma unroll
    for (int k = 0; k < 16; ++k) { const int i = tid + 512 * k; if (i < c0.n4) v0[k] = __builtin_nontemporal_load(c0.s4 + i); }
#pragma unroll
    for (int k = 0; k < 16; ++k) { const int i = tid + 512 * k; if (i < c0.n4) __builtin_nontemporal_store(v0[k], c0.d4 + i); }
}
__device__ __forceinline__ void filler(const Args& a, unsigned* ctl, int phase, unsigned my_units, unsigned total_units, volatile LAS unsigned* misc, int tid) {
    unsigned* done = ctl + 64 * (1 + phase);
    if (tid == 0) { if (total_units) __hip_atomic_fetch_add(done, my_units, __ATOMIC_RELAXED, __HIP_MEMORY_SCOPE_AGENT);
        unsigned id = N_CHUNKS;
        if (!total_units || __hip_atomic_load(done, __ATOMIC_RELAXED, __HIP_MEMORY_SCOPE_AGENT) < total_units) id = __hip_atomic_fetch_add(ctl, 1u, __ATOMIC_RELAXED, __HIP_MEMORY_SCOPE_AGENT);
        misc[16] = id; }
    __syncthreads();
    unsigned id = (unsigned)__builtin_amdgcn_readfirstlane((int)misc[16]);
    for (int it = 1; id < (unsigned)N_CHUNKS; ++it) {
        unsigned nxt = N_CHUNKS;
        if (tid == 0) { if (!total_units || __hip_atomic_load(done, __ATOMIC_RELAXED, __HIP_MEMORY_SCOPE_AGENT) < total_units) nxt = __hip_atomic_fetch_add(ctl, 1u, __ATOMIC_RELAXED, __HIP_MEMORY_SCOPE_AGENT); }
        copy_chunk(a, (int)id, tid);
        if (tid == 0) misc[16 + (it & 1)] = nxt;
        __syncthreads();
        id = (unsigned)__builtin_amdgcn_readfirstlane((int)misc[16 + (it & 1)]);
    }
}
__device__ __forceinline__ unsigned grab(unsigned* ctr, volatile LAS unsigned* misc, int& it, int tid) {
    if (tid == 0) misc[20 + (it & 1)] = __hip_atomic_fetch_add(ctr, 1u, __ATOMIC_RELAXED, __HIP_MEMORY_SCOPE_AGENT);
    __syncthreads();
    const unsigned v = (unsigned)__builtin_amdgcn_readfirstlane((int)misc[20 + (it & 1)]); ++it; return v;
}
__device__ __forceinline__ unsigned units_of(int nwg, int G, int c) { return (c >= 0 && c < G && c < nwg) ? (unsigned)((nwg - c + G - 1) / G) : 0u; }

__device__ __forceinline__ void p0_prologue(const Args& a, LAS unsigned char* lds, int G, int bid, int tid) {
    const int wave = tid >> 6, lane = tid & 63;
    LAS float* scr = (LAS float*)(lds + wave * 16384);
    const int gw = bid * 8 + wave, NGW = G * 8;
    unsigned char* ws = a.ws;
    constexpr int I_IN = (D / 64) * (2 * FF / 32), I_OUT = (FF / 64) * (D / 32), I_3 = (D / 64) * (NIN / 32), I_4A = (512 / 64) * (D / 32), I_4B = (256 / 64) * (D / 32), I_5 = (D / 64) * (D / 32);
    constexpr int NITEMS = 2 * I_IN + 2 * I_OUT + I_3 + I_4A + I_4B + I_5;
    for (int it = gw; it < NITEMS; it += NGW) {
        int r = it;
        if (r < I_IN) { p0_transpose_item<1>(a.in[10], D, 2 * FF, 2 * FF, (bf16*)(ws + WS_W1), a.in[9], scr, r, lane); continue; } r -= I_IN;
        if (r < I_IN) { p0_transpose_item<1>(a.in[25], D, 2 * FF, 2 * FF, (bf16*)(ws + WS_W6), a.in[24], scr, r, lane); continue; } r -= I_IN;
        if (r < I_OUT) { p0_transpose_item<0>(a.in[11], FF, D, D, (bf16*)(ws + WS_W2), nullptr, scr, r, lane); continue; } r -= I_OUT;
        if (r < I_OUT) { p0_transpose_item<0>(a.in[26], FF, D, D, (bf16*)(ws + WS_W7), nullptr, scr, r, lane); continue; } r -= I_OUT;
        if (r < I_3) { p0_transpose_item<2>(a.in[13], D, NIN, NIN, (bf16*)(ws + WS_W3), a.in[12], scr, r, lane); continue; } r -= I_3;
        if (r < I_4A) { p0_transpose_item<0>(a.in[21], 512, D, D, (bf16*)(ws + WS_W4A), nullptr, scr, r, lane); continue; } r -= I_4A;
        if (r < I_4B) { p0_transpose_item<0>(a.in[22], 256, D, D, (bf16*)(ws + WS_W4B), nullptr, scr, r, lane); continue; } r -= I_4B;
        p0_transpose_item<0>(a.in[23], D, D, D, (bf16*)(ws + WS_W5), nullptr, scr, r, lane);
    }
    float* rss0 = (float*)(ws + WS_RSS0); float* rss1 = (float*)(ws + WS_RSS1); float* rss2 = (float*)(ws + WS_RSS2);
    bf16* XB = (bf16*)(ws + WS_XB);
    for (int m0 = gw; m0 < T; m0 += 2 * NGW) {
        f32x4 v[2][4]; float ssq[2];
#pragma unroll
        for (int u = 0; u < 2; ++u) { const int m = m0 + u * NGW; if (m < T) { const float* xr = (m < TP) ? a.in[0] + (size_t)m * D : a.in[1] + (size_t)(m - TP) * D; const f32x4* x4 = (const f32x4*)xr + lane;
#pragma unroll
            for (int j = 0; j < 4; ++j) v[u][j] = __builtin_nontemporal_load(x4 + 64 * j); } }
#pragma unroll
        for (int u = 0; u < 2; ++u) { const int m = m0 + u * NGW; if (m < T) { float sq = 0.f;
#pragma unroll
            for (int j = 0; j < 4; ++j) sq += (v[u][j][0] * v[u][j][0] + v[u][j][1] * v[u][j][1]) + (v[u][j][2] * v[u][j][2] + v[u][j][3] * v[u][j][3]);
            ssq[u] = wave_sum(sq);
            if (lane == 0) { rss0[m] = ssq[u]; rss1[m] = 0.f; rss2[m] = 0.f; }
            v2u* o8 = (v2u*)(XB + (size_t)m * D) + lane;
#pragma unroll
            for (int j = 0; j < 4; ++j) { v2u w; w.x = pk2(v[u][j][0], v[u][j][1]); w.y = pk2(v[u][j][2], v[u][j][3]); o8[64 * j] = w; } } }
    }
    const size_t gtid = (size_t)bid * 512 + tid, nthr = (size_t)G * 512;
    float* rot = (float*)(ws + WS_ROT);
    for (size_t i = gtid; i < (size_t)4100 * 8; i += nthr) {
        const int p = (int)(i >> 3), f = (int)(i & 7); const int pos = p < 4096 ? p : 2048 + (p - 4096);
        const double inv = exp2(-(double)f * (18.931568569324174 / 8.0));
        const double rev = (double)pos * inv * 0.15915494309189535;
        const double fr = rev - rint(rev);
        const float ang = (float)(fr * 6.283185307179586);
        rot[(size_t)p * 16 + f] = __builtin_amdgcn_cosf((float)fr); rot[(size_t)p * 16 + 8 + f] = __builtin_amdgcn_sinf((float)fr); (void)ang;
    }
    { float* qkn = (float*)(ws + WS_QKN); for (size_t i = gtid; i < 1536; i += nthr) qkn[i] = i < 768 ? a.in[15][i] : a.in[16][i - 768]; }
}

__device__ __forceinline__ int crow(int r, int hi) { return (r & 3) + 8 * (r >> 2) + 4 * hi; }
constexpr int KS_STRIDE = 144, VT_OFF = 384 * KS_STRIDE, VT_STRIDE = 776;
struct AttnU { int b, g, h, d, r, i0, hc; };
__device__ __forceinline__ AttnU attn_decode(int unit) {
    AttnU u; u.b = unit / 192; int rem = unit % 192; u.g = rem / 64; rem %= 64; u.h = rem / 16; const int x = rem % 16;
    const int dsh = 2 * u.g, nblk = 16 >> dsh; u.d = 1 << dsh; u.r = x / nblk; u.i0 = (x % nblk) * 256; u.hc = (4 * u.g + u.h) * 64; return u;
}
__device__ __forceinline__ void attn_load(const AttnU& u, const bf16* Kb, const bf16* Vb, int tid, v4u (&kv)[6], v4u (&vv)[6]) {
#pragma unroll
    for (int k = 0; k < 6; ++k) { const int q = tid + 512 * k, s = q >> 3, c = q & 7, i = u.i0 - 128 + s;
        if (i >= 0) { const size_t off = ((size_t)u.b * 4096 + (size_t)i * u.d + u.r) * 768 + u.hc + 8 * c; kv[k] = *(const v4u*)(Kb + off); vv[k] = *(const v4u*)(Vb + off); }
        else { kv[k] = (v4u){0u, 0u, 0u, 0u}; vv[k] = (v4u){0u, 0u, 0u, 0u}; } }
}
__device__ __forceinline__ void attn_write(LAS unsigned char* lds, int tid, const v4u (&kv)[6], const v4u (&vv)[6]) {
#pragma unroll
    for (int k = 0; k < 6; ++k) { const int q = tid + 512 * k, s = q >> 3, c = q & 7;
        *(LAS v4u*)(lds + s * KS_STRIDE + 16 * c) = kv[k];
#pragma unroll
        for (int e = 0; e < 4; ++e) { const unsigned w = vv[k][e];
            *(LAS unsigned short*)(lds + VT_OFF + (8 * c + 2 * e) * VT_STRIDE + s * 2) = (unsigned short)(w & 0xffffu);
            *(LAS unsigned short*)(lds + VT_OFF + (8 * c + 2 * e + 1) * VT_STRIDE + s * 2) = (unsigned short)(w >> 16); } }
}
__device__ __forceinline__ void attn_qload(const AttnU& u, const bf16* Q, int tid, bf16x8 (&qf)[4]) {
    const int w = tid >> 6, lane = tid & 63, ql = lane & 31, hi = lane >> 5;
    const size_t qrow = (size_t)u.b * 4096 + (size_t)(u.i0 + 32 * w + ql) * u.d + u.r;
#pragma unroll
    for (int kk = 0; kk < 4; ++kk) qf[kk] = *(const bf16x8*)(Q + qrow * 768 + u.hc + 16 * kk + 8 * hi);
}
__device__ __forceinline__ void attn_compute(LAS unsigned char* lds, const AttnU& u, const bf16x8 (&qf)[4], bf16* OG, float* ML, int tid) {
    const int w = tid >> 6, lane = tid & 63, ql = lane & 31, hi = lane >> 5;
    const size_t qrow = (size_t)u.b * 4096 + (size_t)(u.i0 + 32 * w + ql) * u.d + u.r;
    f32x16 S[5];
#pragma unroll
    for (int j = 0; j < 5; ++j) {
#pragma unroll
        for (int e = 0; e < 16; ++e) S[j][e] = 0.f;
#pragma unroll
        for (int kk = 0; kk < 4; ++kk) { const bf16x8 af = *(const LAS bf16x8*)(lds + (32 * (w + j) + ql) * KS_STRIDE + (16 * kk + 8 * hi) * 2);
            S[j] = __builtin_amdgcn_mfma_f32_32x32x16_bf16(af, qf[kk], S[j], 0, 0, 0); }
    }
    const bool first = (u.i0 == 0);
#pragma unroll
    for (int e = 0; e < 16; ++e) { const int kl = crow(e, hi); if (kl < ql) S[0][e] = -INFINITY; if (kl > ql) S[4][e] = -INFINITY; }
#pragma unroll
    for (int j = 0; j < 4; ++j) if (first && (w + j < 4)) {
#pragma unroll
        for (int e = 0; e < 16; ++e) S[j][e] = -INFINITY; }
    float mx = -INFINITY;
#pragma unroll
    for (int j = 0; j < 5; ++j)
#pragma unroll
        for (int e = 0; e < 16; ++e) mx = fmaxf(mx, S[j][e]);
    mx = fmaxf(mx, __shfl_xor(mx, 32));
    float l = 0.f;
#pragma unroll
    for (int j = 0; j < 5; ++j)
#pragma unroll
        for (int e = 0; e < 16; ++e) { const float p = __builtin_amdgcn_exp2f(S[j][e] - mx); S[j][e] = p; l += p; }
    l += __shfl_xor(l, 32);
    f32x16 O[2];
#pragma unroll
    for (int e = 0; e < 16; ++e) { O[0][e] = 0.f; O[1][e] = 0.f; }
#pragma unroll
    for (int j = 0; j < 5; ++j)
#pragma unroll
        for (int c = 0; c < 2; ++c) {
            v4u pw; pw.x = pg8::cvt_pk_bf16(S[j][8 * c + 0], S[j][8 * c + 1]); pw.y = pg8::cvt_pk_bf16(S[j][8 * c + 2], S[j][8 * c + 3]); pw.z = pg8::cvt_pk_bf16(S[j][8 * c + 4], S[j][8 * c + 5]); pw.w = pg8::cvt_pk_bf16(S[j][8 * c + 6], S[j][8 * c + 7]);
            const bf16x8 pf = __builtin_bit_cast(bf16x8, pw);
            const int s0 = 32 * (w + j) + 16 * c + 4 * hi;
#pragma unroll
            for (int dt = 0; dt < 2; ++dt) { const int dim = 32 * dt + ql;
                const v2u lo = *(const LAS v2u*)(lds + VT_OFF + dim * VT_STRIDE + s0 * 2), hh = *(const LAS v2u*)(lds + VT_OFF + dim * VT_STRIDE + (s0 + 8) * 2);
                v4u vw; vw.x = lo.x; vw.y = lo.y; vw.z = hh.x; vw.w = hh.y;
                O[dt] = __builtin_amdgcn_mfma_f32_32x32x16_bf16(__builtin_bit_cast(bf16x8, vw), pf, O[dt], 0, 0, 0); }
        }
    const float inv = 1.f / l;
    bf16* og = OG + ((size_t)u.g * T + qrow) * 256 + u.h * 64;
#pragma unroll
    for (int dt = 0; dt < 2; ++dt)
#pragma unroll
        for (int q4 = 0; q4 < 4; ++q4) { v2u w2; w2.x = pg8::cvt_pk_bf16(O[dt][4 * q4] * inv, O[dt][4 * q4 + 1] * inv); w2.y = pg8::cvt_pk_bf16(O[dt][4 * q4 + 2] * inv, O[dt][4 * q4 + 3] * inv);
            *(v2u*)(og + 32 * dt + 8 * q4 + 4 * hi) = w2; }
    if (hi == 0) { float* ml = ML + (((size_t)u.g * T + qrow) * 4 + u.h) * 2; ml[0] = mx; ml[1] = l; }
}

__device__ __forceinline__ void attn_sample_g12(const Args& a, LAS unsigned char* lds, const bf16* Q, const bf16* Kb, const bf16* Vb, bf16* OG, float* ML, int b, int g, int tid) {
    const int w = tid >> 6, lane = tid & 63, s = w >> 1, half = w & 1;
    const int W = 128 << (2 * g), d = 1 << (2 * g);
    const char* ck = (const char*)(a.in[2 + 2 * g] + (size_t)b * W * 256); const char* cv = (const char*)(a.in[3 + 2 * g] + (size_t)b * W * 256); const unsigned voff = (unsigned)lane * 16u;
    const size_t row = (size_t)TP + b * 4 + s; const int head = lane >> 4, dl = (lane & 15) * 4;
    const int hcol = (4 * g + head) * 64 + dl;
    float q[4]; { const v2u qw = *(const v2u*)(Q + row * 768 + hcol); q[0] = bfl(qw.x); q[1] = bfh(qw.x); q[2] = bfl(qw.y); q[3] = bfh(qw.y); }
    float m = -INFINITY, l = 0.f, o[4] = {0.f, 0.f, 0.f, 0.f};
    const int jbeg = half * 65, jend = half ? 129 : 65;
#pragma unroll 1
    for (int j0 = jbeg; j0 < jend; j0 += 16) {
        f32x4 kk[16], vv[16];
#pragma unroll
        for (int jj = 0; jj < 16; ++jj) { const int j = j0 + jj; int idx = W + s - d * j; if (j >= jend) idx = 0;
            if (idx >= W) { const size_t r2 = (size_t)TP + b * 4 + (idx - W); const v2u kw = *(const v2u*)(Kb + r2 * 768 + hcol), vw = *(const v2u*)(Vb + r2 * 768 + hcol);
                kk[jj] = (f32x4){bfl(kw.x), bfh(kw.x), bfl(kw.y), bfh(kw.y)}; vv[jj] = (f32x4){bfl(vw.x), bfh(vw.x), bfl(vw.y), bfh(vw.y)}; }
            else { const int ui = __builtin_amdgcn_readfirstlane(idx); kk[jj] = __builtin_nontemporal_load((const f32x4*)(ck + (size_t)ui * 1024 + voff)); vv[jj] = __builtin_nontemporal_load((const f32x4*)(cv + (size_t)ui * 1024 + voff)); } }
        float sc[16]; float cm = -INFINITY;
#pragma unroll
        for (int jj = 0; jj < 16; ++jj) { float t = (kk[jj][0] * q[0] + kk[jj][1] * q[1]) + (kk[jj][2] * q[2] + kk[jj][3] * q[3]);
            t += __shfl_xor(t, 1); t += __shfl_xor(t, 2); t += __shfl_xor(t, 4); t += __shfl_xor(t, 8);
            sc[jj] = (j0 + jj < jend) ? t : -INFINITY; cm = fmaxf(cm, sc[jj]); }
        const float mn = fmaxf(m, cm), scale = __builtin_amdgcn_exp2f(m - mn);
        l *= scale; o[0] *= scale; o[1] *= scale; o[2] *= scale; o[3] *= scale;
#pragma unroll
        for (int jj = 0; jj < 16; ++jj) { const float p = __builtin_amdgcn_exp2f(sc[jj] - mn); l += p; o[0] += p * vv[jj][0]; o[1] += p * vv[jj][1]; o[2] += p * vv[jj][2]; o[3] += p * vv[jj][3]; }
        m = mn;
    }
    LAS float* P = (LAS float*)lds;
    if (half) { LAS float* pp = P + (w * 64 + lane) * 6; pp[0] = m; pp[1] = l; pp[2] = o[0]; pp[3] = o[1]; pp[4] = o[2]; pp[5] = o[3]; }
    __syncthreads();
    if (!half) { const LAS float* pp = P + ((w + 1) * 64 + lane) * 6; const float m1 = pp[0], l1 = pp[1];
        const float M = fmaxf(m, m1), a0 = __builtin_amdgcn_exp2f(m - M), a1 = __builtin_amdgcn_exp2f(m1 - M);
        const float lt = a0 * l + a1 * l1, inv = 1.f / lt;
        v2u w2; w2.x = pk2((a0 * o[0] + a1 * pp[2]) * inv, (a0 * o[1] + a1 * pp[3]) * inv); w2.y = pk2((a0 * o[2] + a1 * pp[4]) * inv, (a0 * o[3] + a1 * pp[5]) * inv);
        *(v2u*)(OG + ((size_t)g * T + row) * 256 + head * 64 + dl) = w2;
        if ((lane & 15) == 0) { float* ml = ML + (((size_t)g * T + row) * 4 + head) * 2; ml[0] = M; ml[1] = lt; } }
}
template <int NTOK, bool SAMPLE> __device__ __forceinline__ void conv_unit(const Args& a, LAS unsigned char* lds, const bf16* U, bf16* CONVF, const float (&cw)[31], int unit, int tid) {
    const int c = tid; float win[NTOK + 30];
    size_t row0; const unsigned vo2 = (unsigned)c * 2u, vo4 = (unsigned)c * 4u;
    if (!SAMPLE) { row0 = (size_t)unit * NTOK; const int t0 = (int)(row0 & 4095); const char* ub = (const char*)(U + row0 * 512);
#pragma unroll
        for (int jr = 0; jr < NTOK + 30; ++jr) { const int t = t0 - 30 + jr; win[jr] = (t >= 0) ? bf2f_g(*(const unsigned short*)(ub + (jr - 30) * 1024 + vo2)) : 0.f; } }
    else { row0 = (size_t)TP + (size_t)unit * 4; const char* st = (const char*)(a.in[8] + (size_t)unit * 30 * 512); const char* ub = (const char*)(U + row0 * 512);
#pragma unroll
        for (int jr = 0; jr < 30; ++jr) win[jr] = *(const float*)(st + jr * 2048 + vo4);
#pragma unroll
        for (int jr = 0; jr < NTOK; ++jr) win[30 + jr] = bf2f_g(*(const unsigned short*)(ub + jr * 1024 + vo2)); }
    const float cb = *(const float*)((const char*)a.in[18] + vo4);
    LAS float* yb = (LAS float*)lds;
    __syncthreads();
#pragma unroll
    for (int t = 0; t < NTOK; ++t) { float y = cb;
#pragma unroll
        for (int j = 0; j < 31; ++j) y += cw[j] * win[t + j];
        yb[t * 512 + c] = y; }
    __syncthreads();
    const int w = tid >> 6, lane = tid & 63;
    constexpr int TPW = (NTOK + 7) / 8;
#pragma unroll
    for (int tt = 0; tt < TPW; ++tt) { const int t = w * TPW + tt;
        if (t < NTOK) {
            float y[8]; float s = 0.f;
#pragma unroll
            for (int i = 0; i < 8; ++i) { y[i] = yb[t * 512 + lane + 64 * i]; s += y[i]; }
            const float mu = wave_sum(s) * (1.f / 512.f); float q = 0.f;
#pragma unroll
            for (int i = 0; i < 8; ++i) { y[i] -= mu; q += y[i] * y[i]; }
            const float rstd = __builtin_amdgcn_rsqf(wave_sum(q) * (1.f / 512.f) + 1e-6f);
#pragma unroll
            for (int i = 0; i < 8; ++i) { const int cc = lane + 64 * i; const float z = y[i] * rstd * *(const float*)((const char*)a.in[19] + i * 256 + (unsigned)lane * 4u) + *(const float*)((const char*)a.in[20] + i * 256 + (unsigned)lane * 4u);
                const float sw = z * __builtin_amdgcn_rcpf(1.f + __builtin_amdgcn_exp2f(-1.4426950408889634f * z));
                CONVF[(row0 + t) * 512 + cc] = (bf16)f2bf(sw); }
        }
    }
}

__device__ __forceinline__ void combine_groups(const bf16* OG, const float* ML, bf16* BATT, size_t row_lo, size_t row_hi, size_t gtid, size_t nthr) {
    for (size_t i = row_lo * 32 + gtid; i < row_hi * 32; i += nthr) {
        const size_t row = i >> 5; const int c8 = (int)(i & 31), h = c8 >> 3;
        float mg[3], lg[3]; v4u og[3];
#pragma unroll
        for (int g = 0; g < 3; ++g) { const float* ml = ML + (((size_t)g * T + row) * 4 + h) * 2; mg[g] = ml[0]; lg[g] = ml[1]; og[g] = *(const v4u*)(OG + ((size_t)g * T + row) * 256 + c8 * 8); }
        const float M = fmaxf(mg[0], fmaxf(mg[1], mg[2]));
        float wg[3], ws = 0.f;
#pragma unroll
        for (int g = 0; g < 3; ++g) { wg[g] = __builtin_amdgcn_exp2f(mg[g] - M) * lg[g]; ws += wg[g]; }
        const float inv = 1.f / ws; float o[8];
#pragma unroll
        for (int e = 0; e < 8; ++e) o[e] = 0.f;
#pragma unroll
        for (int g = 0; g < 3; ++g) { const float wn = wg[g] * inv;
#pragma unroll
            for (int e = 0; e < 4; ++e) { o[2 * e] += wn * bfl(og[g][e]); o[2 * e + 1] += wn * bfh(og[g][e]); } }
        v4u w; w.x = pk2(o[0], o[1]); w.y = pk2(o[2], o[3]); w.z = pk2(o[4], o[5]); w.w = pk2(o[6], o[7]);
        *(v4u*)(BATT + row * 256 + c8 * 8) = w;
    }
}

#define XB_TMO      128
#define XB_XCNT(j)  (256  + 64 * (j))
#define XB_XSUB(j)  (1280 + 64 * (j))
#define XB_XGEN(j)  (2304 + 64 * (j))
#define XB_TOP      3328
#define XB_TOPGEN   3392
#define XCD_BAR_WORDS 3456
#define XB_SPIN_CAP (1u << 18)

__device__ __forceinline__ unsigned xb_ld(unsigned* p)              { return __hip_atomic_load(p, __ATOMIC_RELAXED, __HIP_MEMORY_SCOPE_AGENT); }
__device__ __forceinline__ unsigned xb_add(unsigned* p, unsigned v) { return __hip_atomic_fetch_add(p, v, __ATOMIC_RELAXED, __HIP_MEMORY_SCOPE_AGENT); }
__device__ __forceinline__ unsigned xb_xcc_id() { return (unsigned)__builtin_amdgcn_s_getreg((3 << 11) | 20) & 0xFu; }
#define XB_SPIN(cond, bar) do { unsigned _sp = 0; while (cond) { __builtin_amdgcn_s_sleep(1); \
    if ((++_sp & 255u) == 0u) { if (xb_ld(&(bar)[XB_TMO])) break; if (_sp > XB_SPIN_CAP) { atomicAdd(&(bar)[XB_TMO], 1u); break; } } } } while (0)

struct XcdBarrier {
    unsigned* bar; unsigned x;
    volatile LAS unsigned* st;
};

__device__ __forceinline__ XcdBarrier xcd_barrier_post(unsigned* bar, volatile LAS unsigned* st) {
    XcdBarrier b; b.bar = bar; b.x = xb_xcc_id(); b.st = st;
    if (threadIdx.x == 0) (void)xb_add(&bar[XB_XCNT(b.x)], 1u);
    return b;
}
__device__ __forceinline__ void xcd_barrier_complete(unsigned* bar, unsigned x, unsigned& nloc, unsigned& nx) {
    const unsigned G = gridDim.x * gridDim.y * gridDim.z;
    unsigned sum, cnt, mine, sp = 0u;
    for (;;) {
        sum = 0u; cnt = 0u; mine = 0u;
#pragma unroll
        for (unsigned j = 0; j < 16; ++j) { const unsigned c = xb_ld(&bar[XB_XCNT(j)]); sum += c; cnt += (c > 0u) ? 1u : 0u; mine = (j == x) ? c : mine; }
        if (sum == G) break;
        __builtin_amdgcn_s_sleep(1);
        if ((++sp & 255u) == 0u) { if (xb_ld(&bar[XB_TMO])) break; if (sp > XB_SPIN_CAP) { atomicAdd(&bar[XB_TMO], 1u); break; } }
    }
    nloc = mine > 0u ? mine : 1u; nx = cnt > 0u ? cnt : 1u;
}

__device__ __forceinline__ void xcd_barrier(const XcdBarrier& b) {
    asm volatile("s_waitcnt vmcnt(0)" ::: "memory");
    __syncthreads();
    if (threadIdx.x == 0) {
        unsigned* bar = b.bar;
        __builtin_amdgcn_s_waitcnt(0);
        unsigned nloc = b.st[0], nx = b.st[1];
        if (nloc == 0u) { xcd_barrier_complete(bar, b.x, nloc, nx); b.st[0] = nloc; b.st[1] = nx; }
        const unsigned old = xb_add(&bar[XB_XSUB(b.x)], 1u);
        const unsigned gen = old / nloc;
        if (old + 1u == (gen + 1u) * nloc) {
            __builtin_amdgcn_fence(__ATOMIC_RELEASE, "agent");
            asm volatile("s_waitcnt vmcnt(0)" ::: "memory");
            const unsigned og = xb_add(&bar[XB_TOP], 1u);
            const unsigned tg = og / nx;
            if (og + 1u == (tg + 1u) * nx) xb_add(&bar[XB_TOPGEN], 1u);
            else XB_SPIN(xb_ld(&bar[XB_TOPGEN]) == tg, bar);
            __builtin_amdgcn_fence(__ATOMIC_ACQUIRE, "agent");
            xb_add(&bar[XB_XGEN(b.x)], 1u);
            asm volatile("s_waitcnt vmcnt(0)" ::: "memory");
        } else {
            XB_SPIN(xb_ld(&bar[XB_XGEN(b.x)]) == gen, bar);
            __builtin_amdgcn_fence(__ATOMIC_ACQUIRE, "agent");
            asm volatile("s_waitcnt vmcnt(0)" ::: "memory");
        }
    }
    __syncthreads();
}
__global__ void __launch_bounds__(512, 2) mk_fwd(Args args) {
    extern __shared__ __attribute__((aligned(16))) unsigned char lds_raw[];
    LAS unsigned char* lds = (LAS unsigned char*)lds_raw;
    const int tid = threadIdx.x, G = gridDim.x, bid = blockIdx.x;
    unsigned char* ws = args.ws;
    const int lo = args.ph_lo, hi = args.ph_hi;
#define IN(k) (lo <= (k) && (k) < hi)
#define SEAM(k) do { if (IN(k) && IN((k) + 1)) { xcd_barrier(bar); } } while (0)
    volatile LAS unsigned* MISC = (volatile LAS unsigned*)(lds + 131072);
    if (tid < 64) MISC[tid] = 0u;
    __syncthreads();
    unsigned* fctl = (unsigned*)(ws + WS_CTL);
    XcdBarrier bar; bar.bar = (unsigned*)(ws + WS_BAR); bar.x = 0; bar.st = nullptr;
    if (hi - lo > 1) bar = xcd_barrier_post((unsigned*)(ws + WS_BAR), MISC + 8);
    float* rss0 = (float*)(ws + WS_RSS0); float* rss1 = (float*)(ws + WS_RSS1); float* rss2 = (float*)(ws + WS_RSS2);
    bf16* XB = (bf16*)(ws + WS_XB); bf16* ACT = (bf16*)(ws + WS_ACT); float* X1 = (float*)(ws + WS_X1); bf16* X1B = (bf16*)(ws + WS_X1B);
    bf16* Ub = (bf16*)(ws + WS_U); bf16* Qb = (bf16*)(ws + WS_Q); bf16* Kb = (bf16*)(ws + WS_K); bf16* Vb = (bf16*)(ws + WS_V); bf16* Gb = (bf16*)(ws + WS_G);
    bf16* CONVF = (bf16*)(ws + WS_CONVF); bf16* OG = (bf16*)(ws + WS_OG); float* ML = (float*)(ws + WS_ML); bf16* BATT = (bf16*)(ws + WS_BATT);
    bf16* TMP = (bf16*)(ws + WS_TMP); bf16* MIX = (bf16*)(ws + WS_MIX); float* X2 = (float*)(ws + WS_X2); bf16* X2B = (bf16*)(ws + WS_X2B);

    if (IN(0)) { p0_prologue(args, lds, G, bid, tid); }
    SEAM(0);
    const bf16* W1 = (const bf16*)(ws + WS_W1); const bf16* W2 = (const bf16*)(ws + WS_W2); const bf16* W3 = (const bf16*)(ws + WS_W3); const bf16* W4A = (const bf16*)(ws + WS_W4A);
    const bf16* W4B = (const bf16*)(ws + WS_W4B); const bf16* W5 = (const bf16*)(ws + WS_W5); const bf16* W6 = (const bf16*)(ws + WS_W6); const bf16* W7 = (const bf16*)(ws + WS_W7);
#define GEMM(EPI, Aop, Bop, Nn, Kk, nM_, pmoff, Gs, cs, Eobj) do { pg8::Gemm g_{Aop, Bop, T, Nn, Kk}; pg8::SubOrder S_; S_.init(nM_, (Nn) / 256, pmoff, Gs, cs); \
        pg8::gemm_phase<EPI, pg8::SubOrder, true, true>(lds, g_, S_, Eobj); } while (0)
    if (IN(1)) {
        pg8::EpiSwiGLU E{rss0, ACT};
        GEMM(pg8::EpiSwiGLU, XB, W1, 2 * FF, D, 64, 0, G - 12, bid < G - 12 ? bid : -1, E);
        GEMM(pg8::EpiSwiGLU, XB, W1, 2 * FF, D, 2, 64, 44, bid - 192, E);
        filler(args, fctl, 1, units_of(64 * 22, G - 12, bid < G - 12 ? bid : -1) + units_of(44, 44, bid - 192), 64 * 22 + 44, MISC, tid);
    }
    SEAM(1);
    if (IN(2)) {
        pg8::EpiResid<true> E{args.in[0], args.in[1] - (size_t)TP * D, X1, X1B, rss1, 0.5f};
        GEMM(pg8::EpiResid<true>, ACT, W2, D, FF, 64, 0, G, bid, E);
    }
    SEAM(2);
    if (IN(3)) {
        { pg8::EpiIn E{rss1, Ub, Qb, Gb, args.in[14], (const float*)(ws + WS_QKN), (const float*)(ws + WS_ROT), args.out};
          GEMM(pg8::EpiIn, X1B, W3, NIN, D, 64, 0, G - 24, bid < G - 24 ? bid : -1, E); }
        { pg8::EpiResid<true> E{args.in[0], args.in[1] - (size_t)TP * D, X1, X1B, rss1, 0.5f};
          GEMM(pg8::EpiResid<true>, ACT, W2, D, FF, 2, 64, 8, bid - (G - 8), E); }
        filler(args, fctl, 3, units_of(64 * 21, G - 24, bid < G - 24 ? bid : -1) + units_of(8, 8, bid - (G - 8)), 64 * 21 + 8, MISC, tid);
    }
    SEAM(3);
    if (IN(4)) {
        { pg8::EpiIn E{rss1, Ub, Qb, Gb, args.in[14], (const float*)(ws + WS_QKN), (const float*)(ws + WS_ROT), args.out};
          GEMM(pg8::EpiIn, X1B, W3, NIN, D, 2, 64, 42, bid, E); }
        int it = 0; unsigned id = grab(fctl + 64 * 20, MISC, it, tid);
        {
            v4u kv[6], vv[6]; AttnU cur = attn_decode(id < 768u ? (int)id : 0);
            if (id < 768u) attn_load(cur, Kb, Vb, tid, kv, vv);
            while (id < 768u) {
                __syncthreads();
                attn_write(lds, tid, kv, vv);
                __syncthreads();
                bf16x8 qf[4]; attn_qload(cur, Qb, tid, qf);
                const unsigned nid = grab(fctl + 64 * 20, MISC, it, tid);
                const AttnU nxt = attn_decode(nid < 768u ? (int)nid : 0);
                if (nid < 768u) attn_load(nxt, Kb, Vb, tid, kv, vv);
                attn_compute(lds, cur, qf, OG, ML, tid);
                cur = nxt; id = nid;
            }
        }
        {   float cw[31];
#pragma unroll
            for (int j = 0; j < 31; ++j) cw[j] = *(const float*)((const char*)args.in[17] + j * 2048 + (unsigned)tid * 4u);
            while (id < 768u + 512u) { conv_unit<32, false>(args, lds, Ub, CONVF, cw, (int)id - 768, tid); id = grab(fctl + 64 * 20, MISC, it, tid); }
        }
    }
    SEAM(4);
    if (IN(5)) {
        combine_groups(OG, ML, BATT, 0, TP, (size_t)bid * 512 + tid, (size_t)G * 512);
        __syncthreads();
        { pg8::EpiGateA E{Gb, TMP}; GEMM(pg8::EpiGateA, CONVF, W4A, D, 512, 64, 0, G, bid, E); }
        int it = 0; int tq = tid; asm volatile("" : "+v"(tq));
        for (;;) { const unsigned id = grab(fctl + 64 * 21, MISC, it, tq); if (id >= 512u) break;
            if (id < 384u) attn_sample_g12(args, lds, Qb, Kb, Vb, OG, ML, (int)(id / 3u), (int)(id % 3u), tq);
            else { float cw[31];
#pragma unroll
                for (int j = 0; j < 31; ++j) cw[j] = *(const float*)((const char*)args.in[17] + j * 2048 + (unsigned)tq * 4u);
                conv_unit<4, true>(args, lds, Ub, CONVF, cw, (int)id - 384, tq); } }
    }
    SEAM(5);
    if (IN(6)) {
        { pg8::EpiGateB E{Gb, TMP, MIX}; GEMM(pg8::EpiGateB, BATT, W4B, D, 256, 64, 0, G, bid, E); }
        combine_groups(OG, ML, BATT, TP, T, (size_t)bid * 512 + tid, (size_t)G * 512);
        __syncthreads();
        { pg8::EpiGateA E{Gb, TMP}; GEMM(pg8::EpiGateA, CONVF, W4A, D, 512, 2, 64, 8, bid, E); }
        filler(args, fctl, 6, 1u + units_of(8, 8, bid), 256 + 8, MISC, tid);
    }
    SEAM(6);
    if (IN(7)) {
        { pg8::EpiResid<true> E{X1, X1, X2, X2B, rss2, 1.0f}; GEMM(pg8::EpiResid<true>, MIX, W5, D, D, 64, 0, G, bid, E); }
        { pg8::EpiGateB E{Gb, TMP, MIX}; GEMM(pg8::EpiGateB, BATT, W4B, D, 256, 2, 64, 8, bid, E); }
        filler(args, fctl, 7, 1u + units_of(8, 8, bid), 256 + 8, MISC, tid);
    }
    SEAM(7);
    if (IN(8)) {
        { pg8::EpiSwiGLU E{rss2, ACT}; GEMM(pg8::EpiSwiGLU, X2B, W6, 2 * FF, D, 64, 0, G - 20, bid < G - 20 ? bid : -1, E); }
        { pg8::EpiResid<true> E{X1, X1, X2, X2B, rss2, 1.0f}; GEMM(pg8::EpiResid<true>, MIX, W5, D, D, 2, 64, 8, bid - (G - 8), E); }
        if (bid >= G - 20) {
            unsigned* cnt = fctl + 64 * 24;
            if (bid >= G - 8) { __threadfence(); __syncthreads(); if (tid == 0) __hip_atomic_fetch_add(cnt, 1u, __ATOMIC_RELEASE, __HIP_MEMORY_SCOPE_AGENT); }
            if (tid == 0) { unsigned sp = 0; while (__hip_atomic_load(cnt, __ATOMIC_ACQUIRE, __HIP_MEMORY_SCOPE_AGENT) < 8u) { __builtin_amdgcn_s_sleep(8); if (++sp > (1u << 22)) break; } }
            __syncthreads(); __threadfence();
            pg8::EpiSwiGLU E{rss2, ACT}; GEMM(pg8::EpiSwiGLU, X2B, W6, 2 * FF, D, 2, 64, 20, bid - (G - 20), E);
        }
        filler(args, fctl, 8, units_of(64 * 22, G - 20, bid < G - 20 ? bid : -1) + units_of(8, 8, bid - (G - 8)) + units_of(44, 20, bid - (G - 20)), 64 * 22 + 8 + 44, MISC, tid);
    }
    SEAM(8);
    if (IN(9)) {
        pg8::EpiResid<false> E{X2, X2, args.out, nullptr, nullptr, 0.5f};
        GEMM(pg8::EpiResid<false>, ACT, W7, D, FF, 64, 0, G, bid, E);
    }
    SEAM(9);
    if (IN(10)) {
        { pg8::EpiResid<false> E{X2, X2, args.out, nullptr, nullptr, 0.5f}; GEMM(pg8::EpiResid<false>, ACT, W7, D, FF, 2, 64, 8, bid, E); }
        filler(args, fctl, 10, 0u, 0u, MISC, tid);
    }
#undef IN
#undef SEAM
}

extern "C" void kernel_launch(void* const* d_in, const int* in_sizes, int n_in, void* d_out, int out_size, void* d_ws, size_t ws_size, hipStream_t stream) {
    static int grid = 0;
    if (grid == 0) {
        int dev = 0, cus = 0, per_cu = 0;
        if (n_in != 27 || ws_size < WS_END) { fprintf(stderr, "kernel_launch: unexpected n_in %d / ws %zu (need %zu)\n", n_in, ws_size, (size_t)WS_END); grid = -1; return; }
        (void)hipGetDevice(&dev);
        (void)hipDeviceGetAttribute(&cus, hipDeviceAttributeMultiprocessorCount, dev);
        if (hipFuncSetAttribute((const void*)mk_fwd, hipFuncAttributeMaxDynamicSharedMemorySize, LDS_BYTES) != hipSuccess) { fprintf(stderr, "kernel_launch: hipFuncSetAttribute failed\n"); grid = -1; return; }
        if (hipOccupancyMaxActiveBlocksPerMultiprocessor(&per_cu, (const void*)mk_fwd, 512, LDS_BYTES) != hipSuccess || per_cu < 1) { fprintf(stderr, "kernel_launch: occupancy query failed (%d)\n", per_cu); per_cu = 1; }
        (void)hipGetLastError();
        grid = cus;
        fprintf(stderr, "kernel_launch: cus %d per_cu %d grid %d\n", cus, per_cu, grid);
    }
    if (grid < 0) return;
    Args a{};
    for (int i = 0; i < 27; ++i) a.in[i] = (const float*)d_in[i];
    a.out = (float*)d_out; a.ws = (unsigned char*)d_ws;
    if (hipMemsetAsync((char*)d_ws + WS_BAR, 0, WS_BAR_BYTES, stream) != hipSuccess) { fprintf(stderr, "kernel_launch: memset failed\n"); return; }
#if MK_N_LAUNCHES == 1
    a.ph_lo = 0; a.ph_hi = N_PHASES;
    hipLaunchKernelGGL(mk_fwd, dim3(grid), dim3(512), LDS_BYTES, stream, a);
#else
    for (int p = 0; p < N_PHASES; ++p) { a.ph_lo = p; a.ph_hi = p + 1; hipLaunchKernelGGL(mk_fwd, dim3(grid), dim3(512), LDS_BYTES, stream, a); }
#endif
}
```

```cpp
#include <hip/hip_runtime.h>
#include <cstdio>
#include <cstdint>
namespace pg8 {
#define PG8_LAS __attribute__((address_space(3)))
typedef unsigned short bf16_t;
typedef short bf16x8 __attribute__((ext_vector_type(8)));
typedef float f32x4 __attribute__((ext_vector_type(4)));
typedef unsigned u32x4 __attribute__((ext_vector_type(4)));
constexpr int BM = 256, BK = 64, HALF = 128, HTB = HALF * BK * 2  , STAGE_BYTES = 8 * HTB, NXCD = 8, WGM = 8;

__host__ __device__ __forceinline__ int lds_byte(int r, int c) { const int st = (r >> 4) * 2 + (c >> 5), rr = r & 15, cc = c & 31, ob = rr * 64 + cc * 2; return st * 1024 + (ob ^ (((ob >> 9) & 1) << 5)); }
__host__ __device__ __forceinline__ void stage_rc(int b, int& R, int& C) { const int st = b / 1024, sb = b % 1024, swz = sb ^ (((sb >> 9) & 1) << 5); R = (st >> 1) * 16 + swz / 64; C = (st & 1) * 32 + (swz % 64) / 2; }
__host__ __device__ __forceinline__ int perm32(int rho) { const int n = rho >> 4, i = rho & 15; return 8 * (i >> 2) + 4 * n + (i & 3); }

struct Unit { int pm, pn; };
struct Gemm { const bf16_t* A; const bf16_t* Bt; int M, N, K; };

struct StaticOrder {
    int nM, nN, nwg, G, c;
    __host__ __device__ void init(int M, int N, int G_, int c_) { nM = M / BM; nN = N / BM; nwg = nM * nN; G = G_; c = c_; }
    __host__ __device__ bool next(int i, Unit& u) const {
        const long L = (long)i * G + c; if (L >= nwg) return false;
        int wgid = (int)L; { const int q = nwg / NXCD, r = nwg % NXCD, xcd = wgid % NXCD, off = wgid / NXCD; wgid = (xcd < r ? xcd * (q + 1) : r * (q + 1) + (xcd - r) * q) + off; }
        const int nig = WGM * nN, gid = wgid / nig, fm = gid * WGM, gsz = (nM - fm) < WGM ? (nM - fm) : WGM;
        u.pm = fm + ((wgid % nig) % gsz); u.pn = (wgid % nig) / gsz; return true;
    }
    __device__ __forceinline__ void a_ready(const Unit&) const {}
    __device__ __forceinline__ void done(const Unit&) const {}
};

__device__ __forceinline__ unsigned cvt_pk_bf16(float lo, float hi) { unsigned r; asm volatile("v_cvt_pk_bf16_f32 %0, %1, %2" : "=v"(r) : "v"(lo), "v"(hi)); return r; }
typedef float f32x2 __attribute__((ext_vector_type(2)));
typedef unsigned u32x2 __attribute__((ext_vector_type(2)));
struct SubOrder {
    int nM, nN, nwg, G, c, pm_off;
    __host__ __device__ void init(int nM_, int nN_, int pm_off_, int G_, int c_) { nM = nM_; nN = nN_; nwg = (c_ >= 0 && c_ < G_) ? nM * nN : 0; G = G_; c = c_; pm_off = pm_off_; }
    __host__ __device__ bool next(int i, Unit& u) const {
        const long L = (long)i * G + c; if (c < 0 || L >= nwg) return false;
        int wgid = (int)L; { const int q = nwg / NXCD, r = nwg % NXCD, xcd = wgid % NXCD, off = wgid / NXCD; wgid = (xcd < r ? xcd * (q + 1) : r * (q + 1) + (xcd - r) * q) + off; }
        const int nig = WGM * nN, gid = wgid / nig, fm = gid * WGM, gsz = (nM - fm) < WGM ? (nM - fm) : WGM;
        u.pm = pm_off + fm + ((wgid % nig) % gsz); u.pn = (wgid % nig) / gsz; return true;
    }
    __device__ __forceinline__ void a_ready(const Unit&) const {}
    __device__ __forceinline__ void done(const Unit&) const {}
};
constexpr float NEPS = 1e-6f;
__device__ __forceinline__ float sigmoid_f(float x) { return __builtin_amdgcn_rcpf(1.f + __builtin_amdgcn_exp2f(-1.4426950408889634f * x)); }
__device__ __forceinline__ float silu_f(float x) { return x * sigmoid_f(x); }
__device__ __forceinline__ float bf2f(unsigned short h) { return __builtin_bit_cast(float, (unsigned)h << 16); }
__device__ __forceinline__ float bflo(unsigned w) { return __builtin_bit_cast(float, w << 16); }
__device__ __forceinline__ float bfhi(unsigned w) { return __builtin_bit_cast(float, w & 0xffff0000u); }

struct EpiSwiGLU {
    static constexpr bool PERM = false, AFTER_DRAIN = false;
    const float* rss; bf16_t* O;
    __device__ __forceinline__ void operator()(const f32x4 (&acc)[2][2][4][2], const Unit& u, int wr, int wc, int fr, int fq) const {
        const int row0 = u.pm * BM + wr * 64 + fr, col0 = u.pn * 128 + wc * 32 + 8 * fq;
#pragma unroll
        for (int ai = 0; ai < 2; ++ai)
#pragma unroll
            for (int m = 0; m < 4; ++m) {
                const int row = row0 + ai * HALF + m * 16;
                const float r = __builtin_amdgcn_rsqf(rss[row] * (1.f / 1024.f) + NEPS);
                float o[8];
#pragma unroll
                for (int n = 0; n < 2; ++n)
#pragma unroll
                    for (int e = 0; e < 4; ++e) o[4 * n + e] = silu_f(acc[ai][0][m][n][e] * r) * (acc[ai][1][m][n][e] * r);
                u32x4 w; w.x = cvt_pk_bf16(o[0], o[1]); w.y = cvt_pk_bf16(o[2], o[3]); w.z = cvt_pk_bf16(o[4], o[5]); w.w = cvt_pk_bf16(o[6], o[7]);
                *(u32x4*)(O + (size_t)row * 2816 + col0) = w;
            }
    }
};

template <bool NEXT> struct EpiResid {
    static constexpr bool PERM = false, AFTER_DRAIN = false;
    const float* base_p; const float* base_s; float* out; bf16_t* outb; float* rss; float alpha;
    __device__ __forceinline__ void operator()(const f32x4 (&acc)[2][2][4][2], const Unit& u, int wr, int wc, int fr, int fq) const {
        const int row0 = u.pm * BM + wr * 64 + fr, col0 = u.pn * BM + wc * 32 + 8 * fq;
        const float* base = (u.pm < 64) ? base_p : base_s;
#pragma unroll
        for (int ai = 0; ai < 2; ++ai)
#pragma unroll
            for (int m = 0; m < 4; ++m) {
                const int row = row0 + ai * HALF + m * 16; float ss = 0.f;
#pragma unroll
                for (int bj = 0; bj < 2; ++bj) {
                    const size_t off = (size_t)row * 1024 + col0 + bj * HALF;
                    const f32x4 b0 = *(const f32x4*)(base + off), b1 = *(const f32x4*)(base + off + 4);
                    const f32x4 v0 = b0 + acc[ai][bj][m][0] * alpha, v1 = b1 + acc[ai][bj][m][1] * alpha;
                    *(f32x4*)(out + off) = v0; *(f32x4*)(out + off + 4) = v1;
                    if (NEXT) {
                        u32x4 w; w.x = cvt_pk_bf16(v0[0], v0[1]); w.y = cvt_pk_bf16(v0[2], v0[3]); w.z = cvt_pk_bf16(v1[0], v1[1]); w.w = cvt_pk_bf16(v1[2], v1[3]);
                        *(u32x4*)(outb + off) = w;
                        ss += (v0[0] * v0[0] + v0[1] * v0[1]) + (v0[2] * v0[2] + v0[3] * v0[3]) + (v1[0] * v1[0] + v1[1] * v1[1]) + (v1[2] * v1[2] + v1[3] * v1[3]);
                    }
                }
                if (NEXT) { ss += __shfl_xor(ss, 16); ss += __shfl_xor(ss, 32); if (fq == 0) unsafeAtomicAdd(rss + row, ss); }
            }
    }
};

struct EpiGateA {
    static constexpr bool PERM = false, AFTER_DRAIN = false;
    const bf16_t* gates; bf16_t* tmp;
    __device__ __forceinline__ void operator()(const f32x4 (&acc)[2][2][4][2], const Unit& u, int wr, int wc, int fr, int fq) const {
        const int row0 = u.pm * BM + wr * 64 + fr, col0 = u.pn * BM + wc * 32 + 8 * fq;
#pragma unroll
        for (int ai = 0; ai < 2; ++ai)
#pragma unroll
            for (int m = 0; m < 4; ++m) {
                const int row = row0 + ai * HALF + m * 16;
#pragma unroll
                for (int bj = 0; bj < 2; ++bj) {
                    const int c = col0 + bj * HALF;
                    const u32x4 g = *(const u32x4*)(gates + (size_t)row * 2048 + c);
                    f32x4 v0 = acc[ai][bj][m][0], v1 = acc[ai][bj][m][1];
                    v0[0] *= bflo(g.x); v0[1] *= bfhi(g.x); v0[2] *= bflo(g.y); v0[3] *= bfhi(g.y);
                    v1[0] *= bflo(g.z); v1[1] *= bfhi(g.z); v1[2] *= bflo(g.w); v1[3] *= bfhi(g.w);
                    u32x4 w; w.x = cvt_pk_bf16(v0[0], v0[1]); w.y = cvt_pk_bf16(v0[2], v0[3]); w.z = cvt_pk_bf16(v1[0], v1[1]); w.w = cvt_pk_bf16(v1[2], v1[3]);
                    *(u32x4*)(tmp + (size_t)row * 1024 + c) = w;
                }
            }
    }
};
struct EpiGateB {
    static constexpr bool PERM = false, AFTER_DRAIN = false;
    const bf16_t* gates; const bf16_t* tmp; bf16_t* mix;
    __device__ __forceinline__ void operator()(const f32x4 (&acc)[2][2][4][2], const Unit& u, int wr, int wc, int fr, int fq) const {
        const int row0 = u.pm * BM + wr * 64 + fr, col0 = u.pn * BM + wc * 32 + 8 * fq;
#pragma unroll
        for (int ai = 0; ai < 2; ++ai)
#pragma unroll
            for (int m = 0; m < 4; ++m) {
                const int row = row0 + ai * HALF + m * 16;
#pragma unroll
                for (int bj = 0; bj < 2; ++bj) {
                    const int c = col0 + bj * HALF;
                    const u32x4 g = *(const u32x4*)(gates + (size_t)row * 2048 + 1024 + c);
                    const u32x4 tw = *(const u32x4*)(tmp + (size_t)row * 1024 + c); const f32x4 t0 = (f32x4){bflo(tw.x), bfhi(tw.x), bflo(tw.y), bfhi(tw.y)}, t1 = (f32x4){bflo(tw.z), bfhi(tw.z), bflo(tw.w), bfhi(tw.w)};
                    f32x4 v0 = acc[ai][bj][m][0], v1 = acc[ai][bj][m][1];
                    v0[0] = t0[0] + v0[0] * bflo(g.x); v0[1] = t0[1] + v0[1] * bfhi(g.x); v0[2] = t0[2] + v0[2] * bflo(g.y); v0[3] = t0[3] + v0[3] * bfhi(g.y);
                    v1[0] = t1[0] + v1[0] * bflo(g.z); v1[1] = t1[1] + v1[1] * bfhi(g.z); v1[2] = t1[2] + v1[2] * bflo(g.w); v1[3] = t1[3] + v1[3] * bfhi(g.w);
                    u32x4 w; w.x = cvt_pk_bf16(v0[0], v0[1]); w.y = cvt_pk_bf16(v0[2], v0[3]); w.z = cvt_pk_bf16(v1[0], v1[1]); w.w = cvt_pk_bf16(v1[2], v1[3]);
                    *(u32x4*)(mix + (size_t)row * 1024 + c) = w;
                }
            }
    }
};

struct EpiIn {
    static constexpr bool PERM = false, AFTER_DRAIN = false;
    const float* rss; bf16_t *U, *Q, *G; const float *b_gate, *qk_norm, *rot; float* out;
    static constexpr size_t O_KP0 = 17301504;
    __device__ __forceinline__ void operator()(const f32x4 (&acc)[2][2][4][2], const Unit& u, int wr, int wc, int fr, int fq) const {
        const int row0 = u.pm * BM + wr * 64 + fr; const int pn = u.pn; const bool samp = u.pm >= 64;
        if (pn < 4) {
            const int col0 = pn * 128 + wc * 32 + 8 * fq;
#pragma unroll
            for (int ai = 0; ai < 2; ++ai)
#pragma unroll
                for (int m = 0; m < 4; ++m) {
                    const int row = row0 + ai * HALF + m * 16; const float r = __builtin_amdgcn_rsqf(rss[row] * (1.f / 1024.f) + NEPS);
                    float o[8];
#pragma unroll
                    for (int n = 0; n < 2; ++n)
#pragma unroll
                        for (int e = 0; e < 4; ++e) o[4 * n + e] = (acc[ai][0][m][n][e] * r) * sigmoid_f(acc[ai][1][m][n][e] * r);
                    u32x4 w; w.x = cvt_pk_bf16(o[0], o[1]); w.y = cvt_pk_bf16(o[2], o[3]); w.z = cvt_pk_bf16(o[4], o[5]); w.w = cvt_pk_bf16(o[6], o[7]);
                    *(u32x4*)(U + (size_t)row * 512 + col0) = w;
                    float* cp = nullptr;
                    if (!samp) { const int t = row & 4095, b = row >> 12; if (t >= 4066) cp = out + 22806528 + ((size_t)(b * 30 + (t - 4066))) * 512 + col0; }
                    else { const int sr = row - 16384; cp = out + 199028736 + ((size_t)((sr >> 2) * 30 + 26 + (sr & 3))) * 512 + col0; }
                    if (cp) { *(f32x4*)cp = (f32x4){o[0], o[1], o[2], o[3]}; *(f32x4*)(cp + 4) = (f32x4){o[4], o[5], o[6], o[7]}; }
                }
        } else if (pn < 13) {
            const int kind = (pn - 4) / 3, g = (pn - 4) % 3;
            const int W = 128 << (2 * g);
            const int hcol = (4 * g + wc) * 64;
            int dim0[2][2];
#pragma unroll
            for (int n = 0; n < 2; ++n) { dim0[0][n] = (kind < 2 && fq < 2) ? 4 * fq + 8 * n : 8 * fq + 4 * n; dim0[1][n] = 32 + 8 * fq + 4 * n; }
            f32x4 gn[2][2];
            if (kind < 2) { const float* nw = qk_norm + kind * 768 + hcol;
#pragma unroll
                for (int bj = 0; bj < 2; ++bj)
#pragma unroll
                    for (int n = 0; n < 2; ++n) gn[bj][n] = *(const f32x4*)(nw + dim0[bj][n]); }
            bf16_t* dstb = Q + (size_t)kind * ((size_t)16896 * 768);
            size_t okp = 17301504, oks = 22867968;
            for (int gg = 0; gg < g; ++gg) { okp += (size_t)2 * 4 * (128 << (2 * gg)) * 256; oks += (size_t)2 * 128 * (128 << (2 * gg)) * 256; }
            if (kind == 2) { okp += (size_t)4 * W * 256; oks += (size_t)128 * W * 256; }
#pragma unroll
            for (int ai = 0; ai < 2; ++ai)
#pragma unroll
                for (int m = 0; m < 4; ++m) {
                    const int row = row0 + ai * HALF + m * 16; const float r = __builtin_amdgcn_rsqf(rss[row] * (1.f / 1024.f) + NEPS);
                    f32x4 v[2][2];
#pragma unroll
                    for (int bj = 0; bj < 2; ++bj)
#pragma unroll
                        for (int n = 0; n < 2; ++n) v[bj][n] = acc[ai][bj][m][n] * r;
                    int posidx, b, tt; float* cdst = nullptr;
                    if (!samp) { tt = row & 4095; b = row >> 12; posidx = tt; if (kind >= 1 && tt >= 4096 - W) cdst = out + okp + ((size_t)(b * W + (tt - (4096 - W))) * 4 + wc) * 64; }
                    else { const int sr = row - 16384; b = sr >> 2; tt = sr & 3; posidx = 4096 + tt; if (kind >= 1) cdst = out + oks + ((size_t)(b * W + (W - 4 + tt)) * 4 + wc) * 64; }
                    if (kind < 2) {
                        float ss = 0.f;
#pragma unroll
                        for (int bj = 0; bj < 2; ++bj)
#pragma unroll
                            for (int n = 0; n < 2; ++n) ss += (v[bj][n][0] * v[bj][n][0] + v[bj][n][1] * v[bj][n][1]) + (v[bj][n][2] * v[bj][n][2] + v[bj][n][3] * v[bj][n][3]);
                        ss += __shfl_xor(ss, 16); ss += __shfl_xor(ss, 32);
                        const float rn = __builtin_amdgcn_rsqf(ss * (1.f / 64.f) + NEPS);
#pragma unroll
                        for (int bj = 0; bj < 2; ++bj)
#pragma unroll
                            for (int n = 0; n < 2; ++n) v[bj][n] = v[bj][n] * rn * gn[bj][n];
                        if (fq < 2) {
                            const f32x4 cs = *(const f32x4*)(rot + (size_t)posidx * 16 + 4 * fq), sn = *(const f32x4*)(rot + (size_t)posidx * 16 + 8 + 4 * fq);
                            const f32x4 x1 = v[0][0], x2 = v[0][1];
                            v[0][0] = x1 * cs - x2 * sn; v[0][1] = x2 * cs + x1 * sn;
                        }
                        if (kind == 0) {
#pragma unroll
                            for (int bj = 0; bj < 2; ++bj)
#pragma unroll
                                for (int n = 0; n < 2; ++n) v[bj][n] = v[bj][n] * (0.125f * 1.4426950408889634f);
                        }
                    }
#pragma unroll
                    for (int bj = 0; bj < 2; ++bj)
#pragma unroll
                        for (int n = 0; n < 2; ++n) {
                            u32x2 w; w.x = cvt_pk_bf16(v[bj][n][0], v[bj][n][1]); w.y = cvt_pk_bf16(v[bj][n][2], v[bj][n][3]);
                            *(u32x2*)(dstb + (size_t)row * 768 + hcol + dim0[bj][n]) = w;
                            if (cdst) *(f32x4*)(cdst + dim0[bj][n]) = v[bj][n];
                        }
                }
        } else {
            const int col0 = (pn - 13) * 256 + wc * 32 + 8 * fq;
            f32x4 bv[2][2];
#pragma unroll
            for (int bj = 0; bj < 2; ++bj)
#pragma unroll
                for (int n = 0; n < 2; ++n) bv[bj][n] = *(const f32x4*)(b_gate + col0 + bj * HALF + 4 * n);
#pragma unroll
            for (int ai = 0; ai < 2; ++ai)
#pragma unroll
                for (int m = 0; m < 4; ++m) {
                    const int row = row0 + ai * HALF + m * 16; const float r = __builtin_amdgcn_rsqf(rss[row] * (1.f / 1024.f) + NEPS);
#pragma unroll
                    for (int bj = 0; bj < 2; ++bj) {
                        float o[8];
#pragma unroll
                        for (int n = 0; n < 2; ++n)
#pragma unroll
                            for (int e = 0; e < 4; ++e) o[4 * n + e] = sigmoid_f(acc[ai][bj][m][n][e] * r + bv[bj][n][e]);
                        u32x4 w; w.x = cvt_pk_bf16(o[0], o[1]); w.y = cvt_pk_bf16(o[2], o[3]); w.z = cvt_pk_bf16(o[4], o[5]); w.w = cvt_pk_bf16(o[6], o[7]);
                        *(u32x4*)(G + (size_t)row * 2048 + col0 + bj * HALF) = w;
                    }
                }
        }
    }
};
template <class Epi, class Sched, bool ALIGN_EPI = false, bool SP2 = false>
__device__ __forceinline__ void gemm_phase(PG8_LAS unsigned char* lds, const Gemm g, const Sched& S, const Epi& E) {
    int tid_o = threadIdx.x; asm volatile("" : "+v"(tid_o));
    const int tid = tid_o, wid = __builtin_amdgcn_readfirstlane(tid >> 6), lane = tid & 63, wr = wid >> 2, wc = wid & 3, fr = lane & 15, fq = lane >> 4;
    const int K = g.K, nt = K / BK;
    unsigned voffA[2], voffB[2];
#pragma unroll
    for (int i = 0; i < 2; ++i) { int R, C; stage_rc(tid * 16 + i * 8192, R, C); const int Rb = Epi::PERM ? ((R & ~31) + perm32(R & 31)) : R;
        voffA[i] = (unsigned)(R * K + C) * 2u; voffB[i] = (unsigned)(Rb * K + C) * 2u; }
    const size_t kstep = (size_t)(BK * 2);
    const size_t hstep = (size_t)HALF * K * 2;
    const size_t tstep = 2 * hstep;
    const unsigned ldsw = (unsigned)wid * 1024u;
    const int aoff = lds_byte(wr * 64 + fr, fq * 8), boff = lds_byte(wc * 32 + fr, fq * 8);
#define PG8_SA(b, h) (((b) * 2 + (h)) * HTB)
#define PG8_SB(b, h) ((4 + (b) * 2 + (h)) * HTB)
#define PG8_STAGE(bufoff, gbase, voff) do { _Pragma("unroll") for (int _i = 0; _i < 2; ++_i) \
        __builtin_amdgcn_global_load_lds((const unsigned*)((const char*)(gbase) + (voff)[_i]), (PG8_LAS unsigned*)(lds + (bufoff) + ldsw + _i * 8192), 16, 0, 0); } while (0)
#define PG8_LDA(dst, b, h) do { _Pragma("unroll") for (int m = 0; m < 4; ++m) _Pragma("unroll") for (int k = 0; k < 2; ++k) dst[m][k] = *(const PG8_LAS bf16x8*)(lds + PG8_SA(b, h) + aoff + m * 2048 + k * 1024); } while (0)
#define PG8_LDB(dst, b, h) do { _Pragma("unroll") for (int n = 0; n < 2; ++n) _Pragma("unroll") for (int k = 0; k < 2; ++k) dst[n][k] = *(const PG8_LAS bf16x8*)(lds + PG8_SB(b, h) + boff + n * 2048 + k * 1024); } while (0)
#define PG8_MMA(ai, bj, At, Bt) do { __builtin_amdgcn_s_setprio(1); _Pragma("unroll") for (int m = 0; m < 4; ++m) _Pragma("unroll") for (int n = 0; n < 2; ++n) _Pragma("unroll") for (int k = 0; k < 2; ++k) \
        acc[ai][bj][m][n] = __builtin_amdgcn_mfma_f32_16x16x32_bf16(Bt[n][k], At[m][k], acc[ai][bj][m][n], 0, 0, 0); __builtin_amdgcn_s_setprio(0); } while (0)
#define PG8_WAIT_V(n) asm volatile("s_waitcnt vmcnt(" #n ")" ::: "memory")
#define PG8_WAIT_L(n) asm volatile("s_waitcnt lgkmcnt(" #n ")" ::: "memory")
#define PG8_BAR __builtin_amdgcn_s_barrier()
#define PG8_SCHED __builtin_amdgcn_sched_barrier(0)
    Unit cur, nxt; int ui = 0;
    if (!S.next(0, cur)) return;
    f32x4 acc[2][2][4][2];
#pragma unroll
    for (int a = 0; a < 2; ++a)
#pragma unroll
        for (int b = 0; b < 2; ++b)
#pragma unroll
            for (int m = 0; m < 4; ++m)
#pragma unroll
                for (int n = 0; n < 2; ++n) acc[a][b][m][n] = (f32x4){0.f, 0.f, 0.f, 0.f};
    bf16x8 At[4][2], B0[2][2], B1[2][2];
    const char* cA = (const char*)g.A + (size_t)cur.pm * tstep; const char* cB = (const char*)g.Bt + (size_t)cur.pn * tstep;
    S.a_ready(cur);
    if constexpr (SP2) {
        PG8_STAGE(PG8_SB(0, 0), cB, voffB); PG8_STAGE(PG8_SB(0, 1), cB + hstep, voffB); PG8_STAGE(PG8_SA(0, 0), cA, voffA); PG8_STAGE(PG8_SA(0, 1), cA + hstep, voffA);
        if (wr == 1) PG8_BAR;
        PG8_WAIT_V(2); PG8_BAR;
        PG8_STAGE(PG8_SB(1, 0), cB + kstep, voffB); PG8_STAGE(PG8_SA(1, 0), cA + kstep, voffA); PG8_STAGE(PG8_SB(1, 1), cB + hstep + kstep, voffB);
        PG8_WAIT_V(6); PG8_BAR;
    } else {
        PG8_STAGE(PG8_SB(0, 0), cB, voffB); PG8_STAGE(PG8_SA(0, 0), cA, voffA); PG8_STAGE(PG8_SB(0, 1), cB + hstep, voffB); PG8_STAGE(PG8_SA(0, 1), cA + hstep, voffA);
        if (wr == 1) PG8_BAR;
        PG8_WAIT_V(4); PG8_BAR;
        PG8_STAGE(PG8_SB(1, 0), cB + kstep, voffB); PG8_STAGE(PG8_SA(1, 0), cA + kstep, voffA); PG8_STAGE(PG8_SB(1, 1), cB + hstep + kstep, voffB);
        PG8_WAIT_V(6); PG8_BAR;
    }
    for (;;) {
        const bool has_next = S.next(ui + 1, nxt);
        const char* nA = has_next ? (const char*)g.A + (size_t)nxt.pm * tstep : cA; const char* nB = has_next ? (const char*)g.Bt + (size_t)nxt.pn * tstep : cB;
        for (int t = 0; t < nt; t += 2) {
            const bool last = (t == nt - 2);
            const char* a1 = cA + (size_t)(t + 1) * kstep;
            const char* a2 = last ? nA : cA + (size_t)(t + 2) * kstep; const char* b2 = last ? nB : cB + (size_t)(t + 2) * kstep;
            const char* a3 = a2 + kstep; const char* b3 = b2 + kstep;
            if (last && has_next) S.a_ready(nxt);
            if constexpr (SP2) {
            PG8_LDB(B0, 0, 0); PG8_LDB(B1, 0, 1); PG8_SCHED; PG8_LDA(At, 0, 0); PG8_STAGE(PG8_SA(1, 1), a1 + hstep, voffA);
            PG8_WAIT_V(8); PG8_WAIT_L(0); PG8_BAR; PG8_MMA(0, 0, At, B0); PG8_MMA(0, 1, At, B1); PG8_BAR; PG8_SCHED;
            PG8_LDA(At, 0, 1); PG8_STAGE(PG8_SB(0, 0), b2, voffB); PG8_STAGE(PG8_SB(0, 1), b2 + hstep, voffB); PG8_STAGE(PG8_SA(0, 0), a2, voffA);
            PG8_WAIT_V(8); PG8_WAIT_L(0); PG8_BAR; PG8_MMA(1, 0, At, B0); PG8_MMA(1, 1, At, B1); PG8_BAR; PG8_SCHED;
            PG8_LDB(B0, 1, 0); PG8_LDB(B1, 1, 1); PG8_SCHED; PG8_LDA(At, 1, 0); PG8_STAGE(PG8_SA(0, 1), a2 + hstep, voffA);
            PG8_WAIT_V(8); PG8_WAIT_L(0); PG8_BAR; PG8_MMA(0, 0, At, B0); PG8_MMA(0, 1, At, B1); PG8_BAR; PG8_SCHED;
            PG8_LDA(At, 1, 1); PG8_STAGE(PG8_SB(1, 0), b3, voffB); PG8_STAGE(PG8_SB(1, 1), b3 + hstep, voffB); PG8_STAGE(PG8_SA(1, 0), a3, voffA);
            PG8_WAIT_V(8); PG8_WAIT_L(0); PG8_BAR; PG8_MMA(1, 0, At, B0); PG8_MMA(1, 1, At, B1); PG8_BAR; PG8_SCHED;
            } else {
            PG8_LDB(B0, 0, 0); PG8_SCHED; PG8_LDA(At, 0, 0); PG8_STAGE(PG8_SA(1, 1), a1 + hstep, voffA);
            PG8_WAIT_L(8); PG8_BAR; PG8_WAIT_L(0); PG8_MMA(0, 0, At, B0); PG8_BAR; PG8_SCHED;
            PG8_LDB(B1, 0, 1); PG8_STAGE(PG8_SB(0, 0), b2, voffB);
            PG8_BAR; PG8_WAIT_L(0); PG8_MMA(0, 1, At, B1); PG8_BAR;
            PG8_LDA(At, 0, 1); PG8_STAGE(PG8_SA(0, 0), a2, voffA);
            PG8_BAR; PG8_WAIT_L(0); PG8_MMA(1, 0, At, B0); PG8_BAR; PG8_SCHED;
            PG8_STAGE(PG8_SB(0, 1), b2 + hstep, voffB);
            PG8_WAIT_V(6); PG8_BAR; PG8_MMA(1, 1, At, B1); PG8_BAR;
            PG8_LDB(B0, 1, 0); PG8_SCHED; PG8_LDA(At, 1, 0); PG8_STAGE(PG8_SA(0, 1), a2 + hstep, voffA);
            PG8_WAIT_L(8); PG8_BAR; PG8_WAIT_L(0); PG8_MMA(0, 0, At, B0); PG8_BAR; PG8_SCHED;
            PG8_LDB(B1, 1, 1); PG8_STAGE(PG8_SB(1, 0), b3, voffB);
            PG8_BAR; PG8_WAIT_L(0); PG8_MMA(0, 1, At, B1); PG8_BAR;
            PG8_LDA(At, 1, 1); PG8_STAGE(PG8_SA(1, 0), a3, voffA);
            PG8_BAR; PG8_WAIT_L(0); PG8_MMA(1, 0, At, B0); PG8_BAR; PG8_SCHED;
            PG8_STAGE(PG8_SB(1, 1), b3 + hstep, voffB);
            PG8_WAIT_V(6); PG8_BAR; PG8_MMA(1, 1, At, B1); PG8_BAR;
            }
        }
        if constexpr (ALIGN_EPI) { if (wr == 0) PG8_BAR; }
        if constexpr (!Epi::AFTER_DRAIN) { E(acc, cur, wr, wc, fr, fq); S.done(cur); }
        if (!has_next) break;
#pragma unroll
        for (int a = 0; a < 2; ++a)
#pragma unroll
            for (int b = 0; b < 2; ++b)
#pragma unroll
                for (int m = 0; m < 4; ++m)
#pragma unroll
                    for (int n = 0; n < 2; ++n) acc[a][b][m][n] = (f32x4){0.f, 0.f, 0.f, 0.f};
        cur = nxt; cA = nA; cB = nB; ++ui;
        if constexpr (ALIGN_EPI) { if (wr == 1) PG8_BAR; }
    }
    PG8_WAIT_V(0);
    if constexpr (!ALIGN_EPI) { if (wr == 0) PG8_BAR; }
    PG8_BAR;
    if constexpr (Epi::AFTER_DRAIN) { E.fused(acc, cur, wr, wc, fr, fq, lds, wid, lane); S.done(cur); }
#undef PG8_SA
#undef PG8_SB
#undef PG8_STAGE
#undef PG8_LDA
#undef PG8_LDB
#undef PG8_MMA
#undef PG8_WAIT_V
#undef PG8_WAIT_L
#undef PG8_BAR
#undef PG8_SCHED
}
}

#ifndef MK_N_LAUNCHES
#define MK_N_LAUNCHES 1
#endif
constexpr int N_PHASES = 10;
constexpr int TP = 16384, TS = 512, T = TP + TS, D = 1024, FF = 2816, NIN = 5376;
#define GAS __attribute__((address_space(1)))
#define LAS __attribute__((address_space(3)))
typedef unsigned short bf16;
typedef float f32x4 __attribute__((ext_vector_type(4)));
typedef float f32x16 __attribute__((ext_vector_type(16)));
typedef short bf16x8 __attribute__((ext_vector_type(8)));
typedef unsigned v4u __attribute__((ext_vector_type(4)));
typedef unsigned v2u __attribute__((ext_vector_type(2)));

constexpr size_t al256(size_t x) { return (x + 255) & ~(size_t)255; }
constexpr size_t WS_BAR = 0, WS_CTL = 16384, WS_BAR_BYTES = 32768;
constexpr size_t WS_RSS0 = WS_BAR_BYTES, WS_RSS1 = WS_RSS0 + al256((size_t)T * 4), WS_RSS2 = WS_RSS1 + al256((size_t)T * 4);
constexpr size_t WS_ROT = WS_RSS2 + al256((size_t)T * 4);
constexpr size_t WS_QKN = WS_ROT + al256((size_t)4100 * 16 * 4);
constexpr size_t WS_W1 = WS_QKN + al256((size_t)1536 * 4);
constexpr size_t WS_W2 = WS_W1 + (size_t)2 * FF * D * 2;
constexpr size_t WS_W3 = WS_W2 + (size_t)D * FF * 2;
constexpr size_t WS_W4A = WS_W3 + (size_t)NIN * D * 2;
constexpr size_t WS_W4B = WS_W4A + (size_t)D * 512 * 2;
constexpr size_t WS_W5 = WS_W4B + (size_t)D * 256 * 2;
constexpr size_t WS_W6 = WS_W5 + (size_t)D * D * 2;
constexpr size_t WS_W7 = WS_W6 + (size_t)2 * FF * D * 2;
constexpr size_t WS_XB = WS_W7 + (size_t)D * FF * 2;
constexpr size_t WS_ACT = WS_XB + (size_t)T * D * 2;
constexpr size_t WS_X1 = WS_ACT + (size_t)T * FF * 2;
constexpr size_t WS_X1B = WS_X1 + (size_t)T * D * 4;
constexpr size_t WS_U = WS_X1B + (size_t)T * D * 2;
constexpr size_t WS_Q = WS_U + (size_t)T * 512 * 2;
constexpr size_t WS_K = WS_Q + (size_t)T * 768 * 2;
constexpr size_t WS_V = WS_K + (size_t)T * 768 * 2;
constexpr size_t WS_G = WS_V + (size_t)T * 768 * 2;
constexpr size_t WS_CONVF = WS_G + (size_t)T * 2048 * 2;
constexpr size_t WS_OG = WS_CONVF + (size_t)T * 512 * 2;
constexpr size_t WS_ML = WS_OG + (size_t)3 * T * 256 * 2;
constexpr size_t WS_BATT = WS_ML + (size_t)3 * T * 8 * 4;
constexpr size_t WS_TMP = WS_BATT + (size_t)T * 256 * 2;
constexpr size_t WS_MIX = WS_TMP + (size_t)T * D * 4;
constexpr size_t WS_X2 = WS_MIX + (size_t)T * D * 2;
constexpr size_t WS_X2B = WS_X2 + (size_t)T * D * 4;
constexpr size_t WS_END = WS_X2B + (size_t)T * D * 2;

constexpr size_t O_CP = 22806528, O_KS0 = 22867968, O_CS = 199028736;

constexpr int LDS_BYTES = 131072 + 1024;

__device__ __forceinline__ unsigned f2bf(float f) { unsigned u = __builtin_bit_cast(unsigned, f); return (u + 0x7fffu + ((u >> 16) & 1u)) >> 16; }
__device__ __forceinline__ unsigned pk2(float lo, float hi) { return f2bf(lo) | (f2bf(hi) << 16); }
__device__ __forceinline__ float bf2f_g(unsigned short h) { return __builtin_bit_cast(float, (unsigned)h << 16); }
__device__ __forceinline__ float bfl(unsigned w) { return __builtin_bit_cast(float, w << 16); }
__device__ __forceinline__ float bfh(unsigned w) { return __builtin_bit_cast(float, w & 0xffff0000u); }
__device__ __forceinline__ float wave_sum(float v) {
#pragma unroll
    for (int o = 1; o < 64; o <<= 1) v += __shfl_xor(v, o);
    return v;
}

struct Args { const float* in[27]; float* out; unsigned char* ws; int ph_lo, ph_hi; };

__device__ __forceinline__ int perm32(int rho) { const int n = rho >> 4, i = rho & 15; return 8 * (i >> 2) + 4 * n + (i & 3); }
template <int MAP> __device__ __forceinline__ int src_col(int nd) {
    if (MAP == 0) return (nd & ~31) + perm32(nd & 31);
    const int pn = nd >> 8, w = nd & 255, bj = w >> 7, rem = w & 127, wc = rem >> 5, slot = rem & 31;
    if (MAP == 1) return bj * FF + pn * 128 + wc * 32 + perm32(slot);
    if (pn < 4) return bj * 512 + pn * 128 + wc * 32 + perm32(slot);
    if (pn < 13) {
        int dim;
        if (pn < 10 && bj == 0) { const int fq = (slot & 15) >> 2, n = slot >> 4, e = slot & 3; dim = fq < 2 ? 4 * fq + 8 * n + e : 8 * fq + 4 * n + e; }
        else dim = 32 * bj + perm32(slot);
        return 1024 + (pn - 4) * 256 + wc * 64 + dim;
    }
    return 3328 + (pn - 13) * 256 + bj * 128 + wc * 32 + perm32(slot);
}
template <int MAP> __device__ __forceinline__ void p0_transpose_item(const float* W, int K, int Ns, int Nd, bf16* WT, const float* gain, LAS float* scr, int item, int lane) {
    const int nblk = Nd / 32, kb = item / nblk, nb = item % nblk, k0 = 64 * kb, n0 = 32 * nb;
    const int sc = src_col<MAP>(n0 + (lane & 31));
    float tv[32];
#pragma unroll
    for (int i = 0; i < 32; ++i) { const int kk = 2 * i + (lane >> 5); tv[i] = __builtin_nontemporal_load(W + (size_t)(k0 + kk) * Ns + sc); }
    if (gain) {
#pragma unroll
        for (int i = 0; i < 32; ++i) tv[i] *= gain[k0 + 2 * i + (lane >> 5)]; }
#pragma unroll
    for (int i = 0; i < 32; ++i) scr[(2 * i + (lane >> 5)) * 33 + (lane & 31)] = tv[i];
    asm volatile("s_waitcnt lgkmcnt(0)" ::: "memory");
    const int c = lane & 7;
#pragma unroll
    for (int j = 0; j < 4; ++j) { const int n = (lane >> 3) + 8 * j; const LAS float* s = scr + (8 * c) * 33 + n;
        v4u o; o.x = pk2(s[0 * 33], s[1 * 33]); o.y = pk2(s[2 * 33], s[3 * 33]); o.z = pk2(s[4 * 33], s[5 * 33]); o.w = pk2(s[6 * 33], s[7 * 33]);
        *(v4u*)(WT + (size_t)(n0 + n) * K + k0 + 8 * c) = o; }
    asm volatile("s_waitcnt lgkmcnt(0)" ::: "memory");
}
constexpr int N_CHUNKS = 5376 + 128;
struct ChunkD { const f32x4* s4; f32x4* d4; int n4; };
__device__ __forceinline__ ChunkD chunk_desc(const Args& a, int id) {
    const float* src; float* dst; int nrows;
    if (id < 5376) {
        int g, r;
        if (id < 256) { g = 0; r = id; } else if (id < 1280) { g = 1; r = id - 256; } else { g = 2; r = id - 1280; }
        const int W = 128 << (2 * g), cpb = 1 << (2 * g);
        const int kv = r / (128 * cpb), r2 = r % (128 * cpb), b = r2 / cpb, ch = r2 % cpb, row0 = ch * 128;
        nrows = (W - 4 - row0) < 128 ? (W - 4 - row0) : 128;
        size_t oks = O_KS0; for (int gg = 0; gg < g; ++gg) oks += (size_t)2 * 128 * (128 << (2 * gg)) * 256;
        oks += (size_t)kv * 128 * W * 256;
        src = a.in[2 + 2 * g + kv] + ((size_t)b * W + 4 + row0) * 256; dst = a.out + oks + ((size_t)b * W + row0) * 256;
    } else { const int b = id - 5376; src = a.in[8] + ((size_t)b * 30 + 4) * 512; dst = a.out + O_CS + (size_t)b * 30 * 512; nrows = 52; }
    ChunkD d; d.s4 = (const f32x4*)src; d.d4 = (f32x4*)dst; d.n4 = nrows * 64; return d;
}
__device__ __forceinline__ void copy_chunk(const Args& a, int id, int tid) {
    const ChunkD c0 = chunk_desc(a, id);
    f32x4 v0[16];
#pragma unroll
    for (int k = 0; k < 16; ++k) { const int i = tid + 512 * k; if (i < c0.n4) v0[k] = __builtin_nontemporal_load(c0.s4 + i); }
#pragma unroll
    for (int k = 0; k < 16; ++k) { const int i = tid + 512 * k; if (i < c0.n4) __builtin_nontemporal_store(v0[k], c0.d4 + i); }
}
__device__ __forceinline__ void filler(const Args& a, unsigned* ctl, int phase, unsigned my_units, unsigned total_units, volatile LAS unsigned* misc, int tid) {
    unsigned* done = ctl + 64 * (1 + phase);
    if (tid == 0) { if (total_units) __hip_atomic_fetch_add(done, my_units, __ATOMIC_RELAXED, __HIP_MEMORY_SCOPE_AGENT);
        unsigned id = N_CHUNKS;
        if (!total_units || __hip_atomic_load(done, __ATOMIC_RELAXED, __HIP_MEMORY_SCOPE_AGENT) < total_units) id = __hip_atomic_fetch_add(ctl, 1u, __ATOMIC_RELAXED, __HIP_MEMORY_SCOPE_AGENT);
        misc[16] = id; }
    __syncthreads();
    unsigned id = (unsigned)__builtin_amdgcn_readfirstlane((int)misc[16]);
    for (int it = 1; id < (unsigned)N_CHUNKS; ++it) {
        unsigned nxt = N_CHUNKS;
        if (tid == 0) { if (!total_units || __hip_atomic_load(done, __ATOMIC_RELAXED, __HIP_MEMORY_SCOPE_AGENT) < total_units) nxt = __hip_atomic_fetch_add(ctl, 1u, __ATOMIC_RELAXED, __HIP_MEMORY_SCOPE_AGENT); }
        copy_chunk(a, (int)id, tid);
        if (tid == 0) misc[16 + (it & 1)] = nxt;
        __syncthreads();
        id = (unsigned)__builtin_amdgcn_readfirstlane((int)misc[16 + (it & 1)]);
    }
}
__device__ __forceinline__ unsigned grab(unsigned* ctr, volatile LAS unsigned* misc, int& it, int tid) {
    if (tid == 0) misc[20 + (it & 1)] = __hip_atomic_fetch_add(ctr, 1u, __ATOMIC_RELAXED, __HIP_MEMORY_SCOPE_AGENT);
    __syncthreads();
    const unsigned v = (unsigned)__builtin_amdgcn_readfirstlane((int)misc[20 + (it & 1)]); ++it; return v;
}
__device__ __forceinline__ unsigned units_of(int nwg, int G, int c) { return (c >= 0 && c < G && c < nwg) ? (unsigned)((nwg - c + G - 1) / G) : 0u; }

__device__ __forceinline__ void p0_prologue(const Args& a, LAS unsigned char* lds, int G, int bid, int tid) {
    const int wave = tid >> 6, lane = tid & 63;
    LAS float* scr = (LAS float*)(lds + wave * 16384);
    const int gw = bid * 8 + wave, NGW = G * 8;
    unsigned char* ws = a.ws;
    constexpr int I_IN = (D / 64) * (2 * FF / 32), I_OUT = (FF / 64) * (D / 32), I_3 = (D / 64) * (NIN / 32), I_4A = (512 / 64) * (D / 32), I_4B = (256 / 64) * (D / 32), I_5 = (D / 64) * (D / 32);
    constexpr int NITEMS = 2 * I_IN + 2 * I_OUT + I_3 + I_4A + I_4B + I_5;
    for (int it = gw; it < NITEMS; it += NGW) {
        int r = it;
        if (r < I_IN) { p0_transpose_item<1>(a.in[10], D, 2 * FF, 2 * FF, (bf16*)(ws + WS_W1), a.in[9], scr, r, lane); continue; } r -= I_IN;
        if (r < I_IN) { p0_transpose_item<1>(a.in[25], D, 2 * FF, 2 * FF, (bf16*)(ws + WS_W6), a.in[24], scr, r, lane); continue; } r -= I_IN;
        if (r < I_OUT) { p0_transpose_item<0>(a.in[11], FF, D, D, (bf16*)(ws + WS_W2), nullptr, scr, r, lane); continue; } r -= I_OUT;
        if (r < I_OUT) { p0_transpose_item<0>(a.in[26], FF, D, D, (bf16*)(ws + WS_W7), nullptr, scr, r, lane); continue; } r -= I_OUT;
        if (r < I_3) { p0_transpose_item<2>(a.in[13], D, NIN, NIN, (bf16*)(ws + WS_W3), a.in[12], scr, r, lane); continue; } r -= I_3;
        if (r < I_4A) { p0_transpose_item<0>(a.in[21], 512, D, D, (bf16*)(ws + WS_W4A), nullptr, scr, r, lane); continue; } r -= I_4A;
        if (r < I_4B) { p0_transpose_item<0>(a.in[22], 256, D, D, (bf16*)(ws + WS_W4B), nullptr, scr, r, lane); continue; } r -= I_4B;
        p0_transpose_item<0>(a.in[23], D, D, D, (bf16*)(ws + WS_W5), nullptr, scr, r, lane);
    }
    float* rss0 = (float*)(ws + WS_RSS0); float* rss1 = (float*)(ws + WS_RSS1); float* rss2 = (float*)(ws + WS_RSS2);
    bf16* XB = (bf16*)(ws + WS_XB);
    for (int m0 = gw; m0 < T; m0 += 2 * NGW) {
        f32x4 v[2][4]; float ssq[2];
#pragma unroll
        for (int u = 0; u < 2; ++u) { const int m = m0 + u * NGW; if (m < T) { const float* xr = (m < TP) ? a.in[0] + (size_t)m * D : a.in[1] + (size_t)(m - TP) * D; const f32x4* x4 = (const f32x4*)xr + lane;
#pragma unroll
            for (int j = 0; j < 4; ++j) v[u][j] = __builtin_nontemporal_load(x4 + 64 * j); } }
#pragma unroll
        for (int u = 0; u < 2; ++u) { const int m = m0 + u * NGW; if (m < T) { float sq = 0.f;
#pragma unroll
            for (int j = 0; j < 4; ++j) sq += (v[u][j][0] * v[u][j][0] + v[u][j][1] * v[u][j][1]) + (v[u][j][2] * v[u][j][2] + v[u][j][3] * v[u][j][3]);
            ssq[u] = wave_sum(sq);
            if (lane == 0) { rss0[m] = ssq[u]; rss1[m] = 0.f; rss2[m] = 0.f; }
            v2u* o8 = (v2u*)(XB + (size_t)m * D) + lane;
#pragma unroll
            for (int j = 0; j < 4; ++j) { v2u w; w.x = pk2(v[u][j][0], v[u][j][1]); w.y = pk2(v[u][j][2], v[u][j][3]); o8[64 * j] = w; } } }
    }
    const size_t gtid = (size_t)bid * 512 + tid, nthr = (size_t)G * 512;
    float* rot = (float*)(ws + WS_ROT);
    for (size_t i = gtid; i < (size_t)4100 * 8; i += nthr) {
        const int p = (int)(i >> 3), f = (int)(i & 7); const int pos = p < 4096 ? p : 2048 + (p - 4096);
        const double inv = exp2(-(double)f * (18.931568569324174 / 8.0));
        const double rev = (double)pos * inv * 0.15915494309189535;
        const double fr = rev - rint(rev);
        const float ang = (float)(fr * 6.283185307179586);
        rot[(size_t)p * 16 + f] = __builtin_amdgcn_cosf((float)fr); rot[(size_t)p * 16 + 8 + f] = __builtin_amdgcn_sinf((float)fr); (void)ang;
    }
    { float* qkn = (float*)(ws + WS_QKN); for (size_t i = gtid; i < 1536; i += nthr) qkn[i] = i < 768 ? a.in[15][i] : a.in[16][i - 768]; }
}

__device__ __forceinline__ int crow(int r, int hi) { return (r & 3) + 8 * (r >> 2) + 4 * hi; }
constexpr int KS_STRIDE = 144, VT_OFF = 384 * KS_STRIDE, VT_STRIDE = 776;
struct AttnU { int b, g, h, d, r, i0, hc; };
__device__ __forceinline__ AttnU attn_decode(int unit) {
    AttnU u; u.b = unit / 192; int rem = unit % 192; u.g = rem / 64; rem %= 64; u.h = rem / 16; const int x = rem % 16;
    const int dsh = 2 * u.g, nblk = 16 >> dsh; u.d = 1 << dsh; u.r = x / nblk; u.i0 = (x % nblk) * 256; u.hc = (4 * u.g + u.h) * 64; return u;
}
__device__ __forceinline__ void attn_load(const AttnU& u, const bf16* Kb, const bf16* Vb, int tid, v4u (&kv)[6], v4u (&vv)[6]) {
#pragma unroll
    for (int k = 0; k < 6; ++k) { const int q = tid + 512 * k, s = q >> 3, c = q & 7, i = u.i0 - 128 + s;
        if (i >= 0) { const size_t off = ((size_t)u.b * 4096 + (size_t)i * u.d + u.r) * 768 + u.hc + 8 * c; kv[k] = *(const v4u*)(Kb + off); vv[k] = *(const v4u*)(Vb + off); }
        else { kv[k] = (v4u){0u, 0u, 0u, 0u}; vv[k] = (v4u){0u, 0u, 0u, 0u}; } }
}
__device__ __forceinline__ void attn_write(LAS unsigned char* lds, int tid, const v4u (&kv)[6], const v4u (&vv)[6]) {
#pragma unroll
    for (int k = 0; k < 6; ++k) { const int q = tid + 512 * k, s = q >> 3, c = q & 7;
        *(LAS v4u*)(lds + s * KS_STRIDE + 16 * c) = kv[k];
#pragma unroll
        for (int e = 0; e < 4; ++e) { const unsigned w = vv[k][e];
            *(LAS unsigned short*)(lds + VT_OFF + (8 * c + 2 * e) * VT_STRIDE + s * 2) = (unsigned short)(w & 0xffffu);
            *(LAS unsigned short*)(lds + VT_OFF + (8 * c + 2 * e + 1) * VT_STRIDE + s * 2) = (unsigned short)(w >> 16); } }
}
__device__ __forceinline__ void attn_qload(const AttnU& u, const bf16* Q, int tid, bf16x8 (&qf)[4]) {
    const int w = tid >> 6, lane = tid & 63, ql = lane & 31, hi = lane >> 5;
    const size_t qrow = (size_t)u.b * 4096 + (size_t)(u.i0 + 32 * w + ql) * u.d + u.r;
#pragma unroll
    for (int kk = 0; kk < 4; ++kk) qf[kk] = *(const bf16x8*)(Q + qrow * 768 + u.hc + 16 * kk + 8 * hi);
}
__device__ __forceinline__ void attn_compute(LAS unsigned char* lds, const AttnU& u, const bf16x8 (&qf)[4], bf16* OG, float* ML, int tid) {
    const int w = tid >> 6, lane = tid & 63, ql = lane & 31, hi = lane >> 5;
    const size_t qrow = (size_t)u.b * 4096 + (size_t)(u.i0 + 32 * w + ql) * u.d + u.r;
    f32x16 S[5];
#pragma unroll
    for (int j = 0; j < 5; ++j) {
#pragma unroll
        for (int e = 0; e < 16; ++e) S[j][e] = 0.f;
#pragma unroll
        for (int kk = 0; kk < 4; ++kk) { const bf16x8 af = *(const LAS bf16x8*)(lds + (32 * (w + j) + ql) * KS_STRIDE + (16 * kk + 8 * hi) * 2);
            S[j] = __builtin_amdgcn_mfma_f32_32x32x16_bf16(af, qf[kk], S[j], 0, 0, 0); }
    }
    const bool first = (u.i0 == 0);
#pragma unroll
    for (int e = 0; e < 16; ++e) { const int kl = crow(e, hi); if (kl < ql) S[0][e] = -INFINITY; if (kl > ql) S[4][e] = -INFINITY; }
#pragma unroll
    for (int j = 0; j < 4; ++j) if (first && (w + j < 4)) {
#pragma unroll
        for (int e = 0; e < 16; ++e) S[j][e] = -INFINITY; }
    float mx = -INFINITY;
#pragma unroll
    for (int j = 0; j < 5; ++j)
#pragma unroll
        for (int e = 0; e < 16; ++e) mx = fmaxf(mx, S[j][e]);
    mx = fmaxf(mx, __shfl_xor(mx, 32));
    float l = 0.f;
#pragma unroll
    for (int j = 0; j < 5; ++j)
#pragma unroll
        for (int e = 0; e < 16; ++e) { const float p = __builtin_amdgcn_exp2f(S[j][e] - mx); S[j][e] = p; l += p; }
    l += __shfl_xor(l, 32);
    f32x16 O[2];
#pragma unroll
    for (int e = 0; e < 16; ++e) { O[0][e] = 0.f; O[1][e] = 0.f; }
#pragma unroll
    for (int j = 0; j < 5; ++j)
#pragma unroll
        for (int c = 0; c < 2; ++c) {
            v4u pw; pw.x = pg8::cvt_pk_bf16(S[j][8 * c + 0], S[j][8 * c + 1]); pw.y = pg8::cvt_pk_bf16(S[j][8 * c + 2], S[j][8 * c + 3]); pw.z = pg8::cvt_pk_bf16(S[j][8 * c + 4], S[j][8 * c + 5]); pw.w = pg8::cvt_pk_bf16(S[j][8 * c + 6], S[j][8 * c + 7]);
            const bf16x8 pf = __builtin_bit_cast(bf16x8, pw);
            const int s0 = 32 * (w + j) + 16 * c + 4 * hi;
#pragma unroll
            for (int dt = 0; dt < 2; ++dt) { const int dim = 32 * dt + ql;
                const v2u lo = *(const LAS v2u*)(lds + VT_OFF + dim * VT_STRIDE + s0 * 2), hh = *(const LAS v2u*)(lds + VT_OFF + dim * VT_STRIDE + (s0 + 8) * 2);
                v4u vw; vw.x = lo.x; vw.y = lo.y; vw.z = hh.x; vw.w = hh.y;
                O[dt] = __builtin_amdgcn_mfma_f32_32x32x16_bf16(__builtin_bit_cast(bf16x8, vw), pf, O[dt], 0, 0, 0); }
        }
    const float inv = 1.f / l;
    bf16* og = OG + ((size_t)u.g * T + qrow) * 256 + u.h * 64;
#pragma unroll
    for (int dt = 0; dt < 2; ++dt)
#pragma unroll
        for (int q4 = 0; q4 < 4; ++q4) { v2u w2; w2.x = pg8::cvt_pk_bf16(O[dt][4 * q4] * inv, O[dt][4 * q4 + 1] * inv); w2.y = pg8::cvt_pk_bf16(O[dt][4 * q4 + 2] * inv, O[dt][4 * q4 + 3] * inv);
            *(v2u*)(og + 32 * dt + 8 * q4 + 4 * hi) = w2; }
    if (hi == 0) { float* ml = ML + (((size_t)u.g * T + qrow) * 4 + u.h) * 2; ml[0] = mx; ml[1] = l; }
}

__device__ __forceinline__ void attn_sample_g12(const Args& a, LAS unsigned char* lds, const bf16* Q, const bf16* Kb, const bf16* Vb, bf16* OG, float* ML, int b, int g, int tid) {
    const int w = tid >> 6, lane = tid & 63, s = w >> 1, half = w & 1;
    const int W = 128 << (2 * g), d = 1 << (2 * g);
    const char* ck = (const char*)(a.in[2 + 2 * g] + (size_t)b * W * 256); const char* cv = (const char*)(a.in[3 + 2 * g] + (size_t)b * W * 256); const unsigned voff = (unsigned)lane * 16u;
    const size_t row = (size_t)TP + b * 4 + s; const int head = lane >> 4, dl = (lane & 15) * 4;
    const int hcol = (4 * g + head) * 64 + dl;
    float q[4]; { const v2u qw = *(const v2u*)(Q + row * 768 + hcol); q[0] = bfl(qw.x); q[1] = bfh(qw.x); q[2] = bfl(qw.y); q[3] = bfh(qw.y); }
    float m = -INFINITY, l = 0.f, o[4] = {0.f, 0.f, 0.f, 0.f};
    const int jbeg = half * 65, jend = half ? 129 : 65;
#pragma unroll 1
    for (int j0 = jbeg; j0 < jend; j0 += 16) {
        f32x4 kk[16], vv[16];
#pragma unroll
        for (int jj = 0; jj < 16; ++jj) { const int j = j0 + jj; int idx = W + s - d * j; if (j >= jend) idx = 0;
            if (idx >= W) { const size_t r2 = (size_t)TP + b * 4 + (idx - W); const v2u kw = *(const v2u*)(Kb + r2 * 768 + hcol), vw = *(const v2u*)(Vb + r2 * 768 + hcol);
                kk[jj] = (f32x4){bfl(kw.x), bfh(kw.x), bfl(kw.y), bfh(kw.y)}; vv[jj] = (f32x4){bfl(vw.x), bfh(vw.x), bfl(vw.y), bfh(vw.y)}; }
            else { const int ui = __builtin_amdgcn_readfirstlane(idx); kk[jj] = __builtin_nontemporal_load((const f32x4*)(ck + (size_t)ui * 1024 + voff)); vv[jj] = __builtin_nontemporal_load((const f32x4*)(cv + (size_t)ui * 1024 + voff)); } }
        float sc[16]; float cm = -INFINITY;
#pragma unroll
        for (int jj = 0; jj < 16; ++jj) { float t = (kk[jj][0] * q[0] + kk[jj][1] * q[1]) + (kk[jj][2] * q[2] + kk[jj][3] * q[3]);
            t += __shfl_xor(t, 1); t += __shfl_xor(t, 2); t += __shfl_xor(t, 4); t += __shfl_xor(t, 8);
            sc[jj] = (j0 + jj < jend) ? t : -INFINITY; cm = fmaxf(cm, sc[jj]); }
        const float mn = fmaxf(m, cm), scale = __builtin_amdgcn_exp2f(m - mn);
        l *= scale; o[0] *= scale; o[1] *= scale; o[2] *= scale; o[3] *= scale;
#pragma unroll
        for (int jj = 0; jj < 16; ++jj) { const float p = __builtin_amdgcn_exp2f(sc[jj] - mn); l += p; o[0] += p * vv[jj][0]; o[1] += p * vv[jj][1]; o[2] += p * vv[jj][2]; o[3] += p * vv[jj][3]; }
        m = mn;
    }
    LAS float* P = (LAS float*)lds;
    if (half) { LAS float* pp = P + (w * 64 + lane) * 6; pp[0] = m; pp[1] = l; pp[2] = o[0]; pp[3] = o[1]; pp[4] = o[2]; pp[5] = o[3]; }
    __syncthreads();
    if (!half) { const LAS float* pp = P + ((w + 1) * 64 + lane) * 6; const float m1 = pp[0], l1 = pp[1];
        const float M = fmaxf(m, m1), a0 = __builtin_amdgcn_exp2f(m - M), a1 = __builtin_amdgcn_exp2f(m1 - M);
        const float lt = a0 * l + a1 * l1, inv = 1.f / lt;
        v2u w2; w2.x = pk2((a0 * o[0] + a1 * pp[2]) * inv, (a0 * o[1] + a1 * pp[3]) * inv); w2.y = pk2((a0 * o[2] + a1 * pp[4]) * inv, (a0 * o[3] + a1 * pp[5]) * inv);
        *(v2u*)(OG + ((size_t)g * T + row) * 256 + head * 64 + dl) = w2;
        if ((lane & 15) == 0) { float* ml = ML + (((size_t)g * T + row) * 4 + head) * 2; ml[0] = M; ml[1] = lt; } }
}
template <int NTOK, bool SAMPLE> __device__ __forceinline__ void conv_unit(const Args& a, LAS unsigned char* lds, const bf16* U, bf16* CONVF, const float (&cw)[31], int unit, int tid) {
    const int c = tid; float win[NTOK + 30];
    size_t row0; const unsigned vo2 = (unsigned)c * 2u, vo4 = (unsigned)c * 4u;
    if (!SAMPLE) { row0 = (size_t)unit * NTOK; const int t0 = (int)(row0 & 4095); const char* ub = (const char*)(U + row0 * 512);
#pragma unroll
        for (int jr = 0; jr < NTOK + 30; ++jr) { const int t = t0 - 30 + jr; win[jr] = (t >= 0) ? bf2f_g(*(const unsigned short*)(ub + (jr - 30) * 1024 + vo2)) : 0.f; } }
    else { row0 = (size_t)TP + (size_t)unit * 4; const char* st = (const char*)(a.in[8] + (size_t)unit * 30 * 512); const char* ub = (const char*)(U + row0 * 512);
#pragma unroll
        for (int jr = 0; jr < 30; ++jr) win[jr] = *(const float*)(st + jr * 2048 + vo4);
#pragma unroll
        for (int jr = 0; jr < NTOK; ++jr) win[30 + jr] = bf2f_g(*(const unsigned short*)(ub + jr * 1024 + vo2)); }
    const float cb = *(const float*)((const char*)a.in[18] + vo4);
    LAS float* yb = (LAS float*)lds;
    __syncthreads();
#pragma unroll
    for (int t = 0; t < NTOK; ++t) { float y = cb;
#pragma unroll
        for (int j = 0; j < 31; ++j) y += cw[j] * win[t + j];
        yb[t * 512 + c] = y; }
    __syncthreads();
    const int w = tid >> 6, lane = tid & 63;
    constexpr int TPW = (NTOK + 7) / 8;
#pragma unroll
    for (int tt = 0; tt < TPW; ++tt) { const int t = w * TPW + tt;
        if (t < NTOK) {
            float y[8]; float s = 0.f;
#pragma unroll
            for (int i = 0; i < 8; ++i) { y[i] = yb[t * 512 + lane + 64 * i]; s += y[i]; }
            const float mu = wave_sum(s) * (1.f / 512.f); float q = 0.f;
#pragma unroll
            for (int i = 0; i < 8; ++i) { y[i] -= mu; q += y[i] * y[i]; }
            const float rstd = __builtin_amdgcn_rsqf(wave_sum(q) * (1.f / 512.f) + 1e-6f);
#pragma unroll
            for (int i = 0; i < 8; ++i) { const int cc = lane + 64 * i; const float z = y[i] * rstd * *(const float*)((const char*)a.in[19] + i * 256 + (unsigned)lane * 4u) + *(const float*)((const char*)a.in[20] + i * 256 + (unsigned)lane * 4u);
                const float sw = z * __builtin_amdgcn_rcpf(1.f + __builtin_amdgcn_exp2f(-1.4426950408889634f * z));
                CONVF[(row0 + t) * 512 + cc] = (bf16)f2bf(sw); }
        }
    }
}

__device__ __forceinline__ void combine_groups(const bf16* OG, const float* ML, bf16* BATT, size_t row_lo, size_t row_hi, size_t gtid, size_t nthr) {
    for (size_t i = row_lo * 32 + gtid; i < row_hi * 32; i += nthr) {
        const size_t row = i >> 5; const int c8 = (int)(i & 31), h = c8 >> 3;
        float mg[3], lg[3]; v4u og[3];
#pragma unroll
        for (int g = 0; g < 3; ++g) { const float* ml = ML + (((size_t)g * T + row) * 4 + h) * 2; mg[g] = ml[0]; lg[g] = ml[1]; og[g] = *(const v4u*)(OG + ((size_t)g * T + row) * 256 + c8 * 8); }
        const float M = fmaxf(mg[0], fmaxf(mg[1], mg[2]));
        float wg[3], ws = 0.f;
#pragma unroll
        for (int g = 0; g < 3; ++g) { wg[g] = __builtin_amdgcn_exp2f(mg[g] - M) * lg[g]; ws += wg[g]; }
        const float inv = 1.f / ws; float o[8];
#pragma unroll
        for (int e = 0; e < 8; ++e) o[e] = 0.f;
#pragma unroll
        for (int g = 0; g < 3; ++g) { const float wn = wg[g] * inv;
#pragma unroll
            for (int e = 0; e < 4; ++e) { o[2 * e] += wn * bfl(og[g][e]); o[2 * e + 1] += wn * bfh(og[g][e]); } }
        v4u w; w.x = pk2(o[0], o[1]); w.y = pk2(o[2], o[3]); w.z = pk2(o[4], o[5]); w.w = pk2(o[6], o[7]);
        *(v4u*)(BATT + row * 256 + c8 * 8) = w;
    }
}

__device__ __forceinline__ void subseam(unsigned* cnt, unsigned n, bool produce, int tid) {
    if (produce) { __threadfence(); __syncthreads(); if (tid == 0) __hip_atomic_fetch_add(cnt, 1u, __ATOMIC_RELEASE, __HIP_MEMORY_SCOPE_AGENT); }
    if (tid == 0) { unsigned sp = 0; while (__hip_atomic_load(cnt, __ATOMIC_ACQUIRE, __HIP_MEMORY_SCOPE_AGENT) < n) { __builtin_amdgcn_s_sleep(8); if (++sp > (1u << 22)) break; } }
    __syncthreads(); __threadfence();
}
#define XB_TMO      128
#define XB_XCNT(j)  (256  + 64 * (j))
#define XB_XSUB(j)  (1280 + 64 * (j))
#define XB_XGEN(j)  (2304 + 64 * (j))
#define XB_TOP      3328
#define XB_TOPGEN   3392
#define XCD_BAR_WORDS 3456
#define XB_SPIN_CAP (1u << 18)

__device__ __forceinline__ unsigned xb_ld(unsigned* p)              { return __hip_atomic_load(p, __ATOMIC_RELAXED, __HIP_MEMORY_SCOPE_AGENT); }
__device__ __forceinline__ unsigned xb_add(unsigned* p, unsigned v) { return __hip_atomic_fetch_add(p, v, __ATOMIC_RELAXED, __HIP_MEMORY_SCOPE_AGENT); }
__device__ __forceinline__ unsigned xb_xcc_id() { return (unsigned)__builtin_amdgcn_s_getreg((3 << 11) | 20) & 0xFu; }
#define XB_SPIN(cond, bar) do { unsigned _sp = 0; while (cond) { __builtin_amdgcn_s_sleep(1); \
    if ((++_sp & 255u) == 0u) { if (xb_ld(&(bar)[XB_TMO])) break; if (_sp > XB_SPIN_CAP) { atomicAdd(&(bar)[XB_TMO], 1u); break; } } } } while (0)

struct XcdBarrier {
    unsigned* bar; unsigned x;
    volatile LAS unsigned* st;
};

__device__ __forceinline__ XcdBarrier xcd_barrier_post(unsigned* bar, volatile LAS unsigned* st) {
    XcdBarrier b; b.bar = bar; b.x = xb_xcc_id(); b.st = st;
    if (threadIdx.x == 0) (void)xb_add(&bar[XB_XCNT(b.x)], 1u);
    return b;
}
__device__ __forceinline__ void xcd_barrier_complete(unsigned* bar, unsigned x, unsigned& nloc, unsigned& nx) {
    const unsigned G = gridDim.x * gridDim.y * gridDim.z;
    unsigned sum, cnt, mine, sp = 0u;
    for (;;) {
        sum = 0u; cnt = 0u; mine = 0u;
#pragma unroll
        for (unsigned j = 0; j < 16; ++j) { const unsigned c = xb_ld(&bar[XB_XCNT(j)]); sum += c; cnt += (c > 0u) ? 1u : 0u; mine = (j == x) ? c : mine; }
        if (sum == G) break;
        __builtin_amdgcn_s_sleep(1);
        if ((++sp & 255u) == 0u) { if (xb_ld(&bar[XB_TMO])) break; if (sp > XB_SPIN_CAP) { atomicAdd(&bar[XB_TMO], 1u); break; } }
    }
    nloc = mine > 0u ? mine : 1u; nx = cnt > 0u ? cnt : 1u;
}

__device__ __forceinline__ void xcd_barrier(const XcdBarrier& b) {
    asm volatile("s_waitcnt vmcnt(0)" ::: "memory");
    __syncthreads();
    if (threadIdx.x == 0) {
        unsigned* bar = b.bar;
        __builtin_amdgcn_s_waitcnt(0);
        unsigned nloc = b.st[0], nx = b.st[1];
        if (nloc == 0u) { xcd_barrier_complete(bar, b.x, nloc, nx); b.st[0] = nloc; b.st[1] = nx; }
        const unsigned old = xb_add(&bar[XB_XSUB(b.x)], 1u);
        const unsigned gen = old / nloc;
        if (old + 1u == (gen + 1u) * nloc) {
            __builtin_amdgcn_fence(__ATOMIC_RELEASE, "agent");
            asm volatile("s_waitcnt vmcnt(0)" ::: "memory");
            const unsigned og = xb_add(&bar[XB_TOP], 1u);
            const unsigned tg = og / nx;
            if (og + 1u == (tg + 1u) * nx) xb_add(&bar[XB_TOPGEN], 1u);
            else XB_SPIN(xb_ld(&bar[XB_TOPGEN]) == tg, bar);
            __builtin_amdgcn_fence(__ATOMIC_ACQUIRE, "agent");
            xb_add(&bar[XB_XGEN(b.x)], 1u);
            asm volatile("s_waitcnt vmcnt(0)" ::: "memory");
        } else {
            XB_SPIN(xb_ld(&bar[XB_XGEN(b.x)]) == gen, bar);
            __builtin_amdgcn_fence(__ATOMIC_ACQUIRE, "agent");
            asm volatile("s_waitcnt vmcnt(0)" ::: "memory");
        }
    }
    __syncthreads();
}
__global__ void __launch_bounds__(512, 2) mk_fwd(Args args) {
    extern __shared__ __attribute__((aligned(16))) unsigned char lds_raw[];
    LAS unsigned char* lds = (LAS unsigned char*)lds_raw;
    const int tid = threadIdx.x, G = gridDim.x, bid = blockIdx.x;
    unsigned char* ws = args.ws;
    const int lo = args.ph_lo, hi = args.ph_hi;
#define IN(k) (lo <= (k) && (k) < hi)
#define SEAM(k) do { if (IN(k) && IN((k) + 1)) { xcd_barrier(bar); } } while (0)
    volatile LAS unsigned* MISC = (volatile LAS unsigned*)(lds + 131072);
    if (tid < 64) MISC[tid] = 0u;
    __syncthreads();
    unsigned* fctl = (unsigned*)(ws + WS_CTL);
    XcdBarrier bar; bar.bar = (unsigned*)(ws + WS_BAR); bar.x = 0; bar.st = nullptr;
    if (hi - lo > 1) bar = xcd_barrier_post((unsigned*)(ws + WS_BAR), MISC + 8);
    float* rss0 = (float*)(ws + WS_RSS0); float* rss1 = (float*)(ws + WS_RSS1); float* rss2 = (float*)(ws + WS_RSS2);
    bf16* XB = (bf16*)(ws + WS_XB); bf16* ACT = (bf16*)(ws + WS_ACT); float* X1 = (float*)(ws + WS_X1); bf16* X1B = (bf16*)(ws + WS_X1B);
    bf16* Ub = (bf16*)(ws + WS_U); bf16* Qb = (bf16*)(ws + WS_Q); bf16* Kb = (bf16*)(ws + WS_K); bf16* Vb = (bf16*)(ws + WS_V); bf16* Gb = (bf16*)(ws + WS_G);
    bf16* CONVF = (bf16*)(ws + WS_CONVF); bf16* OG = (bf16*)(ws + WS_OG); float* ML = (float*)(ws + WS_ML); bf16* BATT = (bf16*)(ws + WS_BATT);
    bf16* TMP = (bf16*)(ws + WS_TMP); bf16* MIX = (bf16*)(ws + WS_MIX); float* X2 = (float*)(ws + WS_X2); bf16* X2B = (bf16*)(ws + WS_X2B);

    if (IN(0)) { p0_prologue(args, lds, G, bid, tid); }
    SEAM(0);
    const bf16* W1 = (const bf16*)(ws + WS_W1); const bf16* W2 = (const bf16*)(ws + WS_W2); const bf16* W3 = (const bf16*)(ws + WS_W3); const bf16* W4A = (const bf16*)(ws + WS_W4A);
    const bf16* W4B = (const bf16*)(ws + WS_W4B); const bf16* W5 = (const bf16*)(ws + WS_W5); const bf16* W6 = (const bf16*)(ws + WS_W6); const bf16* W7 = (const bf16*)(ws + WS_W7);
#define GEMM(EPI, Aop, Bop, Nn, Kk, nM_, pmoff, Gs, cs, Eobj) do { pg8::Gemm g_{Aop, Bop, T, Nn, Kk}; pg8::SubOrder S_; S_.init(nM_, (Nn) / 256, pmoff, Gs, cs); \
        pg8::gemm_phase<EPI, pg8::SubOrder, true, true>(lds, g_, S_, Eobj); } while (0)
    if (IN(1)) {
        pg8::EpiSwiGLU E{rss0, ACT};
        GEMM(pg8::EpiSwiGLU, XB, W1, 2 * FF, D, 64, 0, G - 12, bid < G - 12 ? bid : -1, E);
        GEMM(pg8::EpiSwiGLU, XB, W1, 2 * FF, D, 2, 64, 44, bid - 192, E);
    }
    SEAM(1);
    if (IN(2)) {
        pg8::EpiResid<true> E{args.in[0], args.in[1] - (size_t)TP * D, X1, X1B, rss1, 0.5f};
        GEMM(pg8::EpiResid<true>, ACT, W2, D, FF, 64, 0, G, bid, E);
    }
    SEAM(2);
    if (IN(3)) {
        { pg8::EpiIn E{rss1, Ub, Qb, Gb, args.in[14], (const float*)(ws + WS_QKN), (const float*)(ws + WS_ROT), args.out};
          GEMM(pg8::EpiIn, X1B, W3, NIN, D, 64, 0, G - 24, bid < G - 24 ? bid : -1, E); }
        { pg8::EpiResid<true> E{args.in[0], args.in[1] - (size_t)TP * D, X1, X1B, rss1, 0.5f};
          GEMM(pg8::EpiResid<true>, ACT, W2, D, FF, 2, 64, 8, bid - (G - 8), E); }
        if (bid >= G - 24) {
            unsigned* cnt = fctl + 64 * 26;
            if (bid >= G - 8) { __threadfence(); __syncthreads(); if (tid == 0) __hip_atomic_fetch_add(cnt, 1u, __ATOMIC_RELEASE, __HIP_MEMORY_SCOPE_AGENT); }
            if (tid == 0) { unsigned sp = 0; while (__hip_atomic_load(cnt, __ATOMIC_ACQUIRE, __HIP_MEMORY_SCOPE_AGENT) < 8u) { __builtin_amdgcn_s_sleep(8); if (++sp > (1u << 22)) break; } }
            __syncthreads(); __threadfence();
            pg8::EpiIn E{rss1, Ub, Qb, Gb, args.in[14], (const float*)(ws + WS_QKN), (const float*)(ws + WS_ROT), args.out};
            GEMM(pg8::EpiIn, X1B, W3, NIN, D, 2, 64, 24, bid - (G - 24), E);
        }
    }
    SEAM(3);
    if (IN(4)) {
        int it = 0; unsigned id = grab(fctl + 64 * 20, MISC, it, tid);
        while (id < 384u) { attn_sample_g12(args, lds, Qb, Kb, Vb, OG, ML, (int)(id / 3u), (int)(id % 3u), tid); id = grab(fctl + 64 * 20, MISC, it, tid); }
        {
            v4u kv[6], vv[6]; AttnU cur = attn_decode(id < 1152u ? (int)id - 384 : 0);
            if (id < 1152u) attn_load(cur, Kb, Vb, tid, kv, vv);
            while (id < 1152u) {
                __syncthreads();
                attn_write(lds, tid, kv, vv);
                __syncthreads();
                bf16x8 qf[4]; attn_qload(cur, Qb, tid, qf);
                const unsigned nid = grab(fctl + 64 * 20, MISC, it, tid);
                const AttnU nxt = attn_decode(nid < 1152u ? (int)nid - 384 : 0);
                if (nid < 1152u) attn_load(nxt, Kb, Vb, tid, kv, vv);
                attn_compute(lds, cur, qf, OG, ML, tid);
                cur = nxt; id = nid;
            }
        }
        {   float cw[31];
#pragma unroll
            for (int j = 0; j < 31; ++j) cw[j] = *(const float*)((const char*)args.in[17] + j * 2048 + (unsigned)tid * 4u);
            while (id < 1664u) { conv_unit<32, false>(args, lds, Ub, CONVF, cw, (int)id - 1152, tid); id = grab(fctl + 64 * 20, MISC, it, tid); }
            while (id < 1792u) { conv_unit<4, true>(args, lds, Ub, CONVF, cw, (int)id - 1664, tid); id = grab(fctl + 64 * 20, MISC, it, tid); }
        }
    }
    SEAM(4);
    if (IN(5)) {
        combine_groups(OG, ML, BATT, 0, TP, (size_t)bid * 512 + tid, (size_t)G * 512);
        __syncthreads();
        { pg8::EpiGateA E{Gb, TMP}; GEMM(pg8::EpiGateA, CONVF, W4A, D, 512, 64, 0, G, bid, E); }
    }
    SEAM(5);
    if (IN(6)) {
        pg8::EpiGateB E{Gb, TMP, MIX}; GEMM(pg8::EpiGateB, BATT, W4B, D, 256, 64, 0, G, bid, E);
    }
    SEAM(6);
    if (IN(7)) {
        pg8::EpiResid<true> E{X1, X1, X2, X2B, rss2, 1.0f}; GEMM(pg8::EpiResid<true>, MIX, W5, D, D, 64, 0, G, bid, E);
    }
    SEAM(7);
    if (IN(8)) {
        { pg8::EpiSwiGLU E{rss2, ACT}; GEMM(pg8::EpiSwiGLU, X2B, W6, 2 * FF, D, 64, 0, G - 8, bid < G - 8 ? bid : -1, E); }
        if (bid >= G - 8) { const int sb = bid - (G - 8);
            combine_groups(OG, ML, BATT, TP, T, (size_t)sb * 512 + tid, (size_t)8 * 512);
            { pg8::EpiGateA E{Gb, TMP}; GEMM(pg8::EpiGateA, CONVF, W4A, D, 512, 2, 64, 8, sb, E); }
            subseam(fctl + 64 * 27, 8u, true, tid);
            { pg8::EpiGateB E{Gb, TMP, MIX}; GEMM(pg8::EpiGateB, BATT, W4B, D, 256, 2, 64, 8, sb, E); }
            subseam(fctl + 64 * 28, 8u, true, tid);
            { pg8::EpiResid<true> E{X1, X1, X2, X2B, rss2, 1.0f}; GEMM(pg8::EpiResid<true>, MIX, W5, D, D, 2, 64, 8, sb, E); }
        }
    }
    SEAM(8);
    if (IN(9)) {
        { pg8::EpiResid<false> E{X2, X2, args.out, nullptr, nullptr, 0.5f}; GEMM(pg8::EpiResid<false>, ACT, W7, D, FF, 64, 0, G / 2, bid < G / 2 ? bid : -1, E); }
        if (bid >= G / 2 && bid < G / 2 + 44) { const int sb = bid - G / 2;
            { pg8::EpiSwiGLU E{rss2, ACT}; GEMM(pg8::EpiSwiGLU, X2B, W6, 2 * FF, D, 2, 64, 44, sb, E); }
            if (sb < 8) { subseam(fctl + 64 * 29, 44u, true, tid);
                pg8::EpiResid<false> E{X2, X2, args.out, nullptr, nullptr, 0.5f}; GEMM(pg8::EpiResid<false>, ACT, W7, D, FF, 2, 64, 8, sb, E); }
            else { __threadfence(); __syncthreads(); if (tid == 0) __hip_atomic_fetch_add(fctl + 64 * 29, 1u, __ATOMIC_RELEASE, __HIP_MEMORY_SCOPE_AGENT); }
        }
        filler(args, fctl, 10, 0u, 0u, MISC, tid);
    }
#undef IN
#undef SEAM
}

extern "C" void kernel_launch(void* const* d_in, const int* in_sizes, int n_in, void* d_out, int out_size, void* d_ws, size_t ws_size, hipStream_t stream) {
    static int grid = 0;
    if (grid == 0) {
        int dev = 0, cus = 0, per_cu = 0;
        if (n_in != 27 || ws_size < WS_END) { fprintf(stderr, "kernel_launch: unexpected n_in %d / ws %zu (need %zu)\n", n_in, ws_size, (size_t)WS_END); grid = -1; return; }
        (void)hipGetDevice(&dev);
        (void)hipDeviceGetAttribute(&cus, hipDeviceAttributeMultiprocessorCount, dev);
        if (hipFuncSetAttribute((const void*)mk_fwd, hipFuncAttributeMaxDynamicSharedMemorySize, LDS_BYTES) != hipSuccess) { fprintf(stderr, "kernel_launch: hipFuncSetAttribute failed\n"); grid = -1; return; }
        if (hipOccupancyMaxActiveBlocksPerMultiprocessor(&per_cu, (const void*)mk_fwd, 512, LDS_BYTES) != hipSuccess || per_cu < 1) { fprintf(stderr, "kernel_launch: occupancy query failed (%d)\n", per_cu); per_cu = 1; }
        (void)hipGetLastError();
        grid = cus;
        fprintf(stderr, "kernel_launch: cus %d per_cu %d grid %d\n", cus, per_cu, grid);
    }
    if (grid < 0) return;
    Args a{};
    for (int i = 0; i < 27; ++i) a.in[i] = (const float*)d_in[i];
    a.out = (float*)d_out; a.ws = (unsigned char*)d_ws;
    if (hipMemsetAsync((char*)d_ws + WS_BAR, 0, WS_BAR_BYTES, stream) != hipSuccess) { fprintf(stderr, "kernel_launch: memset failed\n"); return; }
#if MK_N_LAUNCHES == 1
    a.ph_lo = 0; a.ph_hi = N_PHASES;
    hipLaunchKernelGGL(mk_fwd, dim3(grid), dim3(512), LDS_BYTES, stream, a);
#else
    for (int p = 0; p < N_PHASES; ++p) { a.ph_lo = p; a.ph_hi = p + 1; hipLaunchKernelGGL(mk_fwd, dim3(grid), dim3(512), LDS_BYTES, stream, a); }
#endif
}
```

```cpp
#include <hip/hip_runtime.h>
#include <cstdio>
#include <cstdint>
namespace pg8 {
#define PG8_LAS __attribute__((address_space(3)))
typedef unsigned short bf16_t;
typedef short bf16x8 __attribute__((ext_vector_type(8)));
typedef float f32x4 __attribute__((ext_vector_type(4)));
typedef unsigned u32x4 __attribute__((ext_vector_type(4)));
constexpr int BM = 256, BK = 64, HALF = 128, HTB = HALF * BK * 2  , STAGE_BYTES = 8 * HTB, NXCD = 8, WGM = 8;

__host__ __device__ __forceinline__ int lds_byte(int r, int c) { const int st = (r >> 4) * 2 + (c >> 5), rr = r & 15, cc = c & 31, ob = rr * 64 + cc * 2; return st * 1024 + (ob ^ (((ob >> 9) & 1) << 5)); }
__host__ __device__ __forceinline__ void stage_rc(int b, int& R, int& C) { const int st = b / 1024, sb = b % 1024, swz = sb ^ (((sb >> 9) & 1) << 5); R = (st >> 1) * 16 + swz / 64; C = (st & 1) * 32 + (swz % 64) / 2; }
__host__ __device__ __forceinline__ int perm32(int rho) { const int n = rho >> 4, i = rho & 15; return 8 * (i >> 2) + 4 * n + (i & 3); }

struct Unit { int pm, pn; };
struct Gemm { const bf16_t* A; const bf16_t* Bt; int M, N, K; };

struct StaticOrder {
    int nM, nN, nwg, G, c;
    __host__ __device__ void init(int M, int N, int G_, int c_) { nM = M / BM; nN = N / BM; nwg = nM * nN; G = G_; c = c_; }
    __host__ __device__ bool next(int i, Unit& u) const {
        const long L = (long)i * G + c; if (L >= nwg) return false;
        int wgid = (int)L; { const int q = nwg / NXCD, r = nwg % NXCD, xcd = wgid % NXCD, off = wgid / NXCD; wgid = (xcd < r ? xcd * (q + 1) : r * (q + 1) + (xcd - r) * q) + off; }
        const int nig = WGM * nN, gid = wgid / nig, fm = gid * WGM, gsz = (nM - fm) < WGM ? (nM - fm) : WGM;
        u.pm = fm + ((wgid % nig) % gsz); u.pn = (wgid % nig) / gsz; return true;
    }
    __device__ __forceinline__ void a_ready(const Unit&) const {}
    __device__ __forceinline__ void done(const Unit&) const {}
};

__device__ __forceinline__ unsigned cvt_pk_bf16(float lo, float hi) { unsigned r; asm volatile("v_cvt_pk_bf16_f32 %0, %1, %2" : "=v"(r) : "v"(lo), "v"(hi)); return r; }
typedef float f32x2 __attribute__((ext_vector_type(2)));
typedef unsigned u32x2 __attribute__((ext_vector_type(2)));
struct SubOrder {
    int nM, nN, nwg, G, c, pm_off;
    __host__ __device__ void init(int nM_, int nN_, int pm_off_, int G_, int c_) { nM = nM_; nN = nN_; nwg = (c_ >= 0 && c_ < G_) ? nM * nN : 0; G = G_; c = c_; pm_off = pm_off_; }
    __host__ __device__ bool next(int i, Unit& u) const {
        const long L = (long)i * G + c; if (c < 0 || L >= nwg) return false;
        int wgid = (int)L; { const int q = nwg / NXCD, r = nwg % NXCD, xcd = wgid % NXCD, off = wgid / NXCD; wgid = (xcd < r ? xcd * (q + 1) : r * (q + 1) + (xcd - r) * q) + off; }
        const int nig = WGM * nN, gid = wgid / nig, fm = gid * WGM, gsz = (nM - fm) < WGM ? (nM - fm) : WGM;
        u.pm = pm_off + fm + ((wgid % nig) % gsz); u.pn = (wgid % nig) / gsz; return true;
    }
    __device__ __forceinline__ void a_ready(const Unit&) const {}
    __device__ __forceinline__ void done(const Unit&) const {}
};
constexpr float NEPS = 1e-6f;
__device__ __forceinline__ float sigmoid_f(float x) { return __builtin_amdgcn_rcpf(1.f + __builtin_amdgcn_exp2f(-1.4426950408889634f * x)); }
__device__ __forceinline__ float silu_f(float x) { return x * sigmoid_f(x); }
__device__ __forceinline__ float bf2f(unsigned short h) { return __builtin_bit_cast(float, (unsigned)h << 16); }
__device__ __forceinline__ float bflo(unsigned w) { return __builtin_bit_cast(float, w << 16); }
__device__ __forceinline__ float bfhi(unsigned w) { return __builtin_bit_cast(float, w & 0xffff0000u); }

struct EpiSwiGLU {
    static constexpr bool PERM = false, AFTER_DRAIN = false;
    const float* rss; bf16_t* O;
    __device__ __forceinline__ void operator()(const f32x4 (&acc)[2][2][4][2], const Unit& u, int wr, int wc, int fr, int fq) const {
        const int row0 = u.pm * BM + wr * 64 + fr, col0 = u.pn * 128 + wc * 32 + 8 * fq;
#pragma unroll
        for (int ai = 0; ai < 2; ++ai)
#pragma unroll
            for (int m = 0; m < 4; ++m) {
                const int row = row0 + ai * HALF + m * 16;
                const float r = __builtin_amdgcn_rsqf(rss[row] * (1.f / 1024.f) + NEPS);
                float o[8];
#pragma unroll
                for (int n = 0; n < 2; ++n)
#pragma unroll
                    for (int e = 0; e < 4; ++e) o[4 * n + e] = silu_f(acc[ai][0][m][n][e] * r) * (acc[ai][1][m][n][e] * r);
                u32x4 w; w.x = cvt_pk_bf16(o[0], o[1]); w.y = cvt_pk_bf16(o[2], o[3]); w.z = cvt_pk_bf16(o[4], o[5]); w.w = cvt_pk_bf16(o[6], o[7]);
                *(u32x4*)(O + (size_t)row * 2816 + col0) = w;
            }
    }
};

template <bool NEXT> struct EpiResid {
    static constexpr bool PERM = false, AFTER_DRAIN = false;
    const float* base_p; const float* base_s; float* out; bf16_t* outb; float* rss; float alpha;
    __device__ __forceinline__ void operator()(const f32x4 (&acc)[2][2][4][2], const Unit& u, int wr, int wc, int fr, int fq) const {
        const int row0 = u.pm * BM + wr * 64 + fr, col0 = u.pn * BM + wc * 32 + 8 * fq;
        const float* base = (u.pm < 64) ? base_p : base_s;
#pragma unroll
        for (int ai = 0; ai < 2; ++ai)
#pragma unroll
            for (int m = 0; m < 4; ++m) {
                const int row = row0 + ai * HALF + m * 16; float ss = 0.f;
#pragma unroll
                for (int bj = 0; bj < 2; ++bj) {
                    const size_t off = (size_t)row * 1024 + col0 + bj * HALF;
                    const f32x4 b0 = *(const f32x4*)(base + off), b1 = *(const f32x4*)(base + off + 4);
                    const f32x4 v0 = b0 + acc[ai][bj][m][0] * alpha, v1 = b1 + acc[ai][bj][m][1] * alpha;
                    *(f32x4*)(out + off) = v0; *(f32x4*)(out + off + 4) = v1;
                    if (NEXT) {
                        u32x4 w; w.x = cvt_pk_bf16(v0[0], v0[1]); w.y = cvt_pk_bf16(v0[2], v0[3]); w.z = cvt_pk_bf16(v1[0], v1[1]); w.w = cvt_pk_bf16(v1[2], v1[3]);
                        *(u32x4*)(outb + off) = w;
                        ss += (v0[0] * v0[0] + v0[1] * v0[1]) + (v0[2] * v0[2] + v0[3] * v0[3]) + (v1[0] * v1[0] + v1[1] * v1[1]) + (v1[2] * v1[2] + v1[3] * v1[3]);
                    }
                }
                if (NEXT) { ss += __shfl_xor(ss, 16); ss += __shfl_xor(ss, 32); if (fq == 0) unsafeAtomicAdd(rss + row, ss); }
            }
    }
};

struct EpiGateA {
    static constexpr bool PERM = false, AFTER_DRAIN = false;
    const bf16_t* gates; bf16_t* tmp;
    __device__ __forceinline__ void operator()(const f32x4 (&acc)[2][2][4][2], const Unit& u, int wr, int wc, int fr, int fq) const {
        const int row0 = u.pm * BM + wr * 64 + fr, col0 = u.pn * BM + wc * 32 + 8 * fq;
#pragma unroll
        for (int ai = 0; ai < 2; ++ai)
#pragma unroll
            for (int m = 0; m < 4; ++m) {
                const int row = row0 + ai * HALF + m * 16;
#pragma unroll
                for (int bj = 0; bj < 2; ++bj) {
                    const int c = col0 + bj * HALF;
                    const u32x4 g = *(const u32x4*)(gates + (size_t)row * 2048 + c);
                    f32x4 v0 = acc[ai][bj][m][0], v1 = acc[ai][bj][m][1];
                    v0[0] *= bflo(g.x); v0[1] *= bfhi(g.x); v0[2] *= bflo(g.y); v0[3] *= bfhi(g.y);
                    v1[0] *= bflo(g.z); v1[1] *= bfhi(g.z); v1[2] *= bflo(g.w); v1[3] *= bfhi(g.w);
                    u32x4 w; w.x = cvt_pk_bf16(v0[0], v0[1]); w.y = cvt_pk_bf16(v0[2], v0[3]); w.z = cvt_pk_bf16(v1[0], v1[1]); w.w = cvt_pk_bf16(v1[2], v1[3]);
                    *(u32x4*)(tmp + (size_t)row * 1024 + c) = w;
                }
            }
    }
};
struct EpiGateB {
    static constexpr bool PERM = false, AFTER_DRAIN = false;
    const bf16_t* gates; const bf16_t* tmp; bf16_t* mix;
    __device__ __forceinline__ void operator()(const f32x4 (&acc)[2][2][4][2], const Unit& u, int wr, int wc, int fr, int fq) const {
        const int row0 = u.pm * BM + wr * 64 + fr, col0 = u.pn * BM + wc * 32 + 8 * fq;
#pragma unroll
        for (int ai = 0; ai < 2; ++ai)
#pragma unroll
            for (int m = 0; m < 4; ++m) {
                const int row = row0 + ai * HALF + m * 16;
#pragma unroll
                for (int bj = 0; bj < 2; ++bj) {
                    const int c = col0 + bj * HALF;
                    const u32x4 g = *(const u32x4*)(gates + (size_t)row * 2048 + 1024 + c);
                    const u32x4 tw = *(const u32x4*)(tmp + (size_t)row * 1024 + c); const f32x4 t0 = (f32x4){bflo(tw.x), bfhi(tw.x), bflo(tw.y), bfhi(tw.y)}, t1 = (f32x4){bflo(tw.z), bfhi(tw.z), bflo(tw.w), bfhi(tw.w)};
                    f32x4 v0 = acc[ai][bj][m][0], v1 = acc[ai][bj][m][1];
                    v0[0] = t0[0] + v0[0] * bflo(g.x); v0[1] = t0[1] + v0[1] * bfhi(g.x); v0[2] = t0[2] + v0[2] * bflo(g.y); v0[3] = t0[3] + v0[3] * bfhi(g.y);
                    v1[0] = t1[0] + v1[0] * bflo(g.z); v1[1] = t1[1] + v1[1] * bfhi(g.z); v1[2] = t1[2] + v1[2] * bflo(g.w); v1[3] = t1[3] + v1[3] * bfhi(g.w);
                    u32x4 w; w.x = cvt_pk_bf16(v0[0], v0[1]); w.y = cvt_pk_bf16(v0[2], v0[3]); w.z = cvt_pk_bf16(v1[0], v1[1]); w.w = cvt_pk_bf16(v1[2], v1[3]);
                    *(u32x4*)(mix + (size_t)row * 1024 + c) = w;
                }
            }
    }
};

struct EpiIn {
    static constexpr bool PERM = false, AFTER_DRAIN = false;
    const float* rss; bf16_t *U, *Q, *G; const float *b_gate, *qk_norm, *rot; float* out;
    static constexpr size_t O_KP0 = 17301504;
    __device__ __forceinline__ void operator()(const f32x4 (&acc)[2][2][4][2], const Unit& u, int wr, int wc, int fr, int fq) const {
        const int row0 = u.pm * BM + wr * 64 + fr; const int pn = u.pn; const bool samp = u.pm >= 64;
        if (pn < 4) {
            const int col0 = pn * 128 + wc * 32 + 8 * fq;
#pragma unroll
            for (int ai = 0; ai < 2; ++ai)
#pragma unroll
                for (int m = 0; m < 4; ++m) {
                    const int row = row0 + ai * HALF + m * 16; const float r = __builtin_amdgcn_rsqf(rss[row] * (1.f / 1024.f) + NEPS);
                    float o[8];
#pragma unroll
                    for (int n = 0; n < 2; ++n)
#pragma unroll
                        for (int e = 0; e < 4; ++e) o[4 * n + e] = (acc[ai][0][m][n][e] * r) * sigmoid_f(acc[ai][1][m][n][e] * r);
                    u32x4 w; w.x = cvt_pk_bf16(o[0], o[1]); w.y = cvt_pk_bf16(o[2], o[3]); w.z = cvt_pk_bf16(o[4], o[5]); w.w = cvt_pk_bf16(o[6], o[7]);
                    *(u32x4*)(U + (size_t)row * 512 + col0) = w;
                    float* cp = nullptr;
                    if (!samp) { const int t = row & 4095, b = row >> 12; if (t >= 4066) cp = out + 22806528 + ((size_t)(b * 30 + (t - 4066))) * 512 + col0; }
                    else { const int sr = row - 16384; cp = out + 199028736 + ((size_t)((sr >> 2) * 30 + 26 + (sr & 3))) * 512 + col0; }
                    if (cp) { *(f32x4*)cp = (f32x4){o[0], o[1], o[2], o[3]}; *(f32x4*)(cp + 4) = (f32x4){o[4], o[5], o[6], o[7]}; }
                }
        } else if (pn < 13) {
            const int kind = (pn - 4) / 3, g = (pn - 4) % 3;
            const int W = 128 << (2 * g);
            const int hcol = (4 * g + wc) * 64;
            int dim0[2][2];
#pragma unroll
            for (int n = 0; n < 2; ++n) { dim0[0][n] = (kind < 2 && fq < 2) ? 4 * fq + 8 * n : 8 * fq + 4 * n; dim0[1][n] = 32 + 8 * fq + 4 * n; }
            f32x4 gn[2][2];
            if (kind < 2) { const float* nw = qk_norm + kind * 768 + hcol;
#pragma unroll
                for (int bj = 0; bj < 2; ++bj)
#pragma unroll
                    for (int n = 0; n < 2; ++n) gn[bj][n] = *(const f32x4*)(nw + dim0[bj][n]); }
            bf16_t* dstb = Q + (size_t)kind * ((size_t)16896 * 768);
            size_t okp = 17301504, oks = 22867968;
            for (int gg = 0; gg < g; ++gg) { okp += (size_t)2 * 4 * (128 << (2 * gg)) * 256; oks += (size_t)2 * 128 * (128 << (2 * gg)) * 256; }
            if (kind == 2) { okp += (size_t)4 * W * 256; oks += (size_t)128 * W * 256; }
#pragma unroll
            for (int ai = 0; ai < 2; ++ai)
#pragma unroll
                for (int m = 0; m < 4; ++m) {
                    const int row = row0 + ai * HALF + m * 16; const float r = __builtin_amdgcn_rsqf(rss[row] * (1.f / 1024.f) + NEPS);
                    f32x4 v[2][2];
#pragma unroll
                    for (int bj = 0; bj < 2; ++bj)
#pragma unroll
                        for (int n = 0; n < 2; ++n) v[bj][n] = acc[ai][bj][m][n] * r;
                    int posidx, b, tt; float* cdst = nullptr;
                    if (!samp) { tt = row & 4095; b = row >> 12; posidx = tt; if (kind >= 1 && tt >= 4096 - W) cdst = out + okp + ((size_t)(b * W + (tt - (4096 - W))) * 4 + wc) * 64; }
                    else { const int sr = row - 16384; b = sr >> 2; tt = sr & 3; posidx = 4096 + tt; if (kind >= 1) cdst = out + oks + ((size_t)(b * W + (W - 4 + tt)) * 4 + wc) * 64; }
                    if (kind < 2) {
                        float ss = 0.f;
#pragma unroll
                        for (int bj = 0; bj < 2; ++bj)
#pragma unroll
                            for (int n = 0; n < 2; ++n) ss += (v[bj][n][0] * v[bj][n][0] + v[bj][n][1] * v[bj][n][1]) + (v[bj][n][2] * v[bj][n][2] + v[bj][n][3] * v[bj][n][3]);
                        ss += __shfl_xor(ss, 16); ss += __shfl_xor(ss, 32);
                        const float rn = __builtin_amdgcn_rsqf(ss * (1.f / 64.f) + NEPS);
#pragma unroll
                        for (int bj = 0; bj < 2; ++bj)
#pragma unroll
                            for (int n = 0; n < 2; ++n) v[bj][n] = v[bj][n] * rn * gn[bj][n];
                        if (fq < 2) {
                            const f32x4 cs = *(const f32x4*)(rot + (size_t)posidx * 16 + 4 * fq), sn = *(const f32x4*)(rot + (size_t)posidx * 16 + 8 + 4 * fq);
                            const f32x4 x1 = v[0][0], x2 = v[0][1];
                            v[0][0] = x1 * cs - x2 * sn; v[0][1] = x2 * cs + x1 * sn;
                        }
                        if (kind == 0) {
#pragma unroll
                            for (int bj = 0; bj < 2; ++bj)
#pragma unroll
                                for (int n = 0; n < 2; ++n) v[bj][n] = v[bj][n] * (0.125f * 1.4426950408889634f);
                        }
                    }
#pragma unroll
                    for (int bj = 0; bj < 2; ++bj)
#pragma unroll
                        for (int n = 0; n < 2; ++n) {
                            u32x2 w; w.x = cvt_pk_bf16(v[bj][n][0], v[bj][n][1]); w.y = cvt_pk_bf16(v[bj][n][2], v[bj][n][3]);
                            *(u32x2*)(dstb + (size_t)row * 768 + hcol + dim0[bj][n]) = w;
                            if (cdst) *(f32x4*)(cdst + dim0[bj][n]) = v[bj][n];
                        }
                }
        } else {
            const int col0 = (pn - 13) * 256 + wc * 32 + 8 * fq;
            f32x4 bv[2][2];
#pragma unroll
            for (int bj = 0; bj < 2; ++bj)
#pragma unroll
                for (int n = 0; n < 2; ++n) bv[bj][n] = *(const f32x4*)(b_gate + col0 + bj * HALF + 4 * n);
#pragma unroll
            for (int ai = 0; ai < 2; ++ai)
#pragma unroll
                for (int m = 0; m < 4; ++m) {
                    const int row = row0 + ai * HALF + m * 16; const float r = __builtin_amdgcn_rsqf(rss[row] * (1.f / 1024.f) + NEPS);
#pragma unroll
                    for (int bj = 0; bj < 2; ++bj) {
                        float o[8];
#pragma unroll
                        for (int n = 0; n < 2; ++n)
#pragma unroll
                            for (int e = 0; e < 4; ++e) o[4 * n + e] = sigmoid_f(acc[ai][bj][m][n][e] * r + bv[bj][n][e]);
                        u32x4 w; w.x = cvt_pk_bf16(o[0], o[1]); w.y = cvt_pk_bf16(o[2], o[3]); w.z = cvt_pk_bf16(o[4], o[5]); w.w = cvt_pk_bf16(o[6], o[7]);
                        *(u32x4*)(G + (size_t)row * 2048 + col0 + bj * HALF) = w;
                    }
                }
        }
    }
};
template <class Epi, class Sched, bool ALIGN_EPI = false, bool SP2 = false>
__device__ __forceinline__ void gemm_phase(PG8_LAS unsigned char* lds, const Gemm g, const Sched& S, const Epi& E) {
    int tid_o = threadIdx.x; asm volatile("" : "+v"(tid_o));
    const int tid = tid_o, wid = __builtin_amdgcn_readfirstlane(tid >> 6), lane = tid & 63, wr = wid >> 2, wc = wid & 3, fr = lane & 15, fq = lane >> 4;
    const int K = g.K, nt = K / BK;
    unsigned voffA[2], voffB[2];
#pragma unroll
    for (int i = 0; i < 2; ++i) { int R, C; stage_rc(tid * 16 + i * 8192, R, C); const int Rb = Epi::PERM ? ((R & ~31) + perm32(R & 31)) : R;
        voffA[i] = (unsigned)(R * K + C) * 2u; voffB[i] = (unsigned)(Rb * K + C) * 2u; }
    const size_t kstep = (size_t)(BK * 2);
    const size_t hstep = (size_t)HALF * K * 2;
    const size_t tstep = 2 * hstep;
    const unsigned ldsw = (unsigned)wid * 1024u;
    const int aoff = lds_byte(wr * 64 + fr, fq * 8), boff = lds_byte(wc * 32 + fr, fq * 8);
#define PG8_SA(b, h) (((b) * 2 + (h)) * HTB)
#define PG8_SB(b, h) ((4 + (b) * 2 + (h)) * HTB)
#define PG8_STAGE(bufoff, gbase, voff) do { _Pragma("unroll") for (int _i = 0; _i < 2; ++_i) \
        __builtin_amdgcn_global_load_lds((const unsigned*)((const char*)(gbase) + (voff)[_i]), (PG8_LAS unsigned*)(lds + (bufoff) + ldsw + _i * 8192), 16, 0, 0); } while (0)
#define PG8_LDA(dst, b, h) do { _Pragma("unroll") for (int m = 0; m < 4; ++m) _Pragma("unroll") for (int k = 0; k < 2; ++k) dst[m][k] = *(const PG8_LAS bf16x8*)(lds + PG8_SA(b, h) + aoff + m * 2048 + k * 1024); } while (0)
#define PG8_LDB(dst, b, h) do { _Pragma("unroll") for (int n = 0; n < 2; ++n) _Pragma("unroll") for (int k = 0; k < 2; ++k) dst[n][k] = *(const PG8_LAS bf16x8*)(lds + PG8_SB(b, h) + boff + n * 2048 + k * 1024); } while (0)
#define PG8_MMA(ai, bj, At, Bt) do { __builtin_amdgcn_s_setprio(1); _Pragma("unroll") for (int m = 0; m < 4; ++m) _Pragma("unroll") for (int n = 0; n < 2; ++n) _Pragma("unroll") for (int k = 0; k < 2; ++k) \
        acc[ai][bj][m][n] = __builtin_amdgcn_mfma_f32_16x16x32_bf16(Bt[n][k], At[m][k], acc[ai][bj][m][n], 0, 0, 0); __builtin_amdgcn_s_setprio(0); } while (0)
#define PG8_WAIT_V(n) asm volatile("s_waitcnt vmcnt(" #n ")" ::: "memory")
#define PG8_WAIT_L(n) asm volatile("s_waitcnt lgkmcnt(" #n ")" ::: "memory")
#define PG8_BAR __builtin_amdgcn_s_barrier()
#define PG8_SCHED __builtin_amdgcn_sched_barrier(0)
    Unit cur, nxt; int ui = 0;
    if (!S.next(0, cur)) return;
    f32x4 acc[2][2][4][2];
#pragma unroll
    for (int a = 0; a < 2; ++a)
#pragma unroll
        for (int b = 0; b < 2; ++b)
#pragma unroll
            for (int m = 0; m < 4; ++m)
#pragma unroll
                for (int n = 0; n < 2; ++n) acc[a][b][m][n] = (f32x4){0.f, 0.f, 0.f, 0.f};
    bf16x8 At[4][2], B0[2][2], B1[2][2];
    const char* cA = (const char*)g.A + (size_t)cur.pm * tstep; const char* cB = (const char*)g.Bt + (size_t)cur.pn * tstep;
    S.a_ready(cur);
    if constexpr (SP2) {
        PG8_STAGE(PG8_SB(0, 0), cB, voffB); PG8_STAGE(PG8_SB(0, 1), cB + hstep, voffB); PG8_STAGE(PG8_SA(0, 0), cA, voffA); PG8_STAGE(PG8_SA(0, 1), cA + hstep, voffA);
        if (wr == 1) PG8_BAR;
        PG8_WAIT_V(2); PG8_BAR;
        PG8_STAGE(PG8_SB(1, 0), cB + kstep, voffB); PG8_STAGE(PG8_SA(1, 0), cA + kstep, voffA); PG8_STAGE(PG8_SB(1, 1), cB + hstep + kstep, voffB);
        PG8_WAIT_V(6); PG8_BAR;
    } else {
        PG8_STAGE(PG8_SB(0, 0), cB, voffB); PG8_STAGE(PG8_SA(0, 0), cA, voffA); PG8_STAGE(PG8_SB(0, 1), cB + hstep, voffB); PG8_STAGE(PG8_SA(0, 1), cA + hstep, voffA);
        if (wr == 1) PG8_BAR;
        PG8_WAIT_V(4); PG8_BAR;
        PG8_STAGE(PG8_SB(1, 0), cB + kstep, voffB); PG8_STAGE(PG8_SA(1, 0), cA + kstep, voffA); PG8_STAGE(PG8_SB(1, 1), cB + hstep + kstep, voffB);
        PG8_WAIT_V(6); PG8_BAR;
    }
    for (;;) {
        const bool has_next = S.next(ui + 1, nxt);
        const char* nA = has_next ? (const char*)g.A + (size_t)nxt.pm * tstep : cA; const char* nB = has_next ? (const char*)g.Bt + (size_t)nxt.pn * tstep : cB;
        for (int t = 0; t < nt; t += 2) {
            const bool last = (t == nt - 2);
            const char* a1 = cA + (size_t)(t + 1) * kstep;
            const char* a2 = last ? nA : cA + (size_t)(t + 2) * kstep; const char* b2 = last ? nB : cB + (size_t)(t + 2) * kstep;
            const char* a3 = a2 + kstep; const char* b3 = b2 + kstep;
            if (last && has_next) S.a_ready(nxt);
            if constexpr (SP2) {
            PG8_LDB(B0, 0, 0); PG8_LDB(B1, 0, 1); PG8_SCHED; PG8_LDA(At, 0, 0); PG8_STAGE(PG8_SA(1, 1), a1 + hstep, voffA);
            PG8_WAIT_V(8); PG8_WAIT_L(0); PG8_BAR; PG8_MMA(0, 0, At, B0); PG8_MMA(0, 1, At, B1); PG8_BAR; PG8_SCHED;
            PG8_LDA(At, 0, 1); PG8_STAGE(PG8_SB(0, 0), b2, voffB); PG8_STAGE(PG8_SB(0, 1), b2 + hstep, voffB); PG8_STAGE(PG8_SA(0, 0), a2, voffA);
            PG8_WAIT_V(8); PG8_WAIT_L(0); PG8_BAR; PG8_MMA(1, 0, At, B0); PG8_MMA(1, 1, At, B1); PG8_BAR; PG8_SCHED;
            PG8_LDB(B0, 1, 0); PG8_LDB(B1, 1, 1); PG8_SCHED; PG8_LDA(At, 1, 0); PG8_STAGE(PG8_SA(0, 1), a2 + hstep, voffA);
            PG8_WAIT_V(8); PG8_WAIT_L(0); PG8_BAR; PG8_MMA(0, 0, At, B0); PG8_MMA(0, 1, At, B1); PG8_BAR; PG8_SCHED;
            PG8_LDA(At, 1, 1); PG8_STAGE(PG8_SB(1, 0), b3, voffB); PG8_STAGE(PG8_SB(1, 1), b3 + hstep, voffB); PG8_STAGE(PG8_SA(1, 0), a3, voffA);
            PG8_WAIT_V(8); PG8_WAIT_L(0); PG8_BAR; PG8_MMA(1, 0, At, B0); PG8_MMA(1, 1, At, B1); PG8_BAR; PG8_SCHED;
            } else {
            PG8_LDB(B0, 0, 0); PG8_SCHED; PG8_LDA(At, 0, 0); PG8_STAGE(PG8_SA(1, 1), a1 + hstep, voffA);
            PG8_WAIT_L(8); PG8_BAR; PG8_WAIT_L(0); PG8_MMA(0, 0, At, B0); PG8_BAR; PG8_SCHED;
            PG8_LDB(B1, 0, 1); PG8_STAGE(PG8_SB(0, 0), b2, voffB);
            PG8_BAR; PG8_WAIT_L(0); PG8_MMA(0, 1, At, B1); PG8_BAR;
            PG8_LDA(At, 0, 1); PG8_STAGE(PG8_SA(0, 0), a2, voffA);
            PG8_BAR; PG8_WAIT_L(0); PG8_MMA(1, 0, At, B0); PG8_BAR; PG8_SCHED;
            PG8_STAGE(PG8_SB(0, 1), b2 + hstep, voffB);
            PG8_WAIT_V(6); PG8_BAR; PG8_MMA(1, 1, At, B1); PG8_BAR;
            PG8_LDB(B0, 1, 0); PG8_SCHED; PG8_LDA(At, 1, 0); PG8_STAGE(PG8_SA(0, 1), a2 + hstep, voffA);
            PG8_WAIT_L(8); PG8_BAR; PG8_WAIT_L(0); PG8_MMA(0, 0, At, B0); PG8_BAR; PG8_SCHED;
            PG8_LDB(B1, 1, 1); PG8_STAGE(PG8_SB(1, 0), b3, voffB);
            PG8_BAR; PG8_WAIT_L(0); PG8_MMA(0, 1, At, B1); PG8_BAR;
            PG8_LDA(At, 1, 1); PG8_STAGE(PG8_SA(1, 0), a3, voffA);
            PG8_BAR; PG8_WAIT_L(0); PG8_MMA(1, 0, At, B0); PG8_BAR; PG8_SCHED;
            PG8_STAGE(PG8_SB(1, 1), b3 + hstep, voffB);
            PG8_WAIT_V(6); PG8_BAR; PG8_MMA(1, 1, At, B1); PG8_BAR;
            }
        }
        if constexpr (ALIGN_EPI) { if (wr == 0) PG8_BAR; }
        if constexpr (!Epi::AFTER_DRAIN) { E(acc, cur, wr, wc, fr, fq); S.done(cur); }
        if (!has_next) break;
#pragma unroll
        for (int a = 0; a < 2; ++a)
#pragma unroll
            for (int b = 0; b < 2; ++b)
#pragma unroll
                for (int m = 0; m < 4; ++m)
#pragma unroll
                    for (int n = 0; n < 2; ++n) acc[a][b][m][n] = (f32x4){0.f, 0.f, 0.f, 0.f};
        cur = nxt; cA = nA; cB = nB; ++ui;
        if constexpr (ALIGN_EPI) { if (wr == 1) PG8_BAR; }
    }
    PG8_WAIT_V(0);
    if constexpr (!ALIGN_EPI) { if (wr == 0) PG8_BAR; }
    PG8_BAR;
    if constexpr (Epi::AFTER_DRAIN) { E.fused(acc, cur, wr, wc, fr, fq, lds, wid, lane); S.done(cur); }
#undef PG8_SA
#undef PG8_SB
#undef PG8_STAGE
#undef PG8_LDA
#undef PG8_LDB
#undef PG8_MMA
#undef PG8_WAIT_V
#undef PG8_WAIT_L
#undef PG8_BAR
#undef PG8_SCHED
}
}

#ifndef MK_N_LAUNCHES
#define MK_N_LAUNCHES 1
#endif
constexpr int N_PHASES = 10;
constexpr int TP = 16384, TS = 512, T = TP + TS, D = 1024, FF = 2816, NIN = 5376;
#define GAS __attribute__((address_space(1)))
#define LAS __attribute__((address_space(3)))
typedef unsigned short bf16;
typedef float f32x4 __attribute__((ext_vector_type(4)));
typedef float f32x16 __attribute__((ext_vector_type(16)));
typedef short bf16x8 __attribute__((ext_vector_type(8)));
typedef unsigned v4u __attribute__((ext_vector_type(4)));
typedef unsigned v2u __attribute__((ext_vector_type(2)));

constexpr size_t al256(size_t x) { return (x + 255) & ~(size_t)255; }
constexpr size_t WS_BAR = 0, WS_CTL = 16384, WS_BAR_BYTES = 32768;
constexpr size_t WS_RSS0 = WS_BAR_BYTES, WS_RSS1 = WS_RSS0 + al256((size_t)T * 4), WS_RSS2 = WS_RSS1 + al256((size_t)T * 4);
constexpr size_t WS_ROT = WS_RSS2 + al256((size_t)T * 4);
constexpr size_t WS_QKN = WS_ROT + al256((size_t)4100 * 16 * 4);
constexpr size_t WS_W1 = WS_QKN + al256((size_t)1536 * 4);
constexpr size_t WS_W2 = WS_W1 + (size_t)2 * FF * D * 2;
constexpr size_t WS_W3 = WS_W2 + (size_t)D * FF * 2;
constexpr size_t WS_W4A = WS_W3 + (size_t)NIN * D * 2;
constexpr size_t WS_W4B = WS_W4A + (size_t)D * 512 * 2;
constexpr size_t WS_W5 = WS_W4B + (size_t)D * 256 * 2;
constexpr size_t WS_W6 = WS_W5 + (size_t)D * D * 2;
constexpr size_t WS_W7 = WS_W6 + (size_t)2 * FF * D * 2;
constexpr size_t WS_XB = WS_W7 + (size_t)D * FF * 2;
constexpr size_t WS_ACT = WS_XB + (size_t)T * D * 2;
constexpr size_t WS_X1 = WS_ACT + (size_t)T * FF * 2;
constexpr size_t WS_X1B = WS_X1 + (size_t)T * D * 4;
constexpr size_t WS_U = WS_X1B + (size_t)T * D * 2;
constexpr size_t WS_Q = WS_U + (size_t)T * 512 * 2;
constexpr size_t WS_K = WS_Q + (size_t)T * 768 * 2;
constexpr size_t WS_V = WS_K + (size_t)T * 768 * 2;
constexpr size_t WS_G = WS_V + (size_t)T * 768 * 2;
constexpr size_t WS_CONVF = WS_G + (size_t)T * 2048 * 2;
constexpr size_t WS_OG = WS_CONVF + (size_t)T * 512 * 2;
constexpr size_t WS_ML = WS_OG + (size_t)3 * T * 256 * 2;
constexpr size_t WS_BATT = WS_ML + (size_t)3 * T * 8 * 4;
constexpr size_t WS_TMP = WS_BATT + (size_t)T * 256 * 2;
constexpr size_t WS_MIX = WS_TMP + (size_t)T * D * 4;
constexpr size_t WS_X2 = WS_MIX + (size_t)T * D * 2;
constexpr size_t WS_X2B = WS_X2 + (size_t)T * D * 4;
constexpr size_t WS_END = WS_X2B + (size_t)T * D * 2;

constexpr size_t O_CP = 22806528, O_KS0 = 22867968, O_CS = 199028736;

constexpr int LDS_BYTES = 131072 + 1024;

__device__ __forceinline__ unsigned f2bf(float f) { unsigned u = __builtin_bit_cast(unsigned, f); return (u + 0x7fffu + ((u >> 16) & 1u)) >> 16; }
__device__ __forceinline__ unsigned pk2(float lo, float hi) { return f2bf(lo) | (f2bf(hi) << 16); }
__device__ __forceinline__ float bf2f_g(unsigned short h) { return __builtin_bit_cast(float, (unsigned)h << 16); }
__device__ __forceinline__ float bfl(unsigned w) { return __builtin_bit_cast(float, w << 16); }
__device__ __forceinline__ float bfh(unsigned w) { return __builtin_bit_cast(float, w & 0xffff0000u); }
__device__ __forceinline__ float wave_sum(float v) {
#pragma unroll
    for (int o = 1; o < 64; o <<= 1) v += __shfl_xor(v, o);
    return v;
}

struct Args { const float* in[27]; float* out; unsigned char* ws; int ph_lo, ph_hi; };

__device__ __forceinline__ int perm32(int rho) { const int n = rho >> 4, i = rho & 15; return 8 * (i >> 2) + 4 * n + (i & 3); }
template <int MAP> __device__ __forceinline__ int src_col(int nd) {
    if (MAP == 0) return (nd & ~31) + perm32(nd & 31);
    const int pn = nd >> 8, w = nd & 255, bj = w >> 7, rem = w & 127, wc = rem >> 5, slot = rem & 31;
    if (MAP == 1) return bj * FF + pn * 128 + wc * 32 + perm32(slot);
    if (pn < 4) return bj * 512 + pn * 128 + wc * 32 + perm32(slot);
    if (pn < 13) {
        int dim;
        if (pn < 10 && bj == 0) { const int fq = (slot & 15) >> 2, n = slot >> 4, e = slot & 3; dim = fq < 2 ? 4 * fq + 8 * n + e : 8 * fq + 4 * n + e; }
        else dim = 32 * bj + perm32(slot);
        return 1024 + (pn - 4) * 256 + wc * 64 + dim;
    }
    return 3328 + (pn - 13) * 256 + bj * 128 + wc * 32 + perm32(slot);
}
template <int MAP> __device__ __forceinline__ void p0_transpose_item(const float* W, int K, int Ns, int Nd, bf16* WT, const float* gain, LAS float* scr, int item, int lane) {
    const int nblk = Nd / 32, kb = item / nblk, nb = item % nblk, k0 = 64 * kb, n0 = 32 * nb;
    const int sc = src_col<MAP>(n0 + (lane & 31));
    float tv[32];
#pragma unroll
    for (int i = 0; i < 32; ++i) { const int kk = 2 * i + (lane >> 5); tv[i] = __builtin_nontemporal_load(W + (size_t)(k0 + kk) * Ns + sc); }
    if (gain) {
#pragma unroll
        for (int i = 0; i < 32; ++i) tv[i] *= gain[k0 + 2 * i + (lane >> 5)]; }
#pragma unroll
    for (int i = 0; i < 32; ++i) scr[(2 * i + (lane >> 5)) * 33 + (lane & 31)] = tv[i];
    asm volatile("s_waitcnt lgkmcnt(0)" ::: "memory");
    const int c = lane & 7;
#pragma unroll
    for (int j = 0; j < 4; ++j) { const int n = (lane >> 3) + 8 * j; const LAS float* s = scr + (8 * c) * 33 + n;
        v4u o; o.x = pk2(s[0 * 33], s[1 * 33]); o.y = pk2(s[2 * 33], s[3 * 33]); o.z = pk2(s[4 * 33], s[5 * 33]); o.w = pk2(s[6 * 33], s[7 * 33]);
        *(v4u*)(WT + (size_t)(n0 + n) * K + k0 + 8 * c) = o; }
    asm volatile("s_waitcnt lgkmcnt(0)" ::: "memory");
}
constexpr int N_CHUNKS = 5376 + 128;
struct ChunkD { const f32x4* s4; f32x4* d4; int n4; };
__device__ __forceinline__ ChunkD chunk_desc(const Args& a, int id) {
    const float* src; float* dst; int nrows;
    if (id < 5376) {
        int g, r;
        if (id < 256) { g = 0; r = id; } else if (id < 1280) { g = 1; r = id - 256; } else { g = 2; r = id - 1280; }
        const int W = 128 << (2 * g), cpb = 1 << (2 * g);
        const int kv = r / (128 * cpb), r2 = r % (128 * cpb), b = r2 / cpb, ch = r2 % cpb, row0 = ch * 128;
        nrows = (W - 4 - row0) < 128 ? (W - 4 - row0) : 128;
        size_t oks = O_KS0; for (int gg = 0; gg < g; ++gg) oks += (size_t)2 * 128 * (128 << (2 * gg)) * 256;
        oks += (size_t)kv * 128 * W * 256;
        src = a.in[2 + 2 * g + kv] + ((size_t)b * W + 4 + row0) * 256; dst = a.out + oks + ((size_t)b * W + row0) * 256;
    } else { const int b = id - 5376; src = a.in[8] + ((size_t)b * 30 + 4) * 512; dst = a.out + O_CS + (size_t)b * 30 * 512; nrows = 52; }
    ChunkD d; d.s4 = (const f32x4*)src; d.d4 = (f32x4*)dst; d.n4 = nrows * 64; return d;
}
__device__ __forceinline__ void copy_chunk(const Args& a, int id, int tid) {
    const ChunkD c0 = chunk_desc(a, id);
    f32x4 v0[16];
#pragma unroll
    for (int k = 0; k < 16; ++k) { const int i = tid + 512 * k; if (i < c0.n4) v0[k] = __builtin_nontemporal_load(c0.s4 + i); }
#pragma unroll
    for (int k = 0; k < 16; ++k) { const int i = tid + 512 * k; if (i < c0.n4) __builtin_nontemporal_store(v0[k], c0.d4 + i); }
}
__device__ __forceinline__ void filler(const Args& a, unsigned* ctl, int phase, unsigned my_units, unsigned total_units, volatile LAS unsigned* misc, int tid) {
    unsigned* done = ctl + 64 * (1 + phase);
    if (tid == 0) { if (total_units) __hip_atomic_fetch_add(done, my_units, __ATOMIC_RELAXED, __HIP_MEMORY_SCOPE_AGENT);
        unsigned id = N_CHUNKS;
        if (!total_units || __hip_atomic_load(done, __ATOMIC_RELAXED, __HIP_MEMORY_SCOPE_AGENT) < total_units) id = __hip_atomic_fetch_add(ctl, 1u, __ATOMIC_RELAXED, __HIP_MEMORY_SCOPE_AGENT);
        misc[16] = id; }
    __syncthreads();
    unsigned id = (unsigned)__builtin_amdgcn_readfirstlane((int)misc[16]);
    for (int it = 1; id < (unsigned)N_CHUNKS; ++it) {
        unsigned nxt = N_CHUNKS;
        if (tid == 0) { if (!total_units || __hip_atomic_load(done, __ATOMIC_RELAXED, __HIP_MEMORY_SCOPE_AGENT) < total_units) nxt = __hip_atomic_fetch_add(ctl, 1u, __ATOMIC_RELAXED, __HIP_MEMORY_SCOPE_AGENT); }
        copy_chunk(a, (int)id, tid);
        if (tid == 0) misc[16 + (it & 1)] = nxt;
        __syncthreads();
        id = (unsigned)__builtin_amdgcn_readfirstlane((int)misc[16 + (it & 1)]);
    }
}
__device__ __forceinline__ unsigned grab(unsigned* ctr, volatile LAS unsigned* misc, int& it, int tid) {
    if (tid == 0) misc[20 + (it & 1)] = __hip_atomic_fetch_add(ctr, 1u, __ATOMIC_RELAXED, __HIP_MEMORY_SCOPE_AGENT);
    __syncthreads();
    const unsigned v = (unsigned)__builtin_amdgcn_readfirstlane((int)misc[20 + (it & 1)]); ++it; return v;
}
__device__ __forceinline__ void copy_quota(const Args& a, unsigned* ctl, int quota, volatile LAS unsigned* misc, int tid) {
    for (int k = 0; k < quota; ++k) {
        if (tid == 0) misc[24 + (k & 1)] = __hip_atomic_fetch_add(ctl, 1u, __ATOMIC_RELAXED, __HIP_MEMORY_SCOPE_AGENT);
        __syncthreads();
        const unsigned id = (unsigned)__builtin_amdgcn_readfirstlane((int)misc[24 + (k & 1)]);
        if (id >= (unsigned)N_CHUNKS) break;
        copy_chunk(a, (int)id, tid);
    }
}
__device__ __forceinline__ unsigned units_of(int nwg, int G, int c) { return (c >= 0 && c < G && c < nwg) ? (unsigned)((nwg - c + G - 1) / G) : 0u; }

__device__ __forceinline__ void p0_prologue(const Args& a, LAS unsigned char* lds, int G, int bid, int tid) {
    const int wave = tid >> 6, lane = tid & 63;
    LAS float* scr = (LAS float*)(lds + wave * 16384);
    const int gw = bid * 8 + wave, NGW = G * 8;
    unsigned char* ws = a.ws;
    constexpr int I_IN = (D / 64) * (2 * FF / 32), I_OUT = (FF / 64) * (D / 32), I_3 = (D / 64) * (NIN / 32), I_4A = (512 / 64) * (D / 32), I_4B = (256 / 64) * (D / 32), I_5 = (D / 64) * (D / 32);
    constexpr int NITEMS = 2 * I_IN + 2 * I_OUT + I_3 + I_4A + I_4B + I_5;
    for (int it = gw; it < NITEMS; it += NGW) {
        int r = it;
        if (r < I_IN) { p0_transpose_item<1>(a.in[10], D, 2 * FF, 2 * FF, (bf16*)(ws + WS_W1), a.in[9], scr, r, lane); continue; } r -= I_IN;
        if (r < I_IN) { p0_transpose_item<1>(a.in[25], D, 2 * FF, 2 * FF, (bf16*)(ws + WS_W6), a.in[24], scr, r, lane); continue; } r -= I_IN;
        if (r < I_OUT) { p0_transpose_item<0>(a.in[11], FF, D, D, (bf16*)(ws + WS_W2), nullptr, scr, r, lane); continue; } r -= I_OUT;
        if (r < I_OUT) { p0_transpose_item<0>(a.in[26], FF, D, D, (bf16*)(ws + WS_W7), nullptr, scr, r, lane); continue; } r -= I_OUT;
        if (r < I_3) { p0_transpose_item<2>(a.in[13], D, NIN, NIN, (bf16*)(ws + WS_W3), a.in[12], scr, r, lane); continue; } r -= I_3;
        if (r < I_4A) { p0_transpose_item<0>(a.in[21], 512, D, D, (bf16*)(ws + WS_W4A), nullptr, scr, r, lane); continue; } r -= I_4A;
        if (r < I_4B) { p0_transpose_item<0>(a.in[22], 256, D, D, (bf16*)(ws + WS_W4B), nullptr, scr, r, lane); continue; } r -= I_4B;
        p0_transpose_item<0>(a.in[23], D, D, D, (bf16*)(ws + WS_W5), nullptr, scr, r, lane);
    }
    float* rss0 = (float*)(ws + WS_RSS0); float* rss1 = (float*)(ws + WS_RSS1); float* rss2 = (float*)(ws + WS_RSS2);
    bf16* XB = (bf16*)(ws + WS_XB);
    for (int m0 = gw; m0 < T; m0 += 2 * NGW) {
        f32x4 v[2][4]; float ssq[2];
#pragma unroll
        for (int u = 0; u < 2; ++u) { const int m = m0 + u * NGW; if (m < T) { const float* xr = (m < TP) ? a.in[0] + (size_t)m * D : a.in[1] + (size_t)(m - TP) * D; const f32x4* x4 = (const f32x4*)xr + lane;
#pragma unroll
            for (int j = 0; j < 4; ++j) v[u][j] = __builtin_nontemporal_load(x4 + 64 * j); } }
#pragma unroll
        for (int u = 0; u < 2; ++u) { const int m = m0 + u * NGW; if (m < T) { float sq = 0.f;
#pragma unroll
            for (int j = 0; j < 4; ++j) sq += (v[u][j][0] * v[u][j][0] + v[u][j][1] * v[u][j][1]) + (v[u][j][2] * v[u][j][2] + v[u][j][3] * v[u][j][3]);
            ssq[u] = wave_sum(sq);
            if (lane == 0) { rss0[m] = ssq[u]; rss1[m] = 0.f; rss2[m] = 0.f; }
            v2u* o8 = (v2u*)(XB + (size_t)m * D) + lane;
#pragma unroll
            for (int j = 0; j < 4; ++j) { v2u w; w.x = pk2(v[u][j][0], v[u][j][1]); w.y = pk2(v[u][j][2], v[u][j][3]); o8[64 * j] = w; } } }
    }
    const size_t gtid = (size_t)bid * 512 + tid, nthr = (size_t)G * 512;
    float* rot = (float*)(ws + WS_ROT);
    for (size_t i = gtid; i < (size_t)4100 * 8; i += nthr) {
        const int p = (int)(i >> 3), f = (int)(i & 7); const int pos = p < 4096 ? p : 2048 + (p - 4096);
        const double inv = exp2(-(double)f * (18.931568569324174 / 8.0));
        const double rev = (double)pos * inv * 0.15915494309189535;
        const double fr = rev - rint(rev);
        const float ang = (float)(fr * 6.283185307179586);
        rot[(size_t)p * 16 + f] = __builtin_amdgcn_cosf((float)fr); rot[(size_t)p * 16 + 8 + f] = __builtin_amdgcn_sinf((float)fr); (void)ang;
    }
    { float* qkn = (float*)(ws + WS_QKN); for (size_t i = gtid; i < 1536; i += nthr) qkn[i] = i < 768 ? a.in[15][i] : a.in[16][i - 768]; }
}

__device__ __forceinline__ int crow(int r, int hi) { return (r & 3) + 8 * (r >> 2) + 4 * hi; }
constexpr int KS_STRIDE = 144, VT_OFF = 384 * KS_STRIDE, VT_STRIDE = 776;
struct AttnU { int b, g, h, d, r, i0, hc; };
__device__ __forceinline__ AttnU attn_decode(int unit) {
    AttnU u; u.b = unit / 192; int rem = unit % 192; u.g = rem / 64; rem %= 64; u.h = rem / 16; const int x = rem % 16;
    const int dsh = 2 * u.g, nblk = 16 >> dsh; u.d = 1 << dsh; u.r = x / nblk; u.i0 = (x % nblk) * 256; u.hc = (4 * u.g + u.h) * 64; return u;
}
__device__ __forceinline__ void attn_load(const AttnU& u, const bf16* Kb, const bf16* Vb, int tid, v4u (&kv)[6], v4u (&vv)[6]) {
#pragma unroll
    for (int k = 0; k < 6; ++k) { const int q = tid + 512 * k, s = q >> 3, c = q & 7, i = u.i0 - 128 + s;
        if (i >= 0) { const size_t off = ((size_t)u.b * 4096 + (size_t)i * u.d + u.r) * 768 + u.hc + 8 * c; kv[k] = *(const v4u*)(Kb + off); vv[k] = *(const v4u*)(Vb + off); }
        else { kv[k] = (v4u){0u, 0u, 0u, 0u}; vv[k] = (v4u){0u, 0u, 0u, 0u}; } }
}
__device__ __forceinline__ void attn_write(LAS unsigned char* lds, int tid, const v4u (&kv)[6], const v4u (&vv)[6]) {
#pragma unroll
    for (int k = 0; k < 6; ++k) { const int q = tid + 512 * k, s = q >> 3, c = q & 7;
        *(LAS v4u*)(lds + s * KS_STRIDE + 16 * c) = kv[k];
#pragma unroll
        for (int e = 0; e < 4; ++e) { const unsigned w = vv[k][e];
            *(LAS unsigned short*)(lds + VT_OFF + (8 * c + 2 * e) * VT_STRIDE + s * 2) = (unsigned short)(w & 0xffffu);
            *(LAS unsigned short*)(lds + VT_OFF + (8 * c + 2 * e + 1) * VT_STRIDE + s * 2) = (unsigned short)(w >> 16); } }
}
__device__ __forceinline__ void attn_qload(const AttnU& u, const bf16* Q, int tid, bf16x8 (&qf)[4]) {
    const int w = tid >> 6, lane = tid & 63, ql = lane & 31, hi = lane >> 5;
    const size_t qrow = (size_t)u.b * 4096 + (size_t)(u.i0 + 32 * w + ql) * u.d + u.r;
#pragma unroll
    for (int kk = 0; kk < 4; ++kk) qf[kk] = *(const bf16x8*)(Q + qrow * 768 + u.hc + 16 * kk + 8 * hi);
}
__device__ __forceinline__ void attn_compute(LAS unsigned char* lds, const AttnU& u, const bf16x8 (&qf)[4], bf16* OG, float* ML, int tid) {
    const int w = tid >> 6, lane = tid & 63, ql = lane & 31, hi = lane >> 5;
    const size_t qrow = (size_t)u.b * 4096 + (size_t)(u.i0 + 32 * w + ql) * u.d + u.r;
    f32x16 S[5];
#pragma unroll
    for (int j = 0; j < 5; ++j) {
#pragma unroll
        for (int e = 0; e < 16; ++e) S[j][e] = 0.f;
#pragma unroll
        for (int kk = 0; kk < 4; ++kk) { const bf16x8 af = *(const LAS bf16x8*)(lds + (32 * (w + j) + ql) * KS_STRIDE + (16 * kk + 8 * hi) * 2);
            S[j] = __builtin_amdgcn_mfma_f32_32x32x16_bf16(af, qf[kk], S[j], 0, 0, 0); }
    }
    const bool first = (u.i0 == 0);
#pragma unroll
    for (int e = 0; e < 16; ++e) { const int kl = crow(e, hi); if (kl < ql) S[0][e] = -INFINITY; if (kl > ql) S[4][e] = -INFINITY; }
#pragma unroll
    for (int j = 0; j < 4; ++j) if (first && (w + j < 4)) {
#pragma unroll
        for (int e = 0; e < 16; ++e) S[j][e] = -INFINITY; }
    float mx = -INFINITY;
#pragma unroll
    for (int j = 0; j < 5; ++j)
#pragma unroll
        for (int e = 0; e < 16; ++e) mx = fmaxf(mx, S[j][e]);
    mx = fmaxf(mx, __shfl_xor(mx, 32));
    float l = 0.f;
#pragma unroll
    for (int j = 0; j < 5; ++j)
#pragma unroll
        for (int e = 0; e < 16; ++e) { const float p = __builtin_amdgcn_exp2f(S[j][e] - mx); S[j][e] = p; l += p; }
    l += __shfl_xor(l, 32);
    f32x16 O[2];
#pragma unroll
    for (int e = 0; e < 16; ++e) { O[0][e] = 0.f; O[1][e] = 0.f; }
#pragma unroll
    for (int j = 0; j < 5; ++j)
#pragma unroll
        for (int c = 0; c < 2; ++c) {
            v4u pw; pw.x = pg8::cvt_pk_bf16(S[j][8 * c + 0], S[j][8 * c + 1]); pw.y = pg8::cvt_pk_bf16(S[j][8 * c + 2], S[j][8 * c + 3]); pw.z = pg8::cvt_pk_bf16(S[j][8 * c + 4], S[j][8 * c + 5]); pw.w = pg8::cvt_pk_bf16(S[j][8 * c + 6], S[j][8 * c + 7]);
            const bf16x8 pf = __builtin_bit_cast(bf16x8, pw);
            const int s0 = 32 * (w + j) + 16 * c + 4 * hi;
#pragma unroll
            for (int dt = 0; dt < 2; ++dt) { const int dim = 32 * dt + ql;
                const v2u lo = *(const LAS v2u*)(lds + VT_OFF + dim * VT_STRIDE + s0 * 2), hh = *(const LAS v2u*)(lds + VT_OFF + dim * VT_STRIDE + (s0 + 8) * 2);
                v4u vw; vw.x = lo.x; vw.y = lo.y; vw.z = hh.x; vw.w = hh.y;
                O[dt] = __builtin_amdgcn_mfma_f32_32x32x16_bf16(__builtin_bit_cast(bf16x8, vw), pf, O[dt], 0, 0, 0); }
        }
    const float inv = 1.f / l;
    bf16* og = OG + ((size_t)u.g * T + qrow) * 256 + u.h * 64;
#pragma unroll
    for (int dt = 0; dt < 2; ++dt)
#pragma unroll
        for (int q4 = 0; q4 < 4; ++q4) { v2u w2; w2.x = pg8::cvt_pk_bf16(O[dt][4 * q4] * inv, O[dt][4 * q4 + 1] * inv); w2.y = pg8::cvt_pk_bf16(O[dt][4 * q4 + 2] * inv, O[dt][4 * q4 + 3] * inv);
            *(v2u*)(og + 32 * dt + 8 * q4 + 4 * hi) = w2; }
    if (hi == 0) { float* ml = ML + (((size_t)u.g * T + qrow) * 4 + u.h) * 2; ml[0] = mx; ml[1] = l; }
}

__device__ __forceinline__ void attn_sample_g12(const Args& a, LAS unsigned char* lds, const bf16* Q, const bf16* Kb, const bf16* Vb, bf16* OG, float* ML, int b, int g, int tid) {
    const int w = tid >> 6, lane = tid & 63, s = w >> 1, half = w & 1;
    const int W = 128 << (2 * g), d = 1 << (2 * g);
    const char* ck = (const char*)(a.in[2 + 2 * g] + (size_t)b * W * 256); const char* cv = (const char*)(a.in[3 + 2 * g] + (size_t)b * W * 256); const unsigned voff = (unsigned)lane * 16u;
    const size_t row = (size_t)TP + b * 4 + s; const int head = lane >> 4, dl = (lane & 15) * 4;
    const int hcol = (4 * g + head) * 64 + dl;
    float q[4]; { const v2u qw = *(const v2u*)(Q + row * 768 + hcol); q[0] = bfl(qw.x); q[1] = bfh(qw.x); q[2] = bfl(qw.y); q[3] = bfh(qw.y); }
    float m = -INFINITY, l = 0.f, o[4] = {0.f, 0.f, 0.f, 0.f};
    const int jbeg = half * 65, jend = half ? 129 : 65;
#pragma unroll 1
    for (int j0 = jbeg; j0 < jend; j0 += 16) {
        f32x4 kk[16], vv[16];
#pragma unroll
        for (int jj = 0; jj < 16; ++jj) { const int j = j0 + jj; int idx = W + s - d * j; if (j >= jend) idx = 0;
            if (idx >= W) { const size_t r2 = (size_t)TP + b * 4 + (idx - W); const v2u kw = *(const v2u*)(Kb + r2 * 768 + hcol), vw = *(const v2u*)(Vb + r2 * 768 + hcol);
                kk[jj] = (f32x4){bfl(kw.x), bfh(kw.x), bfl(kw.y), bfh(kw.y)}; vv[jj] = (f32x4){bfl(vw.x), bfh(vw.x), bfl(vw.y), bfh(vw.y)}; }
            else { const int ui = __builtin_amdgcn_readfirstlane(idx); kk[jj] = __builtin_nontemporal_load((const f32x4*)(ck + (size_t)ui * 1024 + voff)); vv[jj] = __builtin_nontemporal_load((const f32x4*)(cv + (size_t)ui * 1024 + voff)); } }
        float sc[16]; float cm = -INFINITY;
#pragma unroll
        for (int jj = 0; jj < 16; ++jj) { float t = (kk[jj][0] * q[0] + kk[jj][1] * q[1]) + (kk[jj][2] * q[2] + kk[jj][3] * q[3]);
            t += __shfl_xor(t, 1); t += __shfl_xor(t, 2); t += __shfl_xor(t, 4); t += __shfl_xor(t, 8);
            sc[jj] = (j0 + jj < jend) ? t : -INFINITY; cm = fmaxf(cm, sc[jj]); }
        const float mn = fmaxf(m, cm), scale = __builtin_amdgcn_exp2f(m - mn);
        l *= scale; o[0] *= scale; o[1] *= scale; o[2] *= scale; o[3] *= scale;
#pragma unroll
        for (int jj = 0; jj < 16; ++jj) { const float p = __builtin_amdgcn_exp2f(sc[jj] - mn); l += p; o[0] += p * vv[jj][0]; o[1] += p * vv[jj][1]; o[2] += p * vv[jj][2]; o[3] += p * vv[jj][3]; }
        m = mn;
    }
    LAS float* P = (LAS float*)lds;
    if (half) { LAS float* pp = P + (w * 64 + lane) * 6; pp[0] = m; pp[1] = l; pp[2] = o[0]; pp[3] = o[1]; pp[4] = o[2]; pp[5] = o[3]; }
    __syncthreads();
    if (!half) { const LAS float* pp = P + ((w + 1) * 64 + lane) * 6; const float m1 = pp[0], l1 = pp[1];
        const float M = fmaxf(m, m1), a0 = __builtin_amdgcn_exp2f(m - M), a1 = __builtin_amdgcn_exp2f(m1 - M);
        const float lt = a0 * l + a1 * l1, inv = 1.f / lt;
        v2u w2; w2.x = pk2((a0 * o[0] + a1 * pp[2]) * inv, (a0 * o[1] + a1 * pp[3]) * inv); w2.y = pk2((a0 * o[2] + a1 * pp[4]) * inv, (a0 * o[3] + a1 * pp[5]) * inv);
        *(v2u*)(OG + ((size_t)g * T + row) * 256 + head * 64 + dl) = w2;
        if ((lane & 15) == 0) { float* ml = ML + (((size_t)g * T + row) * 4 + head) * 2; ml[0] = M; ml[1] = lt; } }
}
template <int NTOK, bool SAMPLE> __device__ __forceinline__ void conv_unit(const Args& a, LAS unsigned char* lds, const bf16* U, bf16* CONVF, const float (&cw)[31], int unit, int tid) {
    const int c = tid; float win[NTOK + 30];
    size_t row0; const unsigned vo2 = (unsigned)c * 2u, vo4 = (unsigned)c * 4u;
    if (!SAMPLE) { row0 = (size_t)unit * NTOK; const int t0 = (int)(row0 & 4095); const char* ub = (const char*)(U + row0 * 512);
#pragma unroll
        for (int jr = 0; jr < NTOK + 30; ++jr) { const int t = t0 - 30 + jr; win[jr] = (t >= 0) ? bf2f_g(*(const unsigned short*)(ub + (jr - 30) * 1024 + vo2)) : 0.f; } }
    else { row0 = (size_t)TP + (size_t)unit * 4; const char* st = (const char*)(a.in[8] + (size_t)unit * 30 * 512); const char* ub = (const char*)(U + row0 * 512);
#pragma unroll
        for (int jr = 0; jr < 30; ++jr) win[jr] = *(const float*)(st + jr * 2048 + vo4);
#pragma unroll
        for (int jr = 0; jr < NTOK; ++jr) win[30 + jr] = bf2f_g(*(const unsigned short*)(ub + jr * 1024 + vo2)); }
    const float cb = *(const float*)((const char*)a.in[18] + vo4);
    LAS float* yb = (LAS float*)lds;
    __syncthreads();
#pragma unroll
    for (int t = 0; t < NTOK; ++t) { float y = cb;
#pragma unroll
        for (int j = 0; j < 31; ++j) y += cw[j] * win[t + j];
        yb[t * 512 + c] = y; }
    __syncthreads();
    const int w = tid >> 6, lane = tid & 63;
    constexpr int TPW = (NTOK + 7) / 8;
#pragma unroll
    for (int tt = 0; tt < TPW; ++tt) { const int t = w * TPW + tt;
        if (t < NTOK) {
            float y[8]; float s = 0.f;
#pragma unroll
            for (int i = 0; i < 8; ++i) { y[i] = yb[t * 512 + lane + 64 * i]; s += y[i]; }
            const float mu = wave_sum(s) * (1.f / 512.f); float q = 0.f;
#pragma unroll
            for (int i = 0; i < 8; ++i) { y[i] -= mu; q += y[i] * y[i]; }
            const float rstd = __builtin_amdgcn_rsqf(wave_sum(q) * (1.f / 512.f) + 1e-6f);
#pragma unroll
            for (int i = 0; i < 8; ++i) { const int cc = lane + 64 * i; const float z = y[i] * rstd * *(const float*)((const char*)a.in[19] + i * 256 + (unsigned)lane * 4u) + *(const float*)((const char*)a.in[20] + i * 256 + (unsigned)lane * 4u);
                const float sw = z * __builtin_amdgcn_rcpf(1.f + __builtin_amdgcn_exp2f(-1.4426950408889634f * z));
                CONVF[(row0 + t) * 512 + cc] = (bf16)f2bf(sw); }
        }
    }
}

__device__ __forceinline__ void combine_groups(const bf16* OG, const float* ML, bf16* BATT, size_t row_lo, size_t row_hi, size_t gtid, size_t nthr) {
    for (size_t i = row_lo * 32 + gtid; i < row_hi * 32; i += nthr) {
        const size_t row = i >> 5; const int c8 = (int)(i & 31), h = c8 >> 3;
        float mg[3], lg[3]; v4u og[3];
#pragma unroll
        for (int g = 0; g < 3; ++g) { const float* ml = ML + (((size_t)g * T + row) * 4 + h) * 2; mg[g] = ml[0]; lg[g] = ml[1]; og[g] = *(const v4u*)(OG + ((size_t)g * T + row) * 256 + c8 * 8); }
        const float M = fmaxf(mg[0], fmaxf(mg[1], mg[2]));
        float wg[3], ws = 0.f;
#pragma unroll
        for (int g = 0; g < 3; ++g) { wg[g] = __builtin_amdgcn_exp2f(mg[g] - M) * lg[g]; ws += wg[g]; }
        const float inv = 1.f / ws; float o[8];
#pragma unroll
        for (int e = 0; e < 8; ++e) o[e] = 0.f;
#pragma unroll
        for (int g = 0; g < 3; ++g) { const float wn = wg[g] * inv;
#pragma unroll
            for (int e = 0; e < 4; ++e) { o[2 * e] += wn * bfl(og[g][e]); o[2 * e + 1] += wn * bfh(og[g][e]); } }
        v4u w; w.x = pk2(o[0], o[1]); w.y = pk2(o[2], o[3]); w.z = pk2(o[4], o[5]); w.w = pk2(o[6], o[7]);
        *(v4u*)(BATT + row * 256 + c8 * 8) = w;
    }
}

__device__ __forceinline__ void subseam(unsigned* cnt, unsigned n, bool produce, int tid) {
    if (produce) { __threadfence(); __syncthreads(); if (tid == 0) __hip_atomic_fetch_add(cnt, 1u, __ATOMIC_RELEASE, __HIP_MEMORY_SCOPE_AGENT); }
    if (tid == 0) { unsigned sp = 0; while (__hip_atomic_load(cnt, __ATOMIC_ACQUIRE, __HIP_MEMORY_SCOPE_AGENT) < n) { __builtin_amdgcn_s_sleep(8); if (++sp > (1u << 22)) break; } }
    __syncthreads(); __threadfence();
}
#define XB_TMO      128
#define XB_XCNT(j)  (256  + 64 * (j))
#define XB_XSUB(j)  (1280 + 64 * (j))
#define XB_XGEN(j)  (2304 + 64 * (j))
#define XB_TOP      3328
#define XB_TOPGEN   3392
#define XCD_BAR_WORDS 3456
#define XB_SPIN_CAP (1u << 18)

__device__ __forceinline__ unsigned xb_ld(unsigned* p)              { return __hip_atomic_load(p, __ATOMIC_RELAXED, __HIP_MEMORY_SCOPE_AGENT); }
__device__ __forceinline__ unsigned xb_add(unsigned* p, unsigned v) { return __hip_atomic_fetch_add(p, v, __ATOMIC_RELAXED, __HIP_MEMORY_SCOPE_AGENT); }
__device__ __forceinline__ unsigned xb_xcc_id() { return (unsigned)__builtin_amdgcn_s_getreg((3 << 11) | 20) & 0xFu; }
#define XB_SPIN(cond, bar) do { unsigned _sp = 0; while (cond) { __builtin_amdgcn_s_sleep(1); \
    if ((++_sp & 255u) == 0u) { if (xb_ld(&(bar)[XB_TMO])) break; if (_sp > XB_SPIN_CAP) { atomicAdd(&(bar)[XB_TMO], 1u); break; } } } } while (0)

struct XcdBarrier {
    unsigned* bar; unsigned x;
    volatile LAS unsigned* st;
};

__device__ __forceinline__ XcdBarrier xcd_barrier_post(unsigned* bar, volatile LAS unsigned* st) {
    XcdBarrier b; b.bar = bar; b.x = xb_xcc_id(); b.st = st;
    if (threadIdx.x == 0) (void)xb_add(&bar[XB_XCNT(b.x)], 1u);
    return b;
}
__device__ __forceinline__ void xcd_barrier_complete(unsigned* bar, unsigned x, unsigned& nloc, unsigned& nx) {
    const unsigned G = gridDim.x * gridDim.y * gridDim.z;
    unsigned sum, cnt, mine, sp = 0u;
    for (;;) {
        sum = 0u; cnt = 0u; mine = 0u;
#pragma unroll
        for (unsigned j = 0; j < 16; ++j) { const unsigned c = xb_ld(&bar[XB_XCNT(j)]); sum += c; cnt += (c > 0u) ? 1u : 0u; mine = (j == x) ? c : mine; }
        if (sum == G) break;
        __builtin_amdgcn_s_sleep(1);
        if ((++sp & 255u) == 0u) { if (xb_ld(&bar[XB_TMO])) break; if (sp > XB_SPIN_CAP) { atomicAdd(&bar[XB_TMO], 1u); break; } }
    }
    nloc = mine > 0u ? mine : 1u; nx = cnt > 0u ? cnt : 1u;
}

__device__ __forceinline__ void xcd_barrier(const XcdBarrier& b) {
    asm volatile("s_waitcnt vmcnt(0)" ::: "memory");
    __syncthreads();
    if (threadIdx.x == 0) {
        unsigned* bar = b.bar;
        __builtin_amdgcn_s_waitcnt(0);
        unsigned nloc = b.st[0], nx = b.st[1];
        if (nloc == 0u) { xcd_barrier_complete(bar, b.x, nloc, nx); b.st[0] = nloc; b.st[1] = nx; }
        const unsigned old = xb_add(&bar[XB_XSUB(b.x)], 1u);
        const unsigned gen = old / nloc;
        if (old + 1u == (gen + 1u) * nloc) {
            __builtin_amdgcn_fence(__ATOMIC_RELEASE, "agent");
            asm volatile("s_waitcnt vmcnt(0)" ::: "memory");
            const unsigned og = xb_add(&bar[XB_TOP], 1u);
            const unsigned tg = og / nx;
            if (og + 1u == (tg + 1u) * nx) xb_add(&bar[XB_TOPGEN], 1u);
            else XB_SPIN(xb_ld(&bar[XB_TOPGEN]) == tg, bar);
            __builtin_amdgcn_fence(__ATOMIC_ACQUIRE, "agent");
            xb_add(&bar[XB_XGEN(b.x)], 1u);
            asm volatile("s_waitcnt vmcnt(0)" ::: "memory");
        } else {
            XB_SPIN(xb_ld(&bar[XB_XGEN(b.x)]) == gen, bar);
            __builtin_amdgcn_fence(__ATOMIC_ACQUIRE, "agent");
            asm volatile("s_waitcnt vmcnt(0)" ::: "memory");
        }
    }
    __syncthreads();
}
__global__ void __launch_bounds__(512, 2) mk_fwd(Args args) {
    extern __shared__ __attribute__((aligned(16))) unsigned char lds_raw[];
    LAS unsigned char* lds = (LAS unsigned char*)lds_raw;
    const int tid = threadIdx.x, G = gridDim.x, bid = blockIdx.x;
    unsigned char* ws = args.ws;
    const int lo = args.ph_lo, hi = args.ph_hi;
#define IN(k) (lo <= (k) && (k) < hi)
#define SEAM(k) do { if (IN(k) && IN((k) + 1)) { xcd_barrier(bar); } } while (0)
    volatile LAS unsigned* MISC = (volatile LAS unsigned*)(lds + 131072);
    if (tid < 64) MISC[tid] = 0u;
    __syncthreads();
    unsigned* fctl = (unsigned*)(ws + WS_CTL);
    XcdBarrier bar; bar.bar = (unsigned*)(ws + WS_BAR); bar.x = 0; bar.st = nullptr;
    if (hi - lo > 1) bar = xcd_barrier_post((unsigned*)(ws + WS_BAR), MISC + 8);
    float* rss0 = (float*)(ws + WS_RSS0); float* rss1 = (float*)(ws + WS_RSS1); float* rss2 = (float*)(ws + WS_RSS2);
    bf16* XB = (bf16*)(ws + WS_XB); bf16* ACT = (bf16*)(ws + WS_ACT); float* X1 = (float*)(ws + WS_X1); bf16* X1B = (bf16*)(ws + WS_X1B);
    bf16* Ub = (bf16*)(ws + WS_U); bf16* Qb = (bf16*)(ws + WS_Q); bf16* Kb = (bf16*)(ws + WS_K); bf16* Vb = (bf16*)(ws + WS_V); bf16* Gb = (bf16*)(ws + WS_G);
    bf16* CONVF = (bf16*)(ws + WS_CONVF); bf16* OG = (bf16*)(ws + WS_OG); float* ML = (float*)(ws + WS_ML); bf16* BATT = (bf16*)(ws + WS_BATT);
    bf16* TMP = (bf16*)(ws + WS_TMP); bf16* MIX = (bf16*)(ws + WS_MIX); float* X2 = (float*)(ws + WS_X2); bf16* X2B = (bf16*)(ws + WS_X2B);

    if (IN(0)) { p0_prologue(args, lds, G, bid, tid); }
    SEAM(0);
    const bf16* W1 = (const bf16*)(ws + WS_W1); const bf16* W2 = (const bf16*)(ws + WS_W2); const bf16* W3 = (const bf16*)(ws + WS_W3); const bf16* W4A = (const bf16*)(ws + WS_W4A);
    const bf16* W4B = (const bf16*)(ws + WS_W4B); const bf16* W5 = (const bf16*)(ws + WS_W5); const bf16* W6 = (const bf16*)(ws + WS_W6); const bf16* W7 = (const bf16*)(ws + WS_W7);
#define GEMM(EPI, Aop, Bop, Nn, Kk, nM_, pmoff, Gs, cs, Eobj) do { pg8::Gemm g_{Aop, Bop, T, Nn, Kk}; pg8::SubOrder S_; S_.init(nM_, (Nn) / 256, pmoff, Gs, cs); \
        pg8::gemm_phase<EPI, pg8::SubOrder, true, true>(lds, g_, S_, Eobj); } while (0)
    if (IN(1)) {
        pg8::EpiSwiGLU E{rss0, ACT};
        GEMM(pg8::EpiSwiGLU, XB, W1, 2 * FF, D, 64, 0, G - 12, bid < G - 12 ? bid : -1, E);
        GEMM(pg8::EpiSwiGLU, XB, W1, 2 * FF, D, 2, 64, 44, bid - 192, E);
        if (bid >= G - 12) copy_quota(args, fctl, 16, MISC, tid);
    }
    SEAM(1);
    if (IN(2)) {
        pg8::EpiResid<true> E{args.in[0], args.in[1] - (size_t)TP * D, X1, X1B, rss1, 0.5f};
        GEMM(pg8::EpiResid<true>, ACT, W2, D, FF, 64, 0, G, bid, E);
    }
    SEAM(2);
    if (IN(3)) {
        { pg8::EpiIn E{rss1, Ub, Qb, Gb, args.in[14], (const float*)(ws + WS_QKN), (const float*)(ws + WS_ROT), args.out};
          GEMM(pg8::EpiIn, X1B, W3, NIN, D, 64, 0, G - 24, bid < G - 24 ? bid : -1, E); }
        { pg8::EpiResid<true> E{args.in[0], args.in[1] - (size_t)TP * D, X1, X1B, rss1, 0.5f};
          GEMM(pg8::EpiResid<true>, ACT, W2, D, FF, 2, 64, 8, bid - (G - 8), E); }
        if (bid >= G - 24 && bid < G - 8) copy_quota(args, fctl, 10, MISC, tid);
        if (bid >= G - 24) {
            unsigned* cnt = fctl + 64 * 26;
            if (bid >= G - 8) { __threadfence(); __syncthreads(); if (tid == 0) __hip_atomic_fetch_add(cnt, 1u, __ATOMIC_RELEASE, __HIP_MEMORY_SCOPE_AGENT); }
            if (tid == 0) { unsigned sp = 0; while (__hip_atomic_load(cnt, __ATOMIC_ACQUIRE, __HIP_MEMORY_SCOPE_AGENT) < 8u) { __builtin_amdgcn_s_sleep(8); if (++sp > (1u << 22)) break; } }
            __syncthreads(); __threadfence();
            pg8::EpiIn E{rss1, Ub, Qb, Gb, args.in[14], (const float*)(ws + WS_QKN), (const float*)(ws + WS_ROT), args.out};
            GEMM(pg8::EpiIn, X1B, W3, NIN, D, 2, 64, 24, bid - (G - 24), E);
        }
    }
    SEAM(3);
    if (IN(4)) {
        int it = 0; unsigned id = grab(fctl + 64 * 20, MISC, it, tid);
        while (id < 384u) { attn_sample_g12(args, lds, Qb, Kb, Vb, OG, ML, (int)(id / 3u), (int)(id % 3u), tid); id = grab(fctl + 64 * 20, MISC, it, tid); }
        {
            v4u kv[6], vv[6]; AttnU cur = attn_decode(id < 1152u ? (int)id - 384 : 0);
            if (id < 1152u) attn_load(cur, Kb, Vb, tid, kv, vv);
            while (id < 1152u) {
                __syncthreads();
                attn_write(lds, tid, kv, vv);
                __syncthreads();
                bf16x8 qf[4]; attn_qload(cur, Qb, tid, qf);
                const unsigned nid = grab(fctl + 64 * 20, MISC, it, tid);
                const AttnU nxt = attn_decode(nid < 1152u ? (int)nid - 384 : 0);
                if (nid < 1152u) attn_load(nxt, Kb, Vb, tid, kv, vv);
                attn_compute(lds, cur, qf, OG, ML, tid);
                cur = nxt; id = nid;
            }
        }
        {   float cw[31];
#pragma unroll
            for (int j = 0; j < 31; ++j) cw[j] = *(const float*)((const char*)args.in[17] + j * 2048 + (unsigned)tid * 4u);
            while (id < 1664u) { conv_unit<32, false>(args, lds, Ub, CONVF, cw, (int)id - 1152, tid); id = grab(fctl + 64 * 20, MISC, it, tid); }
            while (id < 1792u) { conv_unit<4, true>(args, lds, Ub, CONVF, cw, (int)id - 1664, tid); id = grab(fctl + 64 * 20, MISC, it, tid); }
        }
    }
    SEAM(4);
    if (IN(5)) {
        combine_groups(OG, ML, BATT, 0, TP, (size_t)bid * 512 + tid, (size_t)G * 512);
        __syncthreads();
        { pg8::EpiGateA E{Gb, TMP}; GEMM(pg8::EpiGateA, CONVF, W4A, D, 512, 64, 0, G, bid, E); }
    }
    SEAM(5);
    if (IN(6)) {
        pg8::EpiGateB E{Gb, TMP, MIX}; GEMM(pg8::EpiGateB, BATT, W4B, D, 256, 64, 0, G, bid, E);
    }
    SEAM(6);
    if (IN(7)) {
        pg8::EpiResid<true> E{X1, X1, X2, X2B, rss2, 1.0f}; GEMM(pg8::EpiResid<true>, MIX, W5, D, D, 64, 0, G, bid, E);
    }
    SEAM(7);
    if (IN(8)) {
        { pg8::EpiSwiGLU E{rss2, ACT}; GEMM(pg8::EpiSwiGLU, X2B, W6, 2 * FF, D, 64, 0, G - 8, bid < G - 8 ? bid : -1, E); }
        if (bid >= G - 8) { const int sb = bid - (G - 8);
            combine_groups(OG, ML, BATT, TP, T, (size_t)sb * 512 + tid, (size_t)8 * 512);
            { pg8::EpiGateA E{Gb, TMP}; GEMM(pg8::EpiGateA, CONVF, W4A, D, 512, 2, 64, 8, sb, E); }
            subseam(fctl + 64 * 27, 8u, true, tid);
            { pg8::EpiGateB E{Gb, TMP, MIX}; GEMM(pg8::EpiGateB, BATT, W4B, D, 256, 2, 64, 8, sb, E); }
            subseam(fctl + 64 * 28, 8u, true, tid);
            { pg8::EpiResid<true> E{X1, X1, X2, X2B, rss2, 1.0f}; GEMM(pg8::EpiResid<true>, MIX, W5, D, D, 2, 64, 8, sb, E); }
        }
    }
    SEAM(8);
    if (IN(9)) {
        { pg8::EpiResid<false> E{X2, X2, args.out, nullptr, nullptr, 0.5f}; GEMM(pg8::EpiResid<false>, ACT, W7, D, FF, 64, 0, G / 2, bid < G / 2 ? bid : -1, E); }
        if (bid >= G / 2 && bid < G / 2 + 44) { const int sb = bid - G / 2;
            { pg8::EpiSwiGLU E{rss2, ACT}; GEMM(pg8::EpiSwiGLU, X2B, W6, 2 * FF, D, 2, 64, 44, sb, E); }
            if (sb < 8) { subseam(fctl + 64 * 29, 44u, true, tid);
                pg8::EpiResid<false> E{X2, X2, args.out, nullptr, nullptr, 0.5f}; GEMM(pg8::EpiResid<false>, ACT, W7, D, FF, 2, 64, 8, sb, E); }
            else { __threadfence(); __syncthreads(); if (tid == 0) __hip_atomic_fetch_add(fctl + 64 * 29, 1u, __ATOMIC_RELEASE, __HIP_MEMORY_SCOPE_AGENT); }
        }
        filler(args, fctl, 10, 0u, 0u, MISC, tid);
    }
#undef IN
#undef SEAM
}

extern "C" void kernel_launch(void* const* d_in, const int* in_sizes, int n_in, void* d_out, int out_size, void* d_ws, size_t ws_size, hipStream_t stream) {
    static int grid = 0;
    if (grid == 0) {
        int dev = 0, cus = 0, per_cu = 0;
        if (n_in != 27 || ws_size < WS_END) { fprintf(stderr, "kernel_launch: unexpected n_in %d / ws %zu (need %zu)\n", n_in, ws_size, (size_t)WS_END); grid = -1; return; }
        (void)hipGetDevice(&dev);
        (void)hipDeviceGetAttribute(&cus, hipDeviceAttributeMultiprocessorCount, dev);
        if (hipFuncSetAttribute((const void*)mk_fwd, hipFuncAttributeMaxDynamicSharedMemorySize, LDS_BYTES) != hipSuccess) { fprintf(stderr, "kernel_launch: hipFuncSetAttribute failed\n"); grid = -1; return; }
        if (hipOccupancyMaxActiveBlocksPerMultiprocessor(&per_cu, (const void*)mk_fwd, 512, LDS_BYTES) != hipSuccess || per_cu < 1) { fprintf(stderr, "kernel_launch: occupancy query failed (%d)\n", per_cu); per_cu = 1; }
        (void)hipGetLastError();
        grid = cus;
        fprintf(stderr, "kernel_launch: cus %d per_cu %d grid %d\n", cus, per_cu, grid);
    }
    if (grid < 0) return;
    Args a{};
    for (int i = 0; i < 27; ++i) a.in[i] = (const float*)d_in[i];
    a.out = (float*)d_out; a.ws = (unsigned char*)d_ws;
    if (hipMemsetAsync((char*)d_ws + WS_BAR, 0, WS_BAR_BYTES, stream) != hipSuccess) { fprintf(stderr, "kernel_launch: memset failed\n"); return; }
#if MK_N_LAUNCHES == 1
    a.ph_lo = 0; a.ph_hi = N_PHASES;
    hipLaunchKernelGGL(mk_fwd, dim3(grid), dim3(512), LDS_BYTES, stream, a);
#else
    for (int p = 0; p < N_PHASES; ++p) { a.ph_lo = p; a.ph_hi = p + 1; hipLaunchKernelGGL(mk_fwd, dim3(grid), dim3(512), LDS_BYTES, stream, a); }
#endif
}
```
